# Optimizing an MI355X kernel written in HIP

```python
import math
import jax, jax.numpy as jnp
from jax import lax
import numpy as np

D_MODEL = 1024
BATCH = 16
SEQ = 2048
DEPTH = 1

N_DIFF_HEADS = 4
DIFF_HEAD_DIM = 64
DIFF_V_DIM = 2 * DIFF_HEAD_DIM
DIFF_QK_WIDTH = N_DIFF_HEADS * 2 * DIFF_HEAD_DIM
DIFF_OUT_WIDTH = N_DIFF_HEADS * DIFF_V_DIM
Q_BLOCK = 128
GMLP_GROUPS = 4
GMLP_GROUP_DIM = 64
GMLP_WIDTH = GMLP_GROUPS * GMLP_GROUP_DIM
CHUNK = 128
MEM_LEN = 256
N_MEM_HEADS = 4
MEM_HEAD_DIM = 64
MEM_WIDTH = N_MEM_HEADS * MEM_HEAD_DIM
D_MIX = DIFF_OUT_WIDTH + GMLP_WIDTH + MEM_WIDTH
D_IN_PROJ = 2 * DIFF_QK_WIDTH + DIFF_OUT_WIDTH + 2 * GMLP_WIDTH + MEM_WIDTH
SPLITS = (DIFF_QK_WIDTH, 2 * DIFF_QK_WIDTH, 2 * DIFF_QK_WIDTH + DIFF_OUT_WIDTH,
          2 * DIFF_QK_WIDTH + DIFF_OUT_WIDTH + 2 * GMLP_WIDTH)
ROPE_THETA = 500000.0
ROT_DIM = DIFF_HEAD_DIM // 4
N_EXPERTS = 32
TOP_K = 4
D_FF = 1024
SWIGLU_LIMIT = 7.0
SWIGLU_ALPHA = 1.702
EXPERT_BLOCK = 256
EPS = 1e-6

kernel_name = 'hybrid_diffattn_sgu_memxattn_moe'


def rms_norm(x, g):
    xf = x.astype(jnp.float32)
    y = xf * lax.rsqrt(jnp.mean(xf * xf, axis=-1, keepdims=True) + EPS)
    return (y * g.astype(jnp.float32)).astype(x.dtype)


def layer_norm(x, g):
    xf = x.astype(jnp.float32)
    xc = xf - jnp.mean(xf, axis=-1, keepdims=True)
    y = xc * lax.rsqrt(jnp.mean(xc * xc, axis=-1, keepdims=True) + EPS)
    return (y * g.astype(jnp.float32)).astype(x.dtype)


def rope_tables(positions):
    inv_freq = ROPE_THETA ** (-jnp.arange(0, ROT_DIM, 2, dtype=jnp.float32) / ROT_DIM)
    ang = positions.astype(jnp.float32)[..., None] * inv_freq
    return jnp.cos(ang), jnp.sin(ang)


def apply_partial_rope(t, cos, sin):
    c = cos[:, :, None, None, :].astype(t.dtype)
    s = sin[:, :, None, None, :].astype(t.dtype)
    half = ROT_DIM // 2
    x1 = t[..., :half]
    x2 = t[..., half:ROT_DIM]
    rot = jnp.concatenate([x1 * c - x2 * s, x2 * c + x1 * s], axis=-1)
    return jnp.concatenate([rot, t[..., ROT_DIM:]], axis=-1)


def diff_attention(pq, pk, pv, cos, sin, g_q, g_k, lq1, lk1, lq2, lk2, g_sub, lambda_init):
    B, S, _ = pq.shape
    q = pq.reshape(B, S, N_DIFF_HEADS, 2, DIFF_HEAD_DIM)
    k = pk.reshape(B, S, N_DIFF_HEADS, 2, DIFF_HEAD_DIM)
    v = pv.reshape(B, S, N_DIFF_HEADS, DIFF_V_DIM)
    q = apply_partial_rope(rms_norm(q, g_q), cos, sin) * (DIFF_HEAD_DIM ** -0.5)
    k = apply_partial_rope(rms_norm(k, g_k), cos, sin)
    lam = (jnp.exp(jnp.sum(lq1.astype(jnp.float32) * lk1.astype(jnp.float32)))
           - jnp.exp(jnp.sum(lq2.astype(jnp.float32) * lk2.astype(jnp.float32)))
           + lambda_init)
    neg = jnp.finfo(jnp.float32).min
    outs = []
    for i in range(S // Q_BLOCK):
        k_end = (i + 1) * Q_BLOCK
        qs = q[:, i * Q_BLOCK:k_end]
        ks = k[:, :k_end]
        vs = v[:, :k_end]
        s = jnp.einsum('bqhcd,bkhcd->bhcqk', qs, ks).astype(jnp.float32)
        qpos = i * Q_BLOCK + jnp.arange(Q_BLOCK)
        kpos = jnp.arange(k_end)
        s = jnp.where(kpos[None, :] <= qpos[:, None], s, neg)
        p = jax.nn.softmax(s, axis=-1)
        a = p[:, :, 0] - lam * p[:, :, 1]
        outs.append(jnp.einsum('bhqk,bkhe->bqhe', a.astype(v.dtype), vs))
    o = jnp.concatenate(outs, axis=1)
    o = rms_norm(o, g_sub) * (1.0 - lambda_init)
    return o.reshape(B, S, DIFF_OUT_WIDTH)


def spatial_gating(pg, g_sgu, w_sp, b_sp):
    B, S, _ = pg.shape
    z = jax.nn.gelu(pg)
    u, vg = z[..., :GMLP_WIDTH], z[..., GMLP_WIDTH:]
    vg = layer_norm(vg, g_sgu).reshape(B, S // CHUNK, CHUNK, GMLP_GROUPS, GMLP_GROUP_DIM)
    w_causal = jnp.tril(w_sp).astype(vg.dtype)
    mixed = jnp.einsum('gts,bnsgc->bntgc', w_causal, vg) + b_sp.T.astype(vg.dtype)[None, None, :, :, None]
    return u * mixed.reshape(B, S, GMLP_WIDTH)


def memory_cross_attention(pc, mem, g_mem, w_kv, g_q, g_k):
    B, S, _ = pc.shape
    q = rms_norm(pc.reshape(B, S, N_MEM_HEADS, MEM_HEAD_DIM), g_q) * (MEM_HEAD_DIM ** -0.5)
    kv = rms_norm(mem, g_mem) @ w_kv
    M = mem.shape[1]
    k = rms_norm(kv[..., :MEM_WIDTH].reshape(B, M, N_MEM_HEADS, MEM_HEAD_DIM), g_k)
    v = kv[..., MEM_WIDTH:].reshape(B, M, N_MEM_HEADS, MEM_HEAD_DIM)
    s = jnp.einsum('bqhd,bkhd->bhqk', q, k).astype(jnp.float32)
    p = jax.nn.softmax(s, axis=-1).astype(v.dtype)
    return jnp.einsum('bhqk,bkhd->bqhd', p, v).reshape(B, S, MEM_WIDTH)


def moe_ffn(h, w_router, b_router, w1, b1, w2, b2):
    B, S, D = h.shape
    t = h.reshape(-1, D)
    N = t.shape[0]
    logits = (t @ w_router).astype(jnp.float32) + b_router.astype(jnp.float32)
    top_val, top_idx = lax.top_k(logits, TOP_K)
    gates = jax.nn.softmax(top_val, axis=-1).astype(t.dtype)
    A = N * TOP_K
    expert_flat = top_idx.reshape(-1)
    token_flat = jnp.arange(A) // TOP_K
    gate_flat = gates.reshape(-1)
    order = jnp.argsort(expert_flat)
    e_sorted = expert_flat[order]
    tok_sorted = token_flat[order]
    gate_sorted = gate_flat[order]
    counts = jnp.bincount(expert_flat, length=N_EXPERTS)
    padded = ((counts + EXPERT_BLOCK - 1) // EXPERT_BLOCK) * EXPERT_BLOCK
    starts = jnp.cumsum(counts) - counts
    pends = jnp.cumsum(padded)
    pstarts = pends - padded
    dest = pstarts[e_sorted] + jnp.arange(A) - starts[e_sorted]
    n_blocks = -(-A // EXPERT_BLOCK) + N_EXPERTS
    P = n_blocks * EXPERT_BLOCK
    x_buf = jnp.zeros((P, D), t.dtype).at[dest].set(t[tok_sorted])
    block_expert = jnp.clip(jnp.searchsorted(pends, jnp.arange(n_blocks) * EXPERT_BLOCK, side='right'),
                            0, N_EXPERTS - 1)

    def expert_block(args):
        xb, e = args
        hm = xb @ w1[e] + b1[e]
        glu = jnp.minimum(hm[:, :D_FF], SWIGLU_LIMIT)
        lin = jnp.clip(hm[:, D_FF:], -SWIGLU_LIMIT, SWIGLU_LIMIT)
        act = glu * jax.nn.sigmoid(SWIGLU_ALPHA * glu) * (lin + 1.0)
        return act @ w2[e] + b2[e]

    y_buf = lax.map(expert_block, (x_buf.reshape(n_blocks, EXPERT_BLOCK, D), block_expert)).reshape(P, D)
    out = jnp.zeros((N, D), t.dtype).at[tok_sorted].add(gate_sorted[:, None] * y_buf[dest])
    return out.reshape(B, S, D)


def setup_inputs(seed: int = 0) -> dict:
    key = jax.random.key(seed)
    ks = jax.random.split(key, 32)
    L = DEPTH
    f32 = jnp.float32

    def nrm(k, shape, scale):
        return jax.random.normal(k, shape, f32) * scale

    def gain(k, shape):
        return 1.0 + 0.01 * jax.random.normal(k, shape, f32)

    positions = (jnp.arange(SEQ, dtype=jnp.int32)[None, :]
                 + jax.random.randint(ks[2], (BATCH, 1), 0, 4096, dtype=jnp.int32))
    return {
        'x': jax.random.normal(ks[0], (BATCH, SEQ, D_MODEL), f32),
        'mem': jax.random.normal(ks[1], (BATCH, MEM_LEN, D_MODEL), f32),
        'positions': positions,
        'g_mix_norm': gain(ks[3], (L, D_MODEL)),
        'w_in': nrm(ks[4], (L, D_MODEL, D_IN_PROJ), D_MODEL ** -0.5),
        'g_dq': gain(ks[5], (L, DIFF_HEAD_DIM)),
        'g_dk': gain(ks[6], (L, DIFF_HEAD_DIM)),
        'lambda_q1': nrm(ks[7], (L, DIFF_HEAD_DIM), 0.1),
        'lambda_k1': nrm(ks[8], (L, DIFF_HEAD_DIM), 0.1),
        'lambda_q2': nrm(ks[9], (L, DIFF_HEAD_DIM), 0.1),
        'lambda_k2': nrm(ks[10], (L, DIFF_HEAD_DIM), 0.1),
        'g_subln': gain(ks[11], (L, DIFF_V_DIM)),
        'g_sgu': gain(ks[12], (L, GMLP_WIDTH)),
        'w_spatial': nrm(ks[13], (L, GMLP_GROUPS, CHUNK, CHUNK), CHUNK ** -0.5),
        'b_spatial': 1.0 + nrm(ks[14], (L, GMLP_GROUPS, CHUNK), 0.1),
        'g_mem_norm': gain(ks[15], (L, D_MODEL)),
        'w_mem_kv': nrm(ks[16], (L, D_MODEL, 2 * MEM_WIDTH), D_MODEL ** -0.5),
        'g_cq': gain(ks[17], (L, MEM_HEAD_DIM)),
        'g_ck': gain(ks[18], (L, MEM_HEAD_DIM)),
        'w_out': nrm(ks[19], (L, D_MIX, D_MODEL), D_MIX ** -0.5),
        'g_ffn_norm': gain(ks[20], (L, D_MODEL)),
        'w_router': nrm(ks[21], (L, D_MODEL, N_EXPERTS), D_MODEL ** -0.5),
        'b_router': nrm(ks[22], (L, N_EXPERTS), 0.01),
        'w_mlp1': nrm(ks[23], (L, N_EXPERTS, D_MODEL, 2 * D_FF), D_MODEL ** -0.5),
        'b_mlp1': nrm(ks[24], (L, N_EXPERTS, 2 * D_FF), 0.01),
        'w_mlp2': nrm(ks[25], (L, N_EXPERTS, D_FF, D_MODEL), D_FF ** -0.5),
        'b_mlp2': nrm(ks[26], (L, N_EXPERTS, D_MODEL), 0.01),
    }


def reference(x, mem, positions, g_mix_norm, w_in, g_dq, g_dk, lambda_q1, lambda_k1, lambda_q2,
              lambda_k2, g_subln, g_sgu, w_spatial, b_spatial, g_mem_norm, w_mem_kv, g_cq, g_ck,
              w_out, g_ffn_norm, w_router, b_router, w_mlp1, b_mlp1, w_mlp2, b_mlp2):
    cos, sin = rope_tables(positions)
    for l in range(DEPTH):
        lambda_init = 0.8 - 0.6 * math.exp(-0.3 * l)
        h = rms_norm(x, g_mix_norm[l])
        proj = h @ w_in[l]
        pq, pk, pv, pg, pc = jnp.split(proj, SPLITS, axis=-1)
        a = diff_attention(pq, pk, pv, cos, sin, g_dq[l], g_dk[l], lambda_q1[l], lambda_k1[l],
                           lambda_q2[l], lambda_k2[l], g_subln[l], lambda_init)
        g = spatial_gating(pg, g_sgu[l], w_spatial[l], b_spatial[l])
        c = memory_cross_attention(pc, mem, g_mem_norm[l], w_mem_kv[l], g_cq[l], g_ck[l])
        x = x + jnp.concatenate([a, g, c], axis=-1) @ w_out[l]
        x = x + moe_ffn(rms_norm(x, g_ffn_norm[l]), w_router[l], b_router[l],
                        w_mlp1[l], b_mlp1[l], w_mlp2[l], b_mlp2[l])
    return x
```

```cpp
#include <hip/hip_runtime.h>
#include <hip/hip_cooperative_groups.h>
#include <cstdio>
#include <cstdint>
namespace cg = cooperative_groups;

#ifndef MK_N_LAUNCHES
#define MK_N_LAUNCHES 9
#endif

constexpr int BATCH = 16, SEQ = 2048, DM = 1024, M = BATCH * SEQ;
constexpr int NPROJ = 2304;
constexpr int MEML = 256, MM = BATCH * MEML;
constexpr int NE = 32, TOPK = 4, DFF = 1024;
constexpr int MAXTILES = (M * TOPK) / 256 + NE;
constexpr int NSLOT = MAXTILES * 256;
constexpr float EPS = 1e-6f;
constexpr float C2 = 0.125f * 1.4426950408889634f;
constexpr int NWAVES = 8, NTHREADS = 512;
constexpr int LDS_BYTES = 147456;

constexpr size_t MiB = 1u << 20;
constexpr size_t WS_CTL = 0;
constexpr size_t WS_WIN = 2 * MiB, WS_WO = 7 * MiB, WS_WKV = 9 * MiB, WS_CS = 10 * MiB, WS_LIST = 12 * MiB, WS_GLIST = 16 * MiB;
constexpr size_t WS_MEMN = 20 * MiB, WS_MEMK = 28 * MiB, WS_MEMV = 30 * MiB;
constexpr size_t WS_W1 = 32 * MiB, WS_W2 = 160 * MiB, WS_H2 = 224 * MiB, WS_ACT = 288 * MiB;
constexpr size_t WS_XN = 560 * MiB, WS_QB = 624 * MiB, WS_KB = 656 * MiB, WS_VB = 688 * MiB, WS_UB = 720 * MiB, WS_VGB = 736 * MiB, WS_MQB = 752 * MiB;
constexpr size_t WS_OT = 768 * MiB, WS_CAT = 832 * MiB, WS_END = 896 * MiB;
constexpr size_t WS_YB = 560 * MiB;
constexpr size_t WS_PROJ = 224 * MiB;
constexpr size_t WS_KVT = 512 * MiB;
static_assert(WS_ACT + (size_t)NSLOT * DFF * 2 <= WS_XN, "act");
static_assert(WS_PROJ + (size_t)M * NPROJ * 4 <= WS_KVT && WS_KVT + (size_t)MM * 512 * 4 <= WS_XN, "proj temp");

#define LAS __attribute__((address_space(3)))
typedef unsigned short bf16_t;
typedef short bf16x8 __attribute__((ext_vector_type(8)));
typedef float f32x4 __attribute__((ext_vector_type(4)));
typedef unsigned u32x4 __attribute__((ext_vector_type(4)));
typedef unsigned u32x2 __attribute__((ext_vector_type(2)));

__device__ __forceinline__ unsigned f2bf(float f) { unsigned u = __float_as_uint(f); return (u + 0x7fffu + ((u >> 16) & 1u)) >> 16; }
__device__ __forceinline__ float bf2f(unsigned h) { return __uint_as_float(h << 16); }
__device__ __forceinline__ unsigned pk2(float lo, float hi) { return f2bf(lo) | (f2bf(hi) << 16); }
__device__ __forceinline__ float wave_sum(float v) {
#pragma unroll
    for (int o = 1; o < 64; o <<= 1) v += __shfl_xor(v, o);
    return v;
}
__device__ __forceinline__ float gelu_tanh(float x) {
    const float y = 0.7978845608028654f * (x + 0.044715f * x * x * x);
    const float t = 1.f - 2.f / (1.f + __expf(2.f * y));
    return 0.5f * x * (1.f + t);
}

struct Args {
    const void* in[27]; float* out; unsigned char* ws; int ph_lo, ph_hi;
};

__device__ __forceinline__ void transpose_item(const float* W, int K, int N, bf16_t* WT, LAS float* scr, int item, int lane) {
    const int nblk = N / 32, kb = item / nblk, nb = item % nblk, k0 = 64 * kb, n0 = 32 * nb;
#pragma unroll 8
    for (int i = 0; i < 32; ++i) { const int kk = 2 * i + (lane >> 5); scr[kk * 33 + (lane & 31)] = W[(size_t)(k0 + kk) * N + n0 + (lane & 31)]; }
    asm volatile("s_waitcnt lgkmcnt(0)" ::: "memory");
    const int c = lane & 7;
#pragma unroll
    for (int j = 0; j < 4; ++j) { const int n = (lane >> 3) + 8 * j; const LAS float* s = scr + (8 * c) * 33 + n;
        u32x4 o; o.x = pk2(s[0 * 33], s[1 * 33]); o.y = pk2(s[2 * 33], s[3 * 33]); o.z = pk2(s[4 * 33], s[5 * 33]); o.w = pk2(s[6 * 33], s[7 * 33]);
        *(u32x4*)(WT + (size_t)(n0 + n) * K + k0 + 8 * c) = o; }
    asm volatile("s_waitcnt lgkmcnt(0)" ::: "memory");
}
__device__ __forceinline__ void rms_row_to_bf16(const float* xrow, const float* g, bf16_t* orow, int lane) {
    const f32x4* xr = (const f32x4*)xrow + lane; const f32x4* gr = (const f32x4*)g + lane;
    f32x4 v[4]; float s = 0.f;
#pragma unroll
    for (int j = 0; j < 4; ++j) { v[j] = xr[64 * j]; s += (v[j].x * v[j].x + v[j].y * v[j].y) + (v[j].z * v[j].z + v[j].w * v[j].w); }
    const float rstd = 1.0f / sqrtf(wave_sum(s) * (1.f / DM) + EPS);
    u32x2* o8 = (u32x2*)orow + lane;
#pragma unroll
    for (int j = 0; j < 4; ++j) { const f32x4 gg = gr[64 * j]; u32x2 w; w.x = pk2(v[j].x * rstd * gg.x, v[j].y * rstd * gg.y); w.y = pk2(v[j].z * rstd * gg.z, v[j].w * rstd * gg.w); o8[64 * j] = w; }
}

template <int NB, class RowFn, class Epi>
__device__ __forceinline__ void sgemm_item(const bf16_t* A, int lda, RowFn rowfn, const bf16_t* Bt0, const bf16_t* Bt1, int ldb, int K, int m0, int n0, Epi epi, int wave, int lane) {
    const int fr = lane & 15, fq = lane >> 4;
    unsigned aoff[2], boff[4];
#pragma unroll
    for (int mi = 0; mi < 2; ++mi) aoff[mi] = (unsigned)rowfn(m0 + 32 * wave + 16 * mi + fr) * (unsigned)lda + 8u * fq;
#pragma unroll
    for (int ni = 0; ni < 4; ++ni) boff[ni] = (unsigned)(n0 + 16 * ni + fr) * (unsigned)ldb + 8u * fq;
    f32x4 acc[NB][2][4];
#pragma unroll
    for (int b = 0; b < NB; ++b)
#pragma unroll
        for (int mi = 0; mi < 2; ++mi)
#pragma unroll
            for (int ni = 0; ni < 4; ++ni) acc[b][mi][ni] = (f32x4){0.f, 0.f, 0.f, 0.f};
#pragma unroll 2
    for (int k0 = 0; k0 < K; k0 += 32) {
        bf16x8 a[2], bb[NB][4];
#pragma unroll
        for (int mi = 0; mi < 2; ++mi) a[mi] = *(const bf16x8*)(A + k0 + aoff[mi]);
#pragma unroll
        for (int ni = 0; ni < 4; ++ni) { bb[0][ni] = *(const bf16x8*)(Bt0 + k0 + boff[ni]); if (NB == 2) bb[NB - 1][ni] = *(const bf16x8*)(Bt1 + k0 + boff[ni]); }
#pragma unroll
        for (int b = 0; b < NB; ++b)
#pragma unroll
            for (int mi = 0; mi < 2; ++mi)
#pragma unroll
                for (int ni = 0; ni < 4; ++ni) acc[b][mi][ni] = __builtin_amdgcn_mfma_f32_16x16x32_bf16(a[mi], bb[b][ni], acc[b][mi][ni], 0, 0, 0);
    }
#pragma unroll
    for (int mi = 0; mi < 2; ++mi)
#pragma unroll
        for (int ni = 0; ni < 4; ++ni)
#pragma unroll
            for (int j = 0; j < 4; ++j) epi(m0 + 32 * wave + 16 * mi + 4 * fq + j, n0 + 16 * ni + fr, acc[0][mi][ni][j], acc[NB - 1][mi][ni][j]);
}

template <int DV, bool CAUSAL>
__device__ __forceinline__ void sattn_wave(const bf16_t* Qw, int ldq, const bf16_t* Kp, int ldk, const bf16_t* Vp, int ldv, int nblk, int q0, LAS bf16_t* pl, f32x4 (&o)[DV / 16], int lane) {
    const int fr = lane & 15, fq = lane >> 4;
    bf16x8 qa[2];
#pragma unroll
    for (int ks = 0; ks < 2; ++ks) qa[ks] = *(const bf16x8*)(Qw + (size_t)fr * ldq + 32 * ks + 8 * fq);
    float mrow[4], lpart[4];
#pragma unroll
    for (int j = 0; j < 4; ++j) { mrow[j] = -1e30f; lpart[j] = 0.f; }
#pragma unroll
    for (int nt = 0; nt < DV / 16; ++nt) o[nt] = (f32x4){0.f, 0.f, 0.f, 0.f};
    for (int kb = 0; kb < nblk; ++kb) {
        f32x4 s[2];
#pragma unroll
        for (int nt = 0; nt < 2; ++nt) {
            s[nt] = (f32x4){0.f, 0.f, 0.f, 0.f};
            const bf16_t* kr = Kp + (size_t)(kb * 32 + 16 * nt + fr) * ldk + 8 * fq;
#pragma unroll
            for (int ks = 0; ks < 2; ++ks) { const bf16x8 kf = *(const bf16x8*)(kr + 32 * ks); s[nt] = __builtin_amdgcn_mfma_f32_16x16x32_bf16(qa[ks], kf, s[nt], 0, 0, 0); }
        }
        if (CAUSAL) {
#pragma unroll
            for (int nt = 0; nt < 2; ++nt)
#pragma unroll
                for (int j = 0; j < 4; ++j) if (kb * 32 + 16 * nt + fr > q0 + 4 * fq + j) s[nt][j] = -1e30f;
        }
        float alpha[4];
#pragma unroll
        for (int j = 0; j < 4; ++j) {
            float mx = fmaxf(s[0][j], s[1][j]);
            mx = fmaxf(mx, __shfl_xor(mx, 1)); mx = fmaxf(mx, __shfl_xor(mx, 2)); mx = fmaxf(mx, __shfl_xor(mx, 4)); mx = fmaxf(mx, __shfl_xor(mx, 8));
            const float mn = fmaxf(mrow[j], mx);
            alpha[j] = exp2f(mrow[j] - mn); mrow[j] = mn;
            const float p0 = exp2f(s[0][j] - mn), p1 = exp2f(s[1][j] - mn);
            lpart[j] = lpart[j] * alpha[j] + p0 + p1;
            pl[(4 * fq + j) * 40 + fr] = (bf16_t)f2bf(p0); pl[(4 * fq + j) * 40 + 16 + fr] = (bf16_t)f2bf(p1);
        }
#pragma unroll
        for (int nt = 0; nt < DV / 16; ++nt)
#pragma unroll
            for (int j = 0; j < 4; ++j) o[nt][j] *= alpha[j];
        asm volatile("s_waitcnt lgkmcnt(0)" ::: "memory");
        const bf16x8 pa = *(const LAS bf16x8*)(pl + fr * 40 + 8 * fq);
        asm volatile("s_waitcnt lgkmcnt(0)" ::: "memory");
#pragma unroll
        for (int nt = 0; nt < DV / 16; ++nt) {
            bf16x8 vf;
#pragma unroll
            for (int jj = 0; jj < 8; ++jj) vf[jj] = (short)Vp[(size_t)(kb * 32 + 8 * fq + jj) * ldv + 16 * nt + fr];
            o[nt] = __builtin_amdgcn_mfma_f32_16x16x32_bf16(pa, vf, o[nt], 0, 0, 0);
        }
    }
#pragma unroll
    for (int j = 0; j < 4; ++j) {
        float l = lpart[j];
        l += __shfl_xor(l, 1); l += __shfl_xor(l, 2); l += __shfl_xor(l, 4); l += __shfl_xor(l, 8);
        const float rl = 1.0f / l;
#pragma unroll
        for (int nt = 0; nt < DV / 16; ++nt) o[nt][j] *= rl;
    }
}

__global__ void __launch_bounds__(NTHREADS, 2) mk_fwd(Args args) {
    extern __shared__ __attribute__((aligned(16))) unsigned char lds_raw[];
    LAS unsigned char* lds = (LAS unsigned char*)lds_raw;
    const int tid = threadIdx.x, lane = tid & 63, wave = __builtin_amdgcn_readfirstlane(tid >> 6);
    const int G = gridDim.x, bid = blockIdx.x;
    const int gw = bid * NWAVES + wave, NGW = G * NWAVES;
#define DECL_ALL \
    unsigned char* ws = args.ws; \
    const float* x = (const float*)args.in[0]; const float* mem = (const float*)args.in[1]; const int* positions = (const int*)args.in[2]; \
    const float* g_mix = (const float*)args.in[3]; const float* w_in = (const float*)args.in[4]; \
    const float* g_dq = (const float*)args.in[5]; const float* g_dk = (const float*)args.in[6]; \
    const float* lq1 = (const float*)args.in[7]; const float* lk1 = (const float*)args.in[8]; const float* lq2 = (const float*)args.in[9]; const float* lk2 = (const float*)args.in[10]; \
    const float* g_sub = (const float*)args.in[11]; const float* g_sgu = (const float*)args.in[12]; \
    const float* w_sp = (const float*)args.in[13]; const float* b_sp = (const float*)args.in[14]; \
    const float* g_memn = (const float*)args.in[15]; const float* w_kv = (const float*)args.in[16]; \
    const float* g_cq = (const float*)args.in[17]; const float* g_ck = (const float*)args.in[18]; \
    const float* w_out = (const float*)args.in[19]; const float* g_ffn = (const float*)args.in[20]; \
    const float* w_router = (const float*)args.in[21]; const float* b_router = (const float*)args.in[22]; \
    const float* w_mlp1 = (const float*)args.in[23]; const float* b_mlp1 = (const float*)args.in[24]; \
    const float* w_mlp2 = (const float*)args.in[25]; const float* b_mlp2 = (const float*)args.in[26]; \
    float* out = args.out; \
    unsigned* ctl = (unsigned*)(ws + WS_CTL); \
    bf16_t* WIN_T = (bf16_t*)(ws + WS_WIN); bf16_t* WO_T = (bf16_t*)(ws + WS_WO); bf16_t* WKV_T = (bf16_t*)(ws + WS_WKV); \
    float* CS = (float*)(ws + WS_CS); int* LIST = (int*)(ws + WS_LIST); float* GLIST = (float*)(ws + WS_GLIST); \
    bf16_t* MEMN = (bf16_t*)(ws + WS_MEMN); bf16_t* MEMK = (bf16_t*)(ws + WS_MEMK); bf16_t* MEMV = (bf16_t*)(ws + WS_MEMV); \
    bf16_t* W1T = (bf16_t*)(ws + WS_W1); bf16_t* W2T = (bf16_t*)(ws + WS_W2); bf16_t* H2 = (bf16_t*)(ws + WS_H2); bf16_t* ACT = (bf16_t*)(ws + WS_ACT); \
    bf16_t* XN = (bf16_t*)(ws + WS_XN); bf16_t* QB = (bf16_t*)(ws + WS_QB); bf16_t* KB = (bf16_t*)(ws + WS_KB); bf16_t* VB = (bf16_t*)(ws + WS_VB); \
    bf16_t* UB = (bf16_t*)(ws + WS_UB); bf16_t* VGB = (bf16_t*)(ws + WS_VGB); bf16_t* MQB = (bf16_t*)(ws + WS_MQB); \
    bf16_t* CAT = (bf16_t*)(ws + WS_CAT); bf16_t* YB = (bf16_t*)(ws + WS_YB); \
    float* PROJ = (float*)(ws + WS_PROJ); float* KVT = (float*)(ws + WS_KVT); \
    (void)x; (void)mem; (void)positions; (void)g_mix; (void)w_in; (void)g_dq; (void)g_dk; (void)lq1; (void)lk1; (void)lq2; (void)lk2; (void)g_sub; (void)g_sgu; (void)w_sp; (void)b_sp; \
    (void)g_memn; (void)w_kv; (void)g_cq; (void)g_ck; (void)w_out; (void)g_ffn; (void)w_router; (void)b_router; (void)w_mlp1; (void)b_mlp1; (void)w_mlp2; (void)b_mlp2; (void)out; (void)ctl; \
    (void)WIN_T; (void)WO_T; (void)WKV_T; (void)CS; (void)LIST; (void)GLIST; (void)MEMN; (void)MEMK; (void)MEMV; (void)W1T; (void)W2T; (void)H2; (void)ACT; (void)XN; (void)QB; (void)KB; (void)VB; \
    (void)UB; (void)VGB; (void)MQB; (void)CAT; (void)YB; (void)PROJ; (void)KVT;

    const int lo = args.ph_lo, hi = args.ph_hi;
#ifndef PHMASK
#define PHMASK 0x1ff
#endif
#define IN(k) (((PHMASK >> (k)) & 1) && lo <= (k) && (k) < hi)
#define BOTH(k) (IN(k) && IN((k) + 1))
#define GRID_BAR() do { __threadfence(); cg::this_grid().sync(); } while (0)

    if (IN(0)) {
        DECL_ALL
        LAS float* scr = (LAS float*)(lds + wave * 16384);
        constexpr int I_IN = 16 * (NPROJ / 32), I_O = 16 * 32, I_KV = 16 * 16, I_1 = 16 * 64, I_2 = 16 * 32;
        constexpr int NITEMS = I_IN + I_O + I_KV + NE * I_1 + NE * I_2;
        for (int it = gw; it < NITEMS; it += NGW) {
            int r = it;
            if (r < I_IN) { transpose_item(w_in, DM, NPROJ, WIN_T, scr, r, lane); continue; } r -= I_IN;
            if (r < I_O) { transpose_item(w_out, DM, DM, WO_T, scr, r, lane); continue; } r -= I_O;
            if (r < I_KV) { transpose_item(w_kv, DM, 512, WKV_T, scr, r, lane); continue; } r -= I_KV;
            if (r < NE * I_1) { const int e = r / I_1; transpose_item(w_mlp1 + (size_t)e * DM * 2048, DM, 2048, W1T + (size_t)e * 2048 * DM, scr, r % I_1, lane); continue; } r -= NE * I_1;
            { const int e = r / I_2; transpose_item(w_mlp2 + (size_t)e * DFF * DM, DFF, DM, W2T + (size_t)e * DM * DFF, scr, r % I_2, lane); }
        }
        for (int m = gw; m < M; m += NGW) rms_row_to_bf16(x + (size_t)m * DM, g_mix, XN + (size_t)m * DM, lane);
        for (int m = gw; m < MM; m += NGW) rms_row_to_bf16(mem + (size_t)m * DM, g_memn, MEMN + (size_t)m * DM, lane);
        for (int i = bid * NTHREADS + tid; i < M * 8; i += G * NTHREADS) {
            const int tok = i >> 3, f = i & 7;
            const float inv = (float)exp2(-(double)f * 0.125 * 18.931568569324174);
            const float ang = (float)positions[tok] * inv;
            CS[(size_t)tok * 16 + f] = (float)cos((double)ang); CS[(size_t)tok * 16 + 8 + f] = (float)sin((double)ang);
        }
        if (bid == 0 && tid < 64) ctl[tid] = 0u;
        if (BOTH(0)) GRID_BAR();
    }

    if (IN(1)) {
        DECL_ALL
        constexpr int N1 = (M / 256) * (NPROJ / 64), N2 = (MM / 256) * (512 / 64);
        for (int it = bid; it < N1 + N2; it += G) {
            if (it < N1) {
                const int mt = it / (NPROJ / 64), nc = it % (NPROJ / 64);
                sgemm_item<1>(XN, DM, [](int r) { return r; }, WIN_T, WIN_T, DM, DM, mt * 256, nc * 64,
                              [=](int r, int c, float v, float) { PROJ[(size_t)r * NPROJ + c] = v; }, wave, lane);
            } else {
                const int j = it - N1, mt = j / 8, nc = j % 8;
                sgemm_item<1>(MEMN, DM, [](int r) { return r; }, WKV_T, WKV_T, DM, DM, mt * 256, nc * 64,
                              [=](int r, int c, float v, float) { KVT[(size_t)r * 512 + c] = v; }, wave, lane);
            }
        }
        if (BOTH(1)) GRID_BAR();
    }

    if (IN(2)) {
        DECL_ALL
        for (int m = gw; m < M; m += NGW) {
            const float* pr = PROJ + (size_t)m * NPROJ;
            const int i8 = lane & 7; const float cc = CS[(size_t)m * 16 + i8], sn = CS[(size_t)m * 16 + 8 + i8];
            for (int g = 0; g < 16; ++g) {
                const float v = pr[g * 64 + lane];
                const float rstd = 1.0f / sqrtf(wave_sum(v * v) * (1.f / 64) + EPS);
                float y = v * rstd * (g < 8 ? g_dq[lane] : g_dk[lane]);
                const float partner = __shfl_xor(y, 8);
                if (lane < 8) y = y * cc - partner * sn; else if (lane < 16) y = y * cc + partner * sn;
                if (g < 8) QB[(size_t)m * 512 + g * 64 + lane] = (bf16_t)f2bf(y * C2); else KB[(size_t)m * 512 + (g - 8) * 64 + lane] = (bf16_t)f2bf(y);
            }
            for (int j = 0; j < 8; ++j) VB[(size_t)m * 512 + j * 64 + lane] = (bf16_t)f2bf(pr[1024 + j * 64 + lane]);
            for (int j = 0; j < 4; ++j) UB[(size_t)m * 256 + j * 64 + lane] = (bf16_t)f2bf(gelu_tanh(pr[1536 + j * 64 + lane]));
            for (int j = 0; j < 4; ++j) VGB[(size_t)m * 256 + j * 64 + lane] = (bf16_t)f2bf(gelu_tanh(pr[1792 + j * 64 + lane]));
            for (int g = 0; g < 4; ++g) {
                const float v = pr[2048 + g * 64 + lane];
                const float rstd = 1.0f / sqrtf(wave_sum(v * v) * (1.f / 64) + EPS);
                MQB[(size_t)m * 256 + g * 64 + lane] = (bf16_t)f2bf(v * rstd * g_cq[lane] * C2);
            }
        }
        for (int m = gw; m < MM; m += NGW) {
            const float* pr = KVT + (size_t)m * 512;
            for (int g = 0; g < 4; ++g) {
                const float v = pr[g * 64 + lane];
                const float rstd = 1.0f / sqrtf(wave_sum(v * v) * (1.f / 64) + EPS);
                MEMK[(size_t)m * 256 + g * 64 + lane] = (bf16_t)f2bf(v * rstd * g_ck[lane]);
                MEMV[(size_t)m * 256 + g * 64 + lane] = (bf16_t)f2bf(pr[256 + g * 64 + lane]);
            }
        }
        if (BOTH(2)) GRID_BAR();
    }

    if (IN(3)) {
        DECL_ALL
        LAS bf16_t* pl = (LAS bf16_t*)(lds + wave * 2048);
        const float lam = __expf(wave_sum(lq1[lane] * lk1[lane])) - __expf(wave_sum(lq2[lane] * lk2[lane])) + 0.2f;
        const int fr = lane & 15, fq = lane >> 4;
        for (int it = bid; it < BATCH * 4 * 16; it += G) {
            const int b = it / 64, h = (it / 16) & 3, qb = it & 15;
            const int q0 = qb * 128 + wave * 16; const size_t rb = (size_t)b * SEQ;
            f32x4 o1[8], o2[8];
            sattn_wave<128, true>(QB + (rb + q0) * 512 + (h * 2 + 0) * 64, 512, KB + rb * 512 + (h * 2 + 0) * 64, 512, VB + rb * 512 + h * 128, 512, (q0 + 16 + 31) / 32, q0, pl, o1, lane);
            sattn_wave<128, true>(QB + (rb + q0) * 512 + (h * 2 + 1) * 64, 512, KB + rb * 512 + (h * 2 + 1) * 64, 512, VB + rb * 512 + h * 128, 512, (q0 + 16 + 31) / 32, q0, pl, o2, lane);
#pragma unroll
            for (int j = 0; j < 4; ++j) {
                float ss = 0.f;
#pragma unroll
                for (int nt = 0; nt < 8; ++nt) { o1[nt][j] -= lam * o2[nt][j]; ss += o1[nt][j] * o1[nt][j]; }
                ss += __shfl_xor(ss, 1); ss += __shfl_xor(ss, 2); ss += __shfl_xor(ss, 4); ss += __shfl_xor(ss, 8);
                const float rstd = 0.8f / sqrtf(ss * (1.f / 128) + EPS);
#pragma unroll
                for (int nt = 0; nt < 8; ++nt) CAT[(rb + q0 + 4 * fq + j) * 1024 + h * 128 + 16 * nt + fr] = (bf16_t)f2bf(o1[nt][j] * rstd * g_sub[16 * nt + fr]);
            }
        }
        for (int it = bid; it < BATCH * 4 * 16; it += G) {
            const int b = it / 64, h = (it / 16) & 3, qb = it & 15;
            const int q0 = qb * 128 + wave * 16; const size_t rb = (size_t)b * SEQ;
            f32x4 oc[4];
            sattn_wave<64, false>(MQB + (rb + q0) * 256 + h * 64, 256, MEMK + (size_t)b * MEML * 256 + h * 64, 256, MEMV + (size_t)b * MEML * 256 + h * 64, 256, MEML / 32, q0, pl, oc, lane);
#pragma unroll
            for (int j = 0; j < 4; ++j)
#pragma unroll
                for (int nt = 0; nt < 4; ++nt) CAT[(rb + q0 + 4 * fq + j) * 1024 + 768 + h * 64 + 16 * nt + fr] = (bf16_t)f2bf(oc[nt][j]);
        }
        __syncthreads();
        LAS float* vt = (LAS float*)lds;
        for (int it = bid; it < BATCH * 16; it += G) {
            const size_t r0 = (size_t)it * 128;
            for (int rr = wave; rr < 128; rr += NWAVES) {
                const u32x2 w = *(const u32x2*)(VGB + (r0 + rr) * 256 + 4 * lane);
                const float v0 = bf2f(w.x & 0xffffu), v1 = bf2f(w.x >> 16), v2 = bf2f(w.y & 0xffffu), v3 = bf2f(w.y >> 16);
                const float mean = wave_sum((v0 + v1) + (v2 + v3)) * (1.f / 256);
                const float d0 = v0 - mean, d1 = v1 - mean, d2 = v2 - mean, d3 = v3 - mean;
                const float rstd = 1.0f / sqrtf(wave_sum((d0 * d0 + d1 * d1) + (d2 * d2 + d3 * d3)) * (1.f / 256) + EPS);
                const f32x4 gg = *(const f32x4*)(g_sgu + 4 * lane);
                *(LAS f32x4*)(vt + rr * 256 + 4 * lane) = (f32x4){d0 * rstd * gg.x, d1 * rstd * gg.y, d2 * rstd * gg.z, d3 * rstd * gg.w};
            }
            __syncthreads();
            const int ch = tid & 255, g = ch >> 6;
            for (int i = 0; i < 64; ++i) {
                const int t = 2 * i + (tid >> 8);
                const float* wr = w_sp + ((size_t)g * 128 + t) * 128;
                float acc = 0.f;
                for (int s = 0; s <= t; ++s) acc += wr[s] * vt[s * 256 + ch];
                const float u = bf2f(UB[(r0 + t) * 256 + ch]);
                CAT[(r0 + t) * 1024 + 512 + ch] = (bf16_t)f2bf(u * (acc + b_sp[g * 128 + t]));
            }
            __syncthreads();
        }
        if (BOTH(3)) GRID_BAR();
    }

    if (IN(4)) {
        DECL_ALL
        for (int it = bid; it < (M / 256) * (DM / 64); it += G) {
            const int mt = it / 16, nc = it % 16;
            sgemm_item<1>(CAT, DM, [](int r) { return r; }, WO_T, WO_T, DM, DM, mt * 256, nc * 64,
                          [=](int r, int c, float v, float) { out[(size_t)r * DM + c] = x[(size_t)r * DM + c] + v; }, wave, lane);
        }
        if (BOTH(4)) GRID_BAR();
    }

    if (IN(5)) {
        DECL_ALL
        for (int m = gw; m < M; m += NGW) {
            const f32x4* xr = (const f32x4*)(out + (size_t)m * DM) + 4 * lane; const f32x4* gr = (const f32x4*)g_ffn + 4 * lane;
            f32x4 v[4]; float s = 0.f;
#pragma unroll
            for (int j = 0; j < 4; ++j) { v[j] = xr[j]; s += (v[j].x * v[j].x + v[j].y * v[j].y) + (v[j].z * v[j].z + v[j].w * v[j].w); }
            const float rstd = 1.0f / sqrtf(wave_sum(s) * (1.f / DM) + EPS);
            u32x2* o8 = (u32x2*)(H2 + (size_t)m * DM) + 4 * lane;
#pragma unroll
            for (int j = 0; j < 4; ++j) { const f32x4 gg = gr[j]; v[j].x *= rstd * gg.x; v[j].y *= rstd * gg.y; v[j].z *= rstd * gg.z; v[j].w *= rstd * gg.w;
                u32x2 w; w.x = pk2(v[j].x, v[j].y); w.y = pk2(v[j].z, v[j].w); o8[j] = w; }
            const f32x4* wr = (const f32x4*)(w_router + (size_t)lane * 16 * 32);
            LAS float* scr = (LAS float*)(lds + wave * 12800);
            LAS float* hs = scr + 2112 + lane * 17;
#pragma unroll
            for (int j = 0; j < 4; ++j)
#pragma unroll
                for (int i = 0; i < 4; ++i) hs[4 * j + i] = v[j][i];
            asm volatile("s_waitcnt lgkmcnt(0)" ::: "memory");
            float lg[32];
#pragma unroll
            for (int e = 0; e < 32; ++e) lg[e] = 0.f;
#pragma unroll 1
            for (int c = 0; c < 16; ++c) {
                const float hv = hs[c];
#pragma unroll
                for (int e4 = 0; e4 < 8; ++e4) { const f32x4 w = wr[c * 8 + e4]; lg[4 * e4] += hv * w.x; lg[4 * e4 + 1] += hv * w.y; lg[4 * e4 + 2] += hv * w.z; lg[4 * e4 + 3] += hv * w.w; }
            }
#pragma unroll
            for (int e = 0; e < 32; ++e) scr[e * 65 + lane] = lg[e];
            asm volatile("s_waitcnt lgkmcnt(0)" ::: "memory");
            const int e_me = lane & 31, half = lane >> 5;
            float tot = 0.f;
#pragma unroll
            for (int i = 0; i < 32; ++i) tot += scr[e_me * 65 + half * 32 + i];
            asm volatile("s_waitcnt lgkmcnt(0)" ::: "memory");
            tot += __shfl_xor(tot, 32);
            float myv = tot + b_router[e_me];
            float tv[4]; int ti[4];
#pragma unroll
            for (int k = 0; k < 4; ++k) {
                float bv = myv; int bi = e_me;
#pragma unroll
                for (int o = 1; o < 32; o <<= 1) { const float ov = __shfl_xor(bv, o); const int oi = __shfl_xor(bi, o); const bool take = (ov > bv) || (ov == bv && oi < bi); bv = take ? ov : bv; bi = take ? oi : bi; }
                tv[k] = bv; ti[k] = bi;
                if (e_me == bi) myv = -3.0e38f;
            }
            float ex[4], sum = 0.f;
#pragma unroll
            for (int k = 0; k < 4; ++k) { ex[k] = __expf(tv[k] - tv[0]); sum += ex[k]; }
            if (lane == 0) {
#pragma unroll
                for (int k = 0; k < 4; ++k) {
                    const unsigned r = atomicAdd(&ctl[ti[k]], 1u);
                    LIST[(size_t)ti[k] * M + r] = m * 4 + k; GLIST[(size_t)ti[k] * M + r] = ex[k] / sum;
                }
            }
        }
        if (BOTH(5)) GRID_BAR();
    }

    LAS int* tstart = (LAS int*)(lds + 140 * 1024); LAS int* ecnt = tstart + 40;
    if (IN(6) || IN(7)) {
        DECL_ALL
        __syncthreads();
        if (tid == 0) { int acc = 0; for (int e = 0; e < NE; ++e) { const int c = (int)__hip_atomic_load(&ctl[e], __ATOMIC_RELAXED, __HIP_MEMORY_SCOPE_AGENT); tstart[e] = acc; ecnt[e] = c; acc += (c + 255) / 256; } tstart[NE] = acc; }
        __syncthreads();
    }
    if (IN(6)) {
        DECL_ALL
        const int ntiles = tstart[NE];
        for (int it = bid; it < ntiles * 16; it += G) {
            const int t = it / 16, nc = it % 16;
            int e = 0;
            for (int q = 1; q < NE; ++q) if (tstart[q] <= t) e = q;
            const int mt = t - tstart[e], cnt = ecnt[e];
            const int* lst = LIST + (size_t)e * M; const float* b1 = b_mlp1 + (size_t)e * 2048;
            const bf16_t* B0 = W1T + (size_t)e * 2048 * DM;
            sgemm_item<2>(H2, DM, [=](int r) { const int rank = mt * 256 + r; return rank < cnt ? (lst[rank] >> 2) : 0; }, B0, B0 + (size_t)1024 * DM, DM, DM, 0, nc * 64,
                          [=](int r, int c, float v0, float v1) {
                              const float glu = fminf(v0 + b1[c], 7.0f), lin = fminf(fmaxf(v1 + b1[1024 + c], -7.0f), 7.0f);
                              const float a = glu / (1.0f + __expf(-1.702f * glu)) * (lin + 1.0f);
                              ACT[((size_t)t * 256 + r) * DFF + c] = (bf16_t)f2bf(a); }, wave, lane);
        }
        if (BOTH(6)) GRID_BAR();
    }
    if (IN(7)) {
        DECL_ALL
        const int ntiles = tstart[NE];
        for (int it = bid; it < ntiles * 16; it += G) {
            const int t = it / 16, nc = it % 16;
            int e = 0;
            for (int q = 1; q < NE; ++q) if (tstart[q] <= t) e = q;
            const int mt = t - tstart[e], cnt = ecnt[e];
            const int* lst = LIST + (size_t)e * M; const float* gl = GLIST + (size_t)e * M; const float* b2 = b_mlp2 + (size_t)e * DM;
            sgemm_item<1>(ACT + (size_t)t * 256 * DFF, DFF, [](int r) { return r; }, W2T + (size_t)e * DM * DFF, nullptr, DFF, DFF, 0, nc * 64,
                          [=](int r, int c, float v, float) {
                              const int rank = mt * 256 + r;
                              if (rank < cnt) { const int dest = lst[rank]; YB[(size_t)dest * DM + c] = (bf16_t)f2bf(gl[rank] * (v + b2[c])); } }, wave, lane);
        }
        if (BOTH(7)) GRID_BAR();
    }
    if (IN(8)) {
        DECL_ALL
        for (size_t i = (size_t)bid * NTHREADS + tid; i < (size_t)M * DM / 4; i += (size_t)G * NTHREADS) {
            const size_t tok = i / (DM / 4); const int c = (int)(i % (DM / 4)) * 4;
            f32x4 a = *(const f32x4*)(out + tok * DM + c);
#pragma unroll
            for (int k = 0; k < 4; ++k) {
                const u32x2 w = *(const u32x2*)(YB + (tok * 4 + k) * DM + c);
                a.x += bf2f(w.x & 0xffffu); a.y += bf2f(w.x >> 16); a.z += bf2f(w.y & 0xffffu); a.w += bf2f(w.y >> 16);
            }
            *(f32x4*)(out + tok * DM + c) = a;
        }
    }
#undef IN
#undef BOTH
}

extern "C" void kernel_launch(void* const* d_in, const int* in_sizes, int n_in, void* d_out, int out_size, void* d_ws, size_t ws_size, hipStream_t stream) {
    static int grid = 0;
    if (grid == 0) {
        if (n_in != 27 || out_size != M * DM || ws_size < WS_END) { fprintf(stderr, "kernel_launch: unexpected problem (n_in %d out %d ws %zu)\n", n_in, out_size, ws_size); grid = -1; return; }
        int dev = 0, cus = 0, per_cu = 0;
        hipGetDevice(&dev); hipDeviceGetAttribute(&cus, hipDeviceAttributeMultiprocessorCount, dev);
        if (hipFuncSetAttribute((const void*)mk_fwd, hipFuncAttributeMaxDynamicSharedMemorySize, LDS_BYTES) != hipSuccess) { fprintf(stderr, "kernel_launch: hipFuncSetAttribute failed\n"); grid = -1; return; }
        hipOccupancyMaxActiveBlocksPerMultiprocessor(&per_cu, (const void*)mk_fwd, NTHREADS, LDS_BYTES);
        (void)hipGetLastError();
        if (per_cu < 1) { fprintf(stderr, "kernel_launch: occupancy query says %d blocks per CU\n", per_cu); per_cu = 1; }
        grid = cus;
    }
    if (grid < 0) return;
    Args a{};
    for (int i = 0; i < 27; ++i) a.in[i] = d_in[i];
    a.out = (float*)d_out; a.ws = (unsigned char*)d_ws;
    constexpr int NPH = 9;
    if (MK_N_LAUNCHES == 1) {
        a.ph_lo = 0; a.ph_hi = NPH;
        void* kargs[] = {&a};
        hipError_t e = hipLaunchCooperativeKernel((const void*)mk_fwd, dim3(grid), dim3(NTHREADS), kargs, LDS_BYTES, stream);
        if (e != hipSuccess) fprintf(stderr, "cooperative launch failed: %s (grid %d)\n", hipGetErrorString(e), grid);
    } else {
        for (int p = 0; p < NPH; ++p) { a.ph_lo = p; a.ph_hi = p + 1; hipLaunchKernelGGL(mk_fwd, dim3(grid), dim3(NTHREADS), LDS_BYTES, stream, a); }
    }
}
```

```cpp
#include <hip/hip_runtime.h>
#include <hip/hip_cooperative_groups.h>
#include <cstdio>
#include <cstdint>
namespace cg = cooperative_groups;

#ifndef MK_N_LAUNCHES
#define MK_N_LAUNCHES 1
#endif

constexpr int BATCH = 16, SEQ = 2048, DM = 1024, M = BATCH * SEQ;
constexpr int NPROJ = 2304;
constexpr int MEML = 256, MM = BATCH * MEML;
constexpr int NE = 32, TOPK = 4, DFF = 1024;
constexpr int MAXTILES = (M * TOPK) / 256 + NE;
constexpr int NSLOT = MAXTILES * 256;
constexpr float EPS = 1e-6f;
constexpr float C2 = 0.125f * 1.4426950408889634f;
constexpr int NWAVES = 8, NTHREADS = 512;
constexpr int LDS_BYTES = 147456;

constexpr size_t MiB = 1u << 20;
constexpr size_t WS_CTL = 0;
constexpr size_t WS_WIN = 2 * MiB, WS_WO = 7 * MiB, WS_WKV = 9 * MiB, WS_CS = 10 * MiB, WS_LIST = 12 * MiB, WS_GLIST = 16 * MiB;
constexpr size_t WS_MEMN = 20 * MiB, WS_MEMK = 28 * MiB, WS_MEMV = 30 * MiB;
constexpr size_t WS_W1 = 32 * MiB, WS_W2 = 160 * MiB, WS_H2 = 224 * MiB, WS_ACT = 288 * MiB;
constexpr size_t WS_XN = 560 * MiB, WS_QB = 624 * MiB, WS_KB = 656 * MiB, WS_VB = 688 * MiB, WS_UB = 720 * MiB, WS_VGB = 736 * MiB, WS_MQB = 752 * MiB;
constexpr size_t WS_OT = 768 * MiB, WS_CAT = 832 * MiB, WS_END = 896 * MiB;
constexpr size_t WS_YB = 560 * MiB;
constexpr size_t WS_PROJ = 224 * MiB;
constexpr size_t WS_KVT = 512 * MiB;
static_assert(WS_ACT + (size_t)NSLOT * DFF * 2 <= WS_XN, "act");
static_assert(WS_PROJ + (size_t)M * NPROJ * 4 <= WS_KVT && WS_KVT + (size_t)MM * 512 * 4 <= WS_XN, "proj temp");

#define LAS __attribute__((address_space(3)))
typedef unsigned short bf16_t;
typedef short bf16x8 __attribute__((ext_vector_type(8)));
typedef float f32x4 __attribute__((ext_vector_type(4)));
typedef unsigned u32x4 __attribute__((ext_vector_type(4)));
typedef unsigned u32x2 __attribute__((ext_vector_type(2)));

__device__ __forceinline__ unsigned f2bf(float f) { unsigned u = __float_as_uint(f); return (u + 0x7fffu + ((u >> 16) & 1u)) >> 16; }
__device__ __forceinline__ float bf2f(unsigned h) { return __uint_as_float(h << 16); }
__device__ __forceinline__ unsigned pk2(float lo, float hi) { return f2bf(lo) | (f2bf(hi) << 16); }
__device__ __forceinline__ float wave_sum(float v) {
#pragma unroll
    for (int o = 1; o < 64; o <<= 1) v += __shfl_xor(v, o);
    return v;
}
__device__ __forceinline__ float gelu_tanh(float x) {
    const float y = 0.7978845608028654f * (x + 0.044715f * x * x * x);
    const float t = 1.f - 2.f / (1.f + __expf(2.f * y));
    return 0.5f * x * (1.f + t);
}

struct Args {
    const void* in[27]; float* out; unsigned char* ws; int ph_lo, ph_hi;
};

__device__ __forceinline__ void transpose_item(const float* W, int K, int N, bf16_t* WT, LAS float* scr, int item, int lane) {
    const int nblk = N / 32, kb = item / nblk, nb = item % nblk, k0 = 64 * kb, n0 = 32 * nb;
#pragma unroll 8
    for (int i = 0; i < 32; ++i) { const int kk = 2 * i + (lane >> 5); scr[kk * 33 + (lane & 31)] = W[(size_t)(k0 + kk) * N + n0 + (lane & 31)]; }
    asm volatile("s_waitcnt lgkmcnt(0)" ::: "memory");
    const int c = lane & 7;
#pragma unroll
    for (int j = 0; j < 4; ++j) { const int n = (lane >> 3) + 8 * j; const LAS float* s = scr + (8 * c) * 33 + n;
        u32x4 o; o.x = pk2(s[0 * 33], s[1 * 33]); o.y = pk2(s[2 * 33], s[3 * 33]); o.z = pk2(s[4 * 33], s[5 * 33]); o.w = pk2(s[6 * 33], s[7 * 33]);
        *(u32x4*)(WT + (size_t)(n0 + n) * K + k0 + 8 * c) = o; }
    asm volatile("s_waitcnt lgkmcnt(0)" ::: "memory");
}
__device__ __forceinline__ void rms_row_to_bf16(const float* xrow, const float* g, bf16_t* orow, int lane) {
    const f32x4* xr = (const f32x4*)xrow + lane; const f32x4* gr = (const f32x4*)g + lane;
    f32x4 v[4]; float s = 0.f;
#pragma unroll
    for (int j = 0; j < 4; ++j) { v[j] = xr[64 * j]; s += (v[j].x * v[j].x + v[j].y * v[j].y) + (v[j].z * v[j].z + v[j].w * v[j].w); }
    const float rstd = 1.0f / sqrtf(wave_sum(s) * (1.f / DM) + EPS);
    u32x2* o8 = (u32x2*)orow + lane;
#pragma unroll
    for (int j = 0; j < 4; ++j) { const f32x4 gg = gr[64 * j]; u32x2 w; w.x = pk2(v[j].x * rstd * gg.x, v[j].y * rstd * gg.y); w.y = pk2(v[j].z * rstd * gg.z, v[j].w * rstd * gg.w); o8[64 * j] = w; }
}

template <int NB, class RowFn, class Epi>
__device__ __forceinline__ void sgemm_item(const bf16_t* A, int lda, RowFn rowfn, const bf16_t* Bt0, const bf16_t* Bt1, int ldb, int K, int m0, int n0, Epi epi, int wave, int lane) {
    const int fr = lane & 15, fq = lane >> 4;
    unsigned aoff[2], boff[4];
#pragma unroll
    for (int mi = 0; mi < 2; ++mi) aoff[mi] = (unsigned)rowfn(m0 + 32 * wave + 16 * mi + fr) * (unsigned)lda + 8u * fq;
#pragma unroll
    for (int ni = 0; ni < 4; ++ni) boff[ni] = (unsigned)(n0 + 16 * ni + fr) * (unsigned)ldb + 8u * fq;
    f32x4 acc[NB][2][4];
#pragma unroll
    for (int b = 0; b < NB; ++b)
#pragma unroll
        for (int mi = 0; mi < 2; ++mi)
#pragma unroll
            for (int ni = 0; ni < 4; ++ni) acc[b][mi][ni] = (f32x4){0.f, 0.f, 0.f, 0.f};
#pragma unroll 2
    for (int k0 = 0; k0 < K; k0 += 32) {
        bf16x8 a[2], bb[NB][4];
#pragma unroll
        for (int mi = 0; mi < 2; ++mi) a[mi] = *(const bf16x8*)(A + k0 + aoff[mi]);
#pragma unroll
        for (int ni = 0; ni < 4; ++ni) { bb[0][ni] = *(const bf16x8*)(Bt0 + k0 + boff[ni]); if (NB == 2) bb[NB - 1][ni] = *(const bf16x8*)(Bt1 + k0 + boff[ni]); }
#pragma unroll
        for (int b = 0; b < NB; ++b)
#pragma unroll
            for (int mi = 0; mi < 2; ++mi)
#pragma unroll
                for (int ni = 0; ni < 4; ++ni) acc[b][mi][ni] = __builtin_amdgcn_mfma_f32_16x16x32_bf16(a[mi], bb[b][ni], acc[b][mi][ni], 0, 0, 0);
    }
#pragma unroll
    for (int mi = 0; mi < 2; ++mi)
#pragma unroll
        for (int ni = 0; ni < 4; ++ni)
#pragma unroll
            for (int j = 0; j < 4; ++j) epi(m0 + 32 * wave + 16 * mi + 4 * fq + j, n0 + 16 * ni + fr, acc[0][mi][ni][j], acc[NB - 1][mi][ni][j]);
}

template <int DV, bool CAUSAL>
__device__ __forceinline__ void sattn_wave(const bf16_t* Qw, int ldq, const bf16_t* Kp, int ldk, const bf16_t* Vp, int ldv, int nblk, int q0, LAS bf16_t* pl, f32x4 (&o)[DV / 16], int lane) {
    const int fr = lane & 15, fq = lane >> 4;
    bf16x8 qa[2];
#pragma unroll
    for (int ks = 0; ks < 2; ++ks) qa[ks] = *(const bf16x8*)(Qw + (size_t)fr * ldq + 32 * ks + 8 * fq);
    float mrow[4], lpart[4];
#pragma unroll
    for (int j = 0; j < 4; ++j) { mrow[j] = -1e30f; lpart[j] = 0.f; }
#pragma unroll
    for (int nt = 0; nt < DV / 16; ++nt) o[nt] = (f32x4){0.f, 0.f, 0.f, 0.f};
    for (int kb = 0; kb < nblk; ++kb) {
        f32x4 s[2];
#pragma unroll
        for (int nt = 0; nt < 2; ++nt) {
            s[nt] = (f32x4){0.f, 0.f, 0.f, 0.f};
            const bf16_t* kr = Kp + (size_t)(kb * 32 + 16 * nt + fr) * ldk + 8 * fq;
#pragma unroll
            for (int ks = 0; ks < 2; ++ks) { const bf16x8 kf = *(const bf16x8*)(kr + 32 * ks); s[nt] = __builtin_amdgcn_mfma_f32_16x16x32_bf16(qa[ks], kf, s[nt], 0, 0, 0); }
        }
        if (CAUSAL) {
#pragma unroll
            for (int nt = 0; nt < 2; ++nt)
#pragma unroll
                for (int j = 0; j < 4; ++j) if (kb * 32 + 16 * nt + fr > q0 + 4 * fq + j) s[nt][j] = -1e30f;
        }
        float alpha[4];
#pragma unroll
        for (int j = 0; j < 4; ++j) {
            float mx = fmaxf(s[0][j], s[1][j]);
            mx = fmaxf(mx, __shfl_xor(mx, 1)); mx = fmaxf(mx, __shfl_xor(mx, 2)); mx = fmaxf(mx, __shfl_xor(mx, 4)); mx = fmaxf(mx, __shfl_xor(mx, 8));
            const float mn = fmaxf(mrow[j], mx);
            alpha[j] = exp2f(mrow[j] - mn); mrow[j] = mn;
            const float p0 = exp2f(s[0][j] - mn), p1 = exp2f(s[1][j] - mn);
            lpart[j] = lpart[j] * alpha[j] + p0 + p1;
            pl[(4 * fq + j) * 40 + fr] = (bf16_t)f2bf(p0); pl[(4 * fq + j) * 40 + 16 + fr] = (bf16_t)f2bf(p1);
        }
#pragma unroll
        for (int nt = 0; nt < DV / 16; ++nt)
#pragma unroll
            for (int j = 0; j < 4; ++j) o[nt][j] *= alpha[j];
        asm volatile("s_waitcnt lgkmcnt(0)" ::: "memory");
        const bf16x8 pa = *(const LAS bf16x8*)(pl + fr * 40 + 8 * fq);
        asm volatile("s_waitcnt lgkmcnt(0)" ::: "memory");
#pragma unroll
        for (int nt = 0; nt < DV / 16; ++nt) {
            bf16x8 vf;
#pragma unroll
            for (int jj = 0; jj < 8; ++jj) vf[jj] = (short)Vp[(size_t)(kb * 32 + 8 * fq + jj) * ldv + 16 * nt + fr];
            o[nt] = __builtin_amdgcn_mfma_f32_16x16x32_bf16(pa, vf, o[nt], 0, 0, 0);
        }
    }
#pragma unroll
    for (int j = 0; j < 4; ++j) {
        float l = lpart[j];
        l += __shfl_xor(l, 1); l += __shfl_xor(l, 2); l += __shfl_xor(l, 4); l += __shfl_xor(l, 8);
        const float rl = 1.0f / l;
#pragma unroll
        for (int nt = 0; nt < DV / 16; ++nt) o[nt][j] *= rl;
    }
}

__global__ void __launch_bounds__(NTHREADS, 2) mk_fwd(Args args) {
    extern __shared__ __attribute__((aligned(16))) unsigned char lds_raw[];
    LAS unsigned char* lds = (LAS unsigned char*)lds_raw;
    const int tid = threadIdx.x, lane = tid & 63, wave = __builtin_amdgcn_readfirstlane(tid >> 6);
    const int G = gridDim.x, bid = blockIdx.x;
    const int gw = bid * NWAVES + wave, NGW = G * NWAVES;
#define DECL_ALL \
    unsigned char* ws = args.ws; \
    const float* x = (const float*)args.in[0]; const float* mem = (const float*)args.in[1]; const int* positions = (const int*)args.in[2]; \
    const float* g_mix = (const float*)args.in[3]; const float* w_in = (const float*)args.in[4]; \
    const float* g_dq = (const float*)args.in[5]; const float* g_dk = (const float*)args.in[6]; \
    const float* lq1 = (const float*)args.in[7]; const float* lk1 = (const float*)args.in[8]; const float* lq2 = (const float*)args.in[9]; const float* lk2 = (const float*)args.in[10]; \
    const float* g_sub = (const float*)args.in[11]; const float* g_sgu = (const float*)args.in[12]; \
    const float* w_sp = (const float*)args.in[13]; const float* b_sp = (const float*)args.in[14]; \
    const float* g_memn = (const float*)args.in[15]; const float* w_kv = (const float*)args.in[16]; \
    const float* g_cq = (const float*)args.in[17]; const float* g_ck = (const float*)args.in[18]; \
    const float* w_out = (const float*)args.in[19]; const float* g_ffn = (const float*)args.in[20]; \
    const float* w_router = (const float*)args.in[21]; const float* b_router = (const float*)args.in[22]; \
    const float* w_mlp1 = (const float*)args.in[23]; const float* b_mlp1 = (const float*)args.in[24]; \
    const float* w_mlp2 = (const float*)args.in[25]; const float* b_mlp2 = (const float*)args.in[26]; \
    float* out = args.out; \
    unsigned* ctl = (unsigned*)(ws + WS_CTL); \
    bf16_t* WIN_T = (bf16_t*)(ws + WS_WIN); bf16_t* WO_T = (bf16_t*)(ws + WS_WO); bf16_t* WKV_T = (bf16_t*)(ws + WS_WKV); \
    float* CS = (float*)(ws + WS_CS); int* LIST = (int*)(ws + WS_LIST); float* GLIST = (float*)(ws + WS_GLIST); \
    bf16_t* MEMN = (bf16_t*)(ws + WS_MEMN); bf16_t* MEMK = (bf16_t*)(ws + WS_MEMK); bf16_t* MEMV = (bf16_t*)(ws + WS_MEMV); \
    bf16_t* W1T = (bf16_t*)(ws + WS_W1); bf16_t* W2T = (bf16_t*)(ws + WS_W2); bf16_t* H2 = (bf16_t*)(ws + WS_H2); bf16_t* ACT = (bf16_t*)(ws + WS_ACT); \
    bf16_t* XN = (bf16_t*)(ws + WS_XN); bf16_t* QB = (bf16_t*)(ws + WS_QB); bf16_t* KB = (bf16_t*)(ws + WS_KB); bf16_t* VB = (bf16_t*)(ws + WS_VB); \
    bf16_t* UB = (bf16_t*)(ws + WS_UB); bf16_t* VGB = (bf16_t*)(ws + WS_VGB); bf16_t* MQB = (bf16_t*)(ws + WS_MQB); \
    bf16_t* CAT = (bf16_t*)(ws + WS_CAT); bf16_t* YB = (bf16_t*)(ws + WS_YB); \
    float* PROJ = (float*)(ws + WS_PROJ); float* KVT = (float*)(ws + WS_KVT); \
    (void)x; (void)mem; (void)positions; (void)g_mix; (void)w_in; (void)g_dq; (void)g_dk; (void)lq1; (void)lk1; (void)lq2; (void)lk2; (void)g_sub; (void)g_sgu; (void)w_sp; (void)b_sp; \
    (void)g_memn; (void)w_kv; (void)g_cq; (void)g_ck; (void)w_out; (void)g_ffn; (void)w_router; (void)b_router; (void)w_mlp1; (void)b_mlp1; (void)w_mlp2; (void)b_mlp2; (void)out; (void)ctl; \
    (void)WIN_T; (void)WO_T; (void)WKV_T; (void)CS; (void)LIST; (void)GLIST; (void)MEMN; (void)MEMK; (void)MEMV; (void)W1T; (void)W2T; (void)H2; (void)ACT; (void)XN; (void)QB; (void)KB; (void)VB; \
    (void)UB; (void)VGB; (void)MQB; (void)CAT; (void)YB; (void)PROJ; (void)KVT;

    const int lo = args.ph_lo, hi = args.ph_hi;
#ifndef PHMASK
#define PHMASK 0x1ff
#endif
#define IN(k) (((PHMASK >> (k)) & 1) && lo <= (k) && (k) < hi)
#define BOTH(k) (IN(k) && IN((k) + 1))
#define GRID_BAR() do { __threadfence(); cg::this_grid().sync(); } while (0)

    if (IN(0)) {
        DECL_ALL
        LAS float* scr = (LAS float*)(lds + wave * 16384);
        constexpr int I_IN = 16 * (NPROJ / 32), I_O = 16 * 32, I_KV = 16 * 16, I_1 = 16 * 64, I_2 = 16 * 32;
        constexpr int NITEMS = I_IN + I_O + I_KV + NE * I_1 + NE * I_2;
        for (int it = gw; it < NITEMS; it += NGW) {
            int r = it;
            if (r < I_IN) { transpose_item(w_in, DM, NPROJ, WIN_T, scr, r, lane); continue; } r -= I_IN;
            if (r < I_O) { transpose_item(w_out, DM, DM, WO_T, scr, r, lane); continue; } r -= I_O;
            if (r < I_KV) { transpose_item(w_kv, DM, 512, WKV_T, scr, r, lane); continue; } r -= I_KV;
            if (r < NE * I_1) { const int e = r / I_1; transpose_item(w_mlp1 + (size_t)e * DM * 2048, DM, 2048, W1T + (size_t)e * 2048 * DM, scr, r % I_1, lane); continue; } r -= NE * I_1;
            { const int e = r / I_2; transpose_item(w_mlp2 + (size_t)e * DFF * DM, DFF, DM, W2T + (size_t)e * DM * DFF, scr, r % I_2, lane); }
        }
        for (int m = gw; m < M; m += NGW) rms_row_to_bf16(x + (size_t)m * DM, g_mix, XN + (size_t)m * DM, lane);
        for (int m = gw; m < MM; m += NGW) rms_row_to_bf16(mem + (size_t)m * DM, g_memn, MEMN + (size_t)m * DM, lane);
        for (int i = bid * NTHREADS + tid; i < M * 8; i += G * NTHREADS) {
            const int tok = i >> 3, f = i & 7;
            const float inv = (float)exp2(-(double)f * 0.125 * 18.931568569324174);
            const float ang = (float)positions[tok] * inv;
            CS[(size_t)tok * 16 + f] = (float)cos((double)ang); CS[(size_t)tok * 16 + 8 + f] = (float)sin((double)ang);
        }
        if (bid == 0 && tid < 64) ctl[tid] = 0u;
        if (BOTH(0)) GRID_BAR();
    }

    if (IN(1)) {
        DECL_ALL
        constexpr int N1 = (M / 256) * (NPROJ / 64), N2 = (MM / 256) * (512 / 64);
        for (int it = bid; it < N1 + N2; it += G) {
            if (it < N1) {
                const int mt = it / (NPROJ / 64), nc = it % (NPROJ / 64);
                sgemm_item<1>(XN, DM, [](int r) { return r; }, WIN_T, WIN_T, DM, DM, mt * 256, nc * 64,
                              [=](int r, int c, float v, float) { PROJ[(size_t)r * NPROJ + c] = v; }, wave, lane);
            } else {
                const int j = it - N1, mt = j / 8, nc = j % 8;
                sgemm_item<1>(MEMN, DM, [](int r) { return r; }, WKV_T, WKV_T, DM, DM, mt * 256, nc * 64,
                              [=](int r, int c, float v, float) { KVT[(size_t)r * 512 + c] = v; }, wave, lane);
            }
        }
        if (BOTH(1)) GRID_BAR();
    }

    if (IN(2)) {
        DECL_ALL
        for (int m = gw; m < M; m += NGW) {
            const float* pr = PROJ + (size_t)m * NPROJ;
            const int i8 = lane & 7; const float cc = CS[(size_t)m * 16 + i8], sn = CS[(size_t)m * 16 + 8 + i8];
            for (int g = 0; g < 16; ++g) {
                const float v = pr[g * 64 + lane];
                const float rstd = 1.0f / sqrtf(wave_sum(v * v) * (1.f / 64) + EPS);
                float y = v * rstd * (g < 8 ? g_dq[lane] : g_dk[lane]);
                const float partner = __shfl_xor(y, 8);
                if (lane < 8) y = y * cc - partner * sn; else if (lane < 16) y = y * cc + partner * sn;
                if (g < 8) QB[(size_t)m * 512 + g * 64 + lane] = (bf16_t)f2bf(y * C2); else KB[(size_t)m * 512 + (g - 8) * 64 + lane] = (bf16_t)f2bf(y);
            }
            for (int j = 0; j < 8; ++j) VB[(size_t)m * 512 + j * 64 + lane] = (bf16_t)f2bf(pr[1024 + j * 64 + lane]);
            for (int j = 0; j < 4; ++j) UB[(size_t)m * 256 + j * 64 + lane] = (bf16_t)f2bf(gelu_tanh(pr[1536 + j * 64 + lane]));
            for (int j = 0; j < 4; ++j) VGB[(size_t)m * 256 + j * 64 + lane] = (bf16_t)f2bf(gelu_tanh(pr[1792 + j * 64 + lane]));
            for (int g = 0; g < 4; ++g) {
                const float v = pr[2048 + g * 64 + lane];
                const float rstd = 1.0f / sqrtf(wave_sum(v * v) * (1.f / 64) + EPS);
                MQB[(size_t)m * 256 + g * 64 + lane] = (bf16_t)f2bf(v * rstd * g_cq[lane] * C2);
            }
        }
        for (int m = gw; m < MM; m += NGW) {
            const float* pr = KVT + (size_t)m * 512;
            for (int g = 0; g < 4; ++g) {
                const float v = pr[g * 64 + lane];
                const float rstd = 1.0f / sqrtf(wave_sum(v * v) * (1.f / 64) + EPS);
                MEMK[(size_t)m * 256 + g * 64 + lane] = (bf16_t)f2bf(v * rstd * g_ck[lane]);
                MEMV[(size_t)m * 256 + g * 64 + lane] = (bf16_t)f2bf(pr[256 + g * 64 + lane]);
            }
        }
        if (BOTH(2)) GRID_BAR();
    }

    if (IN(3)) {
        DECL_ALL
        LAS bf16_t* pl = (LAS bf16_t*)(lds + wave * 2048);
        const float lam = __expf(wave_sum(lq1[lane] * lk1[lane])) - __expf(wave_sum(lq2[lane] * lk2[lane])) + 0.2f;
        const int fr = lane & 15, fq = lane >> 4;
        for (int it = bid; it < BATCH * 4 * 16; it += G) {
            const int b = it / 64, h = (it / 16) & 3, qb = it & 15;
            const int q0 = qb * 128 + wave * 16; const size_t rb = (size_t)b * SEQ;
            f32x4 o1[8], o2[8];
            sattn_wave<128, true>(QB + (rb + q0) * 512 + (h * 2 + 0) * 64, 512, KB + rb * 512 + (h * 2 + 0) * 64, 512, VB + rb * 512 + h * 128, 512, (q0 + 16 + 31) / 32, q0, pl, o1, lane);
            sattn_wave<128, true>(QB + (rb + q0) * 512 + (h * 2 + 1) * 64, 512, KB + rb * 512 + (h * 2 + 1) * 64, 512, VB + rb * 512 + h * 128, 512, (q0 + 16 + 31) / 32, q0, pl, o2, lane);
#pragma unroll
            for (int j = 0; j < 4; ++j) {
                float ss = 0.f;
#pragma unroll
                for (int nt = 0; nt < 8; ++nt) { o1[nt][j] -= lam * o2[nt][j]; ss += o1[nt][j] * o1[nt][j]; }
                ss += __shfl_xor(ss, 1); ss += __shfl_xor(ss, 2); ss += __shfl_xor(ss, 4); ss += __shfl_xor(ss, 8);
                const float rstd = 0.8f / sqrtf(ss * (1.f / 128) + EPS);
#pragma unroll
                for (int nt = 0; nt < 8; ++nt) CAT[(rb + q0 + 4 * fq + j) * 1024 + h * 128 + 16 * nt + fr] = (bf16_t)f2bf(o1[nt][j] * rstd * g_sub[16 * nt + fr]);
            }
        }
        for (int it = bid; it < BATCH * 4 * 16; it += G) {
            const int b = it / 64, h = (it / 16) & 3, qb = it & 15;
            const int q0 = qb * 128 + wave * 16; const size_t rb = (size_t)b * SEQ;
            f32x4 oc[4];
            sattn_wave<64, false>(MQB + (rb + q0) * 256 + h * 64, 256, MEMK + (size_t)b * MEML * 256 + h * 64, 256, MEMV + (size_t)b * MEML * 256 + h * 64, 256, MEML / 32, q0, pl, oc, lane);
#pragma unroll
            for (int j = 0; j < 4; ++j)
#pragma unroll
                for (int nt = 0; nt < 4; ++nt) CAT[(rb + q0 + 4 * fq + j) * 1024 + 768 + h * 64 + 16 * nt + fr] = (bf16_t)f2bf(oc[nt][j]);
        }
        __syncthreads();
        LAS float* vt = (LAS float*)lds;
        for (int it = bid; it < BATCH * 16; it += G) {
            const size_t r0 = (size_t)it * 128;
            for (int rr = wave; rr < 128; rr += NWAVES) {
                const u32x2 w = *(const u32x2*)(VGB + (r0 + rr) * 256 + 4 * lane);
                const float v0 = bf2f(w.x & 0xffffu), v1 = bf2f(w.x >> 16), v2 = bf2f(w.y & 0xffffu), v3 = bf2f(w.y >> 16);
                const float mean = wave_sum((v0 + v1) + (v2 + v3)) * (1.f / 256);
                const float d0 = v0 - mean, d1 = v1 - mean, d2 = v2 - mean, d3 = v3 - mean;
                const float rstd = 1.0f / sqrtf(wave_sum((d0 * d0 + d1 * d1) + (d2 * d2 + d3 * d3)) * (1.f / 256) + EPS);
                const f32x4 gg = *(const f32x4*)(g_sgu + 4 * lane);
                *(LAS f32x4*)(vt + rr * 256 + 4 * lane) = (f32x4){d0 * rstd * gg.x, d1 * rstd * gg.y, d2 * rstd * gg.z, d3 * rstd * gg.w};
            }
            __syncthreads();
            const int ch = tid & 255, g = ch >> 6;
            for (int i = 0; i < 64; ++i) {
                const int t = 2 * i + (tid >> 8);
                const float* wr = w_sp + ((size_t)g * 128 + t) * 128;
                float acc = 0.f;
                for (int s = 0; s <= t; ++s) acc += wr[s] * vt[s * 256 + ch];
                const float u = bf2f(UB[(r0 + t) * 256 + ch]);
                CAT[(r0 + t) * 1024 + 512 + ch] = (bf16_t)f2bf(u * (acc + b_sp[g * 128 + t]));
            }
            __syncthreads();
        }
        if (BOTH(3)) GRID_BAR();
    }

    if (IN(4)) {
        DECL_ALL
        for (int it = bid; it < (M / 256) * (DM / 64); it += G) {
            const int mt = it / 16, nc = it % 16;
            sgemm_item<1>(CAT, DM, [](int r) { return r; }, WO_T, WO_T, DM, DM, mt * 256, nc * 64,
                          [=](int r, int c, float v, float) { out[(size_t)r * DM + c] = x[(size_t)r * DM + c] + v; }, wave, lane);
        }
        if (BOTH(4)) GRID_BAR();
    }

    if (IN(5)) {
        DECL_ALL
        for (int m = gw; m < M; m += NGW) {
            const f32x4* xr = (const f32x4*)(out + (size_t)m * DM) + 4 * lane; const f32x4* gr = (const f32x4*)g_ffn + 4 * lane;
            f32x4 v[4]; float s = 0.f;
#pragma unroll
            for (int j = 0; j < 4; ++j) { v[j] = xr[j]; s += (v[j].x * v[j].x + v[j].y * v[j].y) + (v[j].z * v[j].z + v[j].w * v[j].w); }
            const float rstd = 1.0f / sqrtf(wave_sum(s) * (1.f / DM) + EPS);
            u32x2* o8 = (u32x2*)(H2 + (size_t)m * DM) + 4 * lane;
#pragma unroll
            for (int j = 0; j < 4; ++j) { const f32x4 gg = gr[j]; v[j].x *= rstd * gg.x; v[j].y *= rstd * gg.y; v[j].z *= rstd * gg.z; v[j].w *= rstd * gg.w;
                u32x2 w; w.x = pk2(v[j].x, v[j].y); w.y = pk2(v[j].z, v[j].w); o8[j] = w; }
            const f32x4* wr = (const f32x4*)(w_router + (size_t)lane * 16 * 32);
            LAS float* scr = (LAS float*)(lds + wave * 12800);
            LAS float* hs = scr + 2112 + lane * 17;
#pragma unroll
            for (int j = 0; j < 4; ++j)
#pragma unroll
                for (int i = 0; i < 4; ++i) hs[4 * j + i] = v[j][i];
            asm volatile("s_waitcnt lgkmcnt(0)" ::: "memory");
            float lg[32];
#pragma unroll
            for (int e = 0; e < 32; ++e) lg[e] = 0.f;
#pragma unroll 1
            for (int c = 0; c < 16; ++c) {
                const float hv = hs[c];
#pragma unroll
                for (int e4 = 0; e4 < 8; ++e4) { const f32x4 w = wr[c * 8 + e4]; lg[4 * e4] += hv * w.x; lg[4 * e4 + 1] += hv * w.y; lg[4 * e4 + 2] += hv * w.z; lg[4 * e4 + 3] += hv * w.w; }
            }
#pragma unroll
            for (int e = 0; e < 32; ++e) scr[e * 65 + lane] = lg[e];
            asm volatile("s_waitcnt lgkmcnt(0)" ::: "memory");
            const int e_me = lane & 31, half = lane >> 5;
            float tot = 0.f;
#pragma unroll
            for (int i = 0; i < 32; ++i) tot += scr[e_me * 65 + half * 32 + i];
            asm volatile("s_waitcnt lgkmcnt(0)" ::: "memory");
            tot += __shfl_xor(tot, 32);
            float myv = tot + b_router[e_me];
            float tv[4]; int ti[4];
#pragma unroll
            for (int k = 0; k < 4; ++k) {
                float bv = myv; int bi = e_me;
#pragma unroll
                for (int o = 1; o < 32; o <<= 1) { const float ov = __shfl_xor(bv, o); const int oi = __shfl_xor(bi, o); const bool take = (ov > bv) || (ov == bv && oi < bi); bv = take ? ov : bv; bi = take ? oi : bi; }
                tv[k] = bv; ti[k] = bi;
                if (e_me == bi) myv = -3.0e38f;
            }
            float ex[4], sum = 0.f;
#pragma unroll
            for (int k = 0; k < 4; ++k) { ex[k] = __expf(tv[k] - tv[0]); sum += ex[k]; }
            if (lane == 0) {
#pragma unroll
                for (int k = 0; k < 4; ++k) {
                    const unsigned r = atomicAdd(&ctl[ti[k]], 1u);
                    LIST[(size_t)ti[k] * M + r] = m * 4 + k; GLIST[(size_t)ti[k] * M + r] = ex[k] / sum;
                }
            }
        }
        if (BOTH(5)) GRID_BAR();
    }

    LAS int* tstart = (LAS int*)(lds + 140 * 1024); LAS int* ecnt = tstart + 40;
    if (IN(6) || IN(7)) {
        DECL_ALL
        __syncthreads();
        if (tid == 0) { int acc = 0; for (int e = 0; e < NE; ++e) { const int c = (int)__hip_atomic_load(&ctl[e], __ATOMIC_RELAXED, __HIP_MEMORY_SCOPE_AGENT); tstart[e] = acc; ecnt[e] = c; acc += (c + 255) / 256; } tstart[NE] = acc; }
        __syncthreads();
    }
    if (IN(6)) {
        DECL_ALL
        const int ntiles = tstart[NE];
        for (int it = bid; it < ntiles * 16; it += G) {
            const int t = it / 16, nc = it % 16;
            int e = 0;
            for (int q = 1; q < NE; ++q) if (tstart[q] <= t) e = q;
            const int mt = t - tstart[e], cnt = ecnt[e];
            const int* lst = LIST + (size_t)e * M; const float* b1 = b_mlp1 + (size_t)e * 2048;
            const bf16_t* B0 = W1T + (size_t)e * 2048 * DM;
            sgemm_item<2>(H2, DM, [=](int r) { const int rank = mt * 256 + r; return rank < cnt ? (lst[rank] >> 2) : 0; }, B0, B0 + (size_t)1024 * DM, DM, DM, 0, nc * 64,
                          [=](int r, int c, float v0, float v1) {
                              const float glu = fminf(v0 + b1[c], 7.0f), lin = fminf(fmaxf(v1 + b1[1024 + c], -7.0f), 7.0f);
                              const float a = glu / (1.0f + __expf(-1.702f * glu)) * (lin + 1.0f);
                              ACT[((size_t)t * 256 + r) * DFF + c] = (bf16_t)f2bf(a); }, wave, lane);
        }
        if (BOTH(6)) GRID_BAR();
    }
    if (IN(7)) {
        DECL_ALL
        const int ntiles = tstart[NE];
        for (int it = bid; it < ntiles * 16; it += G) {
            const int t = it / 16, nc = it % 16;
            int e = 0;
            for (int q = 1; q < NE; ++q) if (tstart[q] <= t) e = q;
            const int mt = t - tstart[e], cnt = ecnt[e];
            const int* lst = LIST + (size_t)e * M; const float* gl = GLIST + (size_t)e * M; const float* b2 = b_mlp2 + (size_t)e * DM;
            sgemm_item<1>(ACT + (size_t)t * 256 * DFF, DFF, [](int r) { return r; }, W2T + (size_t)e * DM * DFF, nullptr, DFF, DFF, 0, nc * 64,
                          [=](int r, int c, float v, float) {
                              const int rank = mt * 256 + r;
                              if (rank < cnt) { const int dest = lst[rank]; YB[(size_t)dest * DM + c] = (bf16_t)f2bf(gl[rank] * (v + b2[c])); } }, wave, lane);
        }
        if (BOTH(7)) GRID_BAR();
    }
    if (IN(8)) {
        DECL_ALL
        for (size_t i = (size_t)bid * NTHREADS + tid; i < (size_t)M * DM / 4; i += (size_t)G * NTHREADS) {
            const size_t tok = i / (DM / 4); const int c = (int)(i % (DM / 4)) * 4;
            f32x4 a = *(const f32x4*)(out + tok * DM + c);
#pragma unroll
            for (int k = 0; k < 4; ++k) {
                const u32x2 w = *(const u32x2*)(YB + (tok * 4 + k) * DM + c);
                a.x += bf2f(w.x & 0xffffu); a.y += bf2f(w.x >> 16); a.z += bf2f(w.y & 0xffffu); a.w += bf2f(w.y >> 16);
            }
            *(f32x4*)(out + tok * DM + c) = a;
        }
    }
#undef IN
#undef BOTH
}

extern "C" void kernel_launch(void* const* d_in, const int* in_sizes, int n_in, void* d_out, int out_size, void* d_ws, size_t ws_size, hipStream_t stream) {
    static int grid = 0;
    if (grid == 0) {
        if (n_in != 27 || out_size != M * DM || ws_size < WS_END) { fprintf(stderr, "kernel_launch: unexpected problem (n_in %d out %d ws %zu)\n", n_in, out_size, ws_size); grid = -1; return; }
        int dev = 0, cus = 0, per_cu = 0;
        hipGetDevice(&dev); hipDeviceGetAttribute(&cus, hipDeviceAttributeMultiprocessorCount, dev);
        if (hipFuncSetAttribute((const void*)mk_fwd, hipFuncAttributeMaxDynamicSharedMemorySize, LDS_BYTES) != hipSuccess) { fprintf(stderr, "kernel_launch: hipFuncSetAttribute failed\n"); grid = -1; return; }
        hipOccupancyMaxActiveBlocksPerMultiprocessor(&per_cu, (const void*)mk_fwd, NTHREADS, LDS_BYTES);
        (void)hipGetLastError();
        if (per_cu < 1) { fprintf(stderr, "kernel_launch: occupancy query says %d blocks per CU\n", per_cu); per_cu = 1; }
        grid = cus;
    }
    if (grid < 0) return;
    Args a{};
    for (int i = 0; i < 27; ++i) a.in[i] = d_in[i];
    a.out = (float*)d_out; a.ws = (unsigned char*)d_ws;
    constexpr int NPH = 9;
    if (MK_N_LAUNCHES == 1) {
        a.ph_lo = 0; a.ph_hi = NPH;
        void* kargs[] = {&a};
        hipError_t e = hipLaunchCooperativeKernel((const void*)mk_fwd, dim3(grid), dim3(NTHREADS), kargs, LDS_BYTES, stream);
        if (e != hipSuccess) fprintf(stderr, "cooperative launch failed: %s (grid %d)\n", hipGetErrorString(e), grid);
    } else {
        for (int p = 0; p < NPH; ++p) { a.ph_lo = p; a.ph_hi = p + 1; hipLaunchKernelGGL(mk_fwd, dim3(grid), dim3(NTHREADS), LDS_BYTES, stream, a); }
    }
}
```

```cpp
#include <hip/hip_runtime.h>
#include <hip/hip_cooperative_groups.h>
#include <cstdio>
#include <cstdint>
namespace cg = cooperative_groups;

#ifndef MK_N_LAUNCHES
#define MK_N_LAUNCHES 1
#endif

constexpr int BATCH = 16, SEQ = 2048, DM = 1024, M = BATCH * SEQ;
constexpr int NPROJ = 2304;
constexpr int MEML = 256, MM = BATCH * MEML;
constexpr int NE = 32, TOPK = 4, DFF = 1024;
constexpr int MAXTILES = (M * TOPK) / 256 + NE;
constexpr int NSLOT = MAXTILES * 256;
constexpr float EPS = 1e-6f;
constexpr float C2 = 0.125f * 1.4426950408889634f;
constexpr int NWAVES = 8, NTHREADS = 512;
constexpr int LDS_BYTES = 147456;

constexpr size_t MiB = 1u << 20;
constexpr size_t WS_CTL = 0;
constexpr size_t WS_WIN = 2 * MiB, WS_WO = 7 * MiB, WS_WKV = 9 * MiB, WS_CS = 10 * MiB, WS_LIST = 12 * MiB, WS_GLIST = 16 * MiB;
constexpr size_t WS_MEMN = 20 * MiB, WS_MEMK = 28 * MiB, WS_MEMV = 30 * MiB;
constexpr size_t WS_W1 = 32 * MiB, WS_W2 = 160 * MiB, WS_H2 = 224 * MiB, WS_ACT = 288 * MiB;
constexpr size_t WS_XN = 560 * MiB, WS_QB = 624 * MiB, WS_KB = 656 * MiB, WS_VB = 688 * MiB, WS_UB = 720 * MiB, WS_VGB = 736 * MiB, WS_MQB = 752 * MiB;
constexpr size_t WS_OT = 768 * MiB, WS_CAT = 832 * MiB, WS_END = 896 * MiB;
constexpr size_t WS_YB = 560 * MiB;
constexpr size_t WS_PROJ = 224 * MiB;
constexpr size_t WS_KVT = 512 * MiB;
static_assert(WS_ACT + (size_t)NSLOT * DFF * 2 <= WS_XN, "act");
static_assert(WS_PROJ + (size_t)M * NPROJ * 4 <= WS_KVT && WS_KVT + (size_t)MM * 512 * 4 <= WS_XN, "proj temp");

#define LAS __attribute__((address_space(3)))
typedef unsigned short bf16_t;
typedef short bf16x8 __attribute__((ext_vector_type(8)));
typedef float f32x4 __attribute__((ext_vector_type(4)));
typedef unsigned u32x4 __attribute__((ext_vector_type(4)));
typedef unsigned u32x2 __attribute__((ext_vector_type(2)));

__device__ __forceinline__ unsigned f2bf(float f) { unsigned u = __float_as_uint(f); return (u + 0x7fffu + ((u >> 16) & 1u)) >> 16; }
__device__ __forceinline__ float bf2f(unsigned h) { return __uint_as_float(h << 16); }
__device__ __forceinline__ unsigned pk2(float lo, float hi) { return f2bf(lo) | (f2bf(hi) << 16); }
__device__ __forceinline__ float wave_sum(float v) {
#pragma unroll
    for (int o = 1; o < 64; o <<= 1) v += __shfl_xor(v, o);
    return v;
}
__device__ __forceinline__ float gelu_tanh(float x) {
    const float y = 0.7978845608028654f * (x + 0.044715f * x * x * x);
    const float t = 1.f - 2.f / (1.f + __expf(2.f * y));
    return 0.5f * x * (1.f + t);
}

struct Args {
    const void* in[27]; float* out; unsigned char* ws; int ph_lo, ph_hi;
};

template <class RowMap>
__device__ __forceinline__ void transpose_item_p(const float* W, int K, int N, bf16_t* WT, LAS float* scr, int item, int lane, RowMap rm) {
    const int nblk = N / 32, kb = item / nblk, nb = item % nblk, k0 = 64 * kb, n0 = 32 * nb;
#pragma unroll 8
    for (int i = 0; i < 32; ++i) { const int kk = 2 * i + (lane >> 5); scr[kk * 33 + (lane & 31)] = W[(size_t)(k0 + kk) * N + n0 + (lane & 31)]; }
    asm volatile("s_waitcnt lgkmcnt(0)" ::: "memory");
    const int c = lane & 7;
#pragma unroll
    for (int j = 0; j < 4; ++j) { const int n = (lane >> 3) + 8 * j; const LAS float* s = scr + (8 * c) * 33 + n;
        u32x4 o; o.x = pk2(s[0 * 33], s[1 * 33]); o.y = pk2(s[2 * 33], s[3 * 33]); o.z = pk2(s[4 * 33], s[5 * 33]); o.w = pk2(s[6 * 33], s[7 * 33]);
        *(u32x4*)(WT + (size_t)rm(n0 + n) * K + k0 + 8 * c) = o; }
    asm volatile("s_waitcnt lgkmcnt(0)" ::: "memory");
}
__device__ __forceinline__ void transpose_item(const float* W, int K, int N, bf16_t* WT, LAS float* scr, int item, int lane) {
    const int nblk = N / 32, kb = item / nblk, nb = item % nblk, k0 = 64 * kb, n0 = 32 * nb;
#pragma unroll 8
    for (int i = 0; i < 32; ++i) { const int kk = 2 * i + (lane >> 5); scr[kk * 33 + (lane & 31)] = W[(size_t)(k0 + kk) * N + n0 + (lane & 31)]; }
    asm volatile("s_waitcnt lgkmcnt(0)" ::: "memory");
    const int c = lane & 7;
#pragma unroll
    for (int j = 0; j < 4; ++j) { const int n = (lane >> 3) + 8 * j; const LAS float* s = scr + (8 * c) * 33 + n;
        u32x4 o; o.x = pk2(s[0 * 33], s[1 * 33]); o.y = pk2(s[2 * 33], s[3 * 33]); o.z = pk2(s[4 * 33], s[5 * 33]); o.w = pk2(s[6 * 33], s[7 * 33]);
        *(u32x4*)(WT + (size_t)(n0 + n) * K + k0 + 8 * c) = o; }
    asm volatile("s_waitcnt lgkmcnt(0)" ::: "memory");
}
__device__ __forceinline__ void rms_row_to_bf16(const float* xrow, const float* g, bf16_t* orow, int lane) {
    const f32x4* xr = (const f32x4*)xrow + lane; const f32x4* gr = (const f32x4*)g + lane;
    f32x4 v[4]; float s = 0.f;
#pragma unroll
    for (int j = 0; j < 4; ++j) { v[j] = xr[64 * j]; s += (v[j].x * v[j].x + v[j].y * v[j].y) + (v[j].z * v[j].z + v[j].w * v[j].w); }
    const float rstd = 1.0f / sqrtf(wave_sum(s) * (1.f / DM) + EPS);
    u32x2* o8 = (u32x2*)orow + lane;
#pragma unroll
    for (int j = 0; j < 4; ++j) { const f32x4 gg = gr[64 * j]; u32x2 w; w.x = pk2(v[j].x * rstd * gg.x, v[j].y * rstd * gg.y); w.y = pk2(v[j].z * rstd * gg.z, v[j].w * rstd * gg.w); o8[64 * j] = w; }
}

template <int NB, class RowFn, class Epi>
__device__ __forceinline__ void sgemm_item(const bf16_t* A, int lda, RowFn rowfn, const bf16_t* Bt0, const bf16_t* Bt1, int ldb, int K, int m0, int n0, Epi epi, int wave, int lane) {
    const int fr = lane & 15, fq = lane >> 4;
    unsigned aoff[2], boff[4];
#pragma unroll
    for (int mi = 0; mi < 2; ++mi) aoff[mi] = (unsigned)rowfn(m0 + 32 * wave + 16 * mi + fr) * (unsigned)lda + 8u * fq;
#pragma unroll
    for (int ni = 0; ni < 4; ++ni) boff[ni] = (unsigned)(n0 + 16 * ni + fr) * (unsigned)ldb + 8u * fq;
    f32x4 acc[NB][2][4];
#pragma unroll
    for (int b = 0; b < NB; ++b)
#pragma unroll
        for (int mi = 0; mi < 2; ++mi)
#pragma unroll
            for (int ni = 0; ni < 4; ++ni) acc[b][mi][ni] = (f32x4){0.f, 0.f, 0.f, 0.f};
#pragma unroll 2
    for (int k0 = 0; k0 < K; k0 += 32) {
        bf16x8 a[2], bb[NB][4];
#pragma unroll
        for (int mi = 0; mi < 2; ++mi) a[mi] = *(const bf16x8*)(A + k0 + aoff[mi]);
#pragma unroll
        for (int ni = 0; ni < 4; ++ni) { bb[0][ni] = *(const bf16x8*)(Bt0 + k0 + boff[ni]); if (NB == 2) bb[NB - 1][ni] = *(const bf16x8*)(Bt1 + k0 + boff[ni]); }
#pragma unroll
        for (int b = 0; b < NB; ++b)
#pragma unroll
            for (int mi = 0; mi < 2; ++mi)
#pragma unroll
                for (int ni = 0; ni < 4; ++ni) acc[b][mi][ni] = __builtin_amdgcn_mfma_f32_16x16x32_bf16(a[mi], bb[b][ni], acc[b][mi][ni], 0, 0, 0);
    }
#pragma unroll
    for (int mi = 0; mi < 2; ++mi)
#pragma unroll
        for (int ni = 0; ni < 4; ++ni)
#pragma unroll
            for (int j = 0; j < 4; ++j) epi(m0 + 32 * wave + 16 * mi + 4 * fq + j, n0 + 16 * ni + fr, acc[0][mi][ni][j], acc[NB - 1][mi][ni][j]);
}

template <int DV, bool CAUSAL>
__device__ __forceinline__ void sattn_wave(const bf16_t* Qw, int ldq, const bf16_t* Kp, int ldk, const bf16_t* Vp, int ldv, int nblk, int q0, LAS bf16_t* pl, f32x4 (&o)[DV / 16], int lane) {
    const int fr = lane & 15, fq = lane >> 4;
    bf16x8 qa[2];
#pragma unroll
    for (int ks = 0; ks < 2; ++ks) qa[ks] = *(const bf16x8*)(Qw + (size_t)fr * ldq + 32 * ks + 8 * fq);
    float mrow[4], lpart[4];
#pragma unroll
    for (int j = 0; j < 4; ++j) { mrow[j] = -1e30f; lpart[j] = 0.f; }
#pragma unroll
    for (int nt = 0; nt < DV / 16; ++nt) o[nt] = (f32x4){0.f, 0.f, 0.f, 0.f};
    for (int kb = 0; kb < nblk; ++kb) {
        f32x4 s[2];
#pragma unroll
        for (int nt = 0; nt < 2; ++nt) {
            s[nt] = (f32x4){0.f, 0.f, 0.f, 0.f};
            const bf16_t* kr = Kp + (size_t)(kb * 32 + 16 * nt + fr) * ldk + 8 * fq;
#pragma unroll
            for (int ks = 0; ks < 2; ++ks) { const bf16x8 kf = *(const bf16x8*)(kr + 32 * ks); s[nt] = __builtin_amdgcn_mfma_f32_16x16x32_bf16(qa[ks], kf, s[nt], 0, 0, 0); }
        }
        if (CAUSAL) {
#pragma unroll
            for (int nt = 0; nt < 2; ++nt)
#pragma unroll
                for (int j = 0; j < 4; ++j) if (kb * 32 + 16 * nt + fr > q0 + 4 * fq + j) s[nt][j] = -1e30f;
        }
        float alpha[4];
#pragma unroll
        for (int j = 0; j < 4; ++j) {
            float mx = fmaxf(s[0][j], s[1][j]);
            mx = fmaxf(mx, __shfl_xor(mx, 1)); mx = fmaxf(mx, __shfl_xor(mx, 2)); mx = fmaxf(mx, __shfl_xor(mx, 4)); mx = fmaxf(mx, __shfl_xor(mx, 8));
            const float mn = fmaxf(mrow[j], mx);
            alpha[j] = exp2f(mrow[j] - mn); mrow[j] = mn;
            const float p0 = exp2f(s[0][j] - mn), p1 = exp2f(s[1][j] - mn);
            lpart[j] = lpart[j] * alpha[j] + p0 + p1;
            pl[(4 * fq + j) * 40 + fr] = (bf16_t)f2bf(p0); pl[(4 * fq + j) * 40 + 16 + fr] = (bf16_t)f2bf(p1);
        }
#pragma unroll
        for (int nt = 0; nt < DV / 16; ++nt)
#pragma unroll
            for (int j = 0; j < 4; ++j) o[nt][j] *= alpha[j];
        asm volatile("s_waitcnt lgkmcnt(0)" ::: "memory");
        const bf16x8 pa = *(const LAS bf16x8*)(pl + fr * 40 + 8 * fq);
        asm volatile("s_waitcnt lgkmcnt(0)" ::: "memory");
#pragma unroll
        for (int nt = 0; nt < DV / 16; ++nt) {
            bf16x8 vf;
#pragma unroll
            for (int jj = 0; jj < 8; ++jj) vf[jj] = (short)Vp[(size_t)(kb * 32 + 8 * fq + jj) * ldv + 16 * nt + fr];
            o[nt] = __builtin_amdgcn_mfma_f32_16x16x32_bf16(pa, vf, o[nt], 0, 0, 0);
        }
    }
#pragma unroll
    for (int j = 0; j < 4; ++j) {
        float l = lpart[j];
        l += __shfl_xor(l, 1); l += __shfl_xor(l, 2); l += __shfl_xor(l, 4); l += __shfl_xor(l, 8);
        const float rl = 1.0f / l;
#pragma unroll
        for (int nt = 0; nt < DV / 16; ++nt) o[nt][j] *= rl;
    }
}


namespace pg8 {
constexpr int BM = 256, BK = 64, HALF = 128, HTB = HALF * BK * 2, STAGE_BYTES = 8 * HTB, KD = 1024;
__device__ __forceinline__ int lds_byte(int r, int c) { const int st = (r >> 4) * 2 + (c >> 5), rr = r & 15, cc = c & 31, ob = rr * 64 + cc * 2; return st * 1024 + (ob ^ (((ob >> 9) & 1) << 5)); }
__device__ __forceinline__ void stage_rc(int b, int& R, int& C) { const int st = b / 1024, sb = b % 1024, swz = sb ^ (((sb >> 9) & 1) << 5); R = (st >> 1) * 16 + swz / 64; C = (st & 1) * 32 + (swz % 64) / 2; }
__device__ __forceinline__ int perm32(int rho) { const int n = rho >> 4, i = rho & 15; return 8 * (i >> 2) + 4 * n + (i & 3); }
__device__ __forceinline__ unsigned cvt_pk_bf16(float lo, float hi) { unsigned r; asm volatile("v_cvt_pk_bf16_f32 %0, %1, %2" : "=v"(r) : "v"(lo), "v"(hi)); return r; }

struct Unit { const char* a; const char* b; int t, pn, e, mt; };

template <class Epi, class Sched, bool GATHER>
__device__ __forceinline__ void gemm_phase(LAS unsigned char* lds, const Sched& S, const Epi& E, LAS unsigned* xoff) {
    const int tid = threadIdx.x, wid = __builtin_amdgcn_readfirstlane(tid >> 6), lane = tid & 63, wr = wid >> 2, wc = wid & 3, fr = lane & 15, fq = lane >> 4;
    constexpr int K = KD, nt = K / BK;
    unsigned voffA0[2], voffA1[2], voffB[2];
    Unit cur, nxt; int ui = 0;
    if (!S.next(0, cur)) return;
#pragma unroll
    for (int i = 0; i < 2; ++i) { int R, C; stage_rc(tid * 16 + i * 8192, R, C); const int Rb = Epi::PERM ? ((R & ~31) + perm32(R & 31)) : R;
        voffB[i] = (unsigned)(Rb * K + C) * 2u;
        if (GATHER) { voffA0[i] = S.arow(cur, R) + (unsigned)C * 2u; voffA1[i] = S.arow(cur, R + HALF) + (unsigned)C * 2u; }
        else { voffA0[i] = (unsigned)(R * K + C) * 2u; voffA1[i] = voffA0[i] + (unsigned)(HALF * K * 2); } }
    if (GATHER) {
        Unit u1; const bool h1 = S.next(1, u1);
#pragma unroll
        for (int i = 0; i < 2; ++i) { int R, C; stage_rc(tid * 16 + i * 8192, R, C);
            xoff[tid * 4 + i] = h1 ? S.arow(u1, R) + (unsigned)C * 2u : voffA0[i]; xoff[tid * 4 + 2 + i] = h1 ? S.arow(u1, R + HALF) + (unsigned)C * 2u : voffA1[i]; }
    }
    const size_t kstep = (size_t)(BK * 2);
    const size_t hstep = (size_t)HALF * K * 2;
    const unsigned ldsw = (unsigned)wid * 1024u;
    const int aoff = lds_byte(wr * 64 + fr, fq * 8), boff = lds_byte(wc * 32 + fr, fq * 8);
#define PG8_SA(b, h) (((b) * 2 + (h)) * HTB)
#define PG8_SB(b, h) ((4 + (b) * 2 + (h)) * HTB)
#define PG8_STAGE(bufoff, gbase, voff) do { _Pragma("unroll") for (int _i = 0; _i < 2; ++_i) \
        __builtin_amdgcn_global_load_lds((const unsigned*)((const char*)(gbase) + (voff)[_i]), (LAS unsigned*)(lds + (bufoff) + ldsw + _i * 8192), 16, 0, 0); } while (0)
#define PG8_LDA(dst, b, h) do { _Pragma("unroll") for (int m = 0; m < 4; ++m) _Pragma("unroll") for (int k = 0; k < 2; ++k) dst[m][k] = *(const LAS bf16x8*)(lds + PG8_SA(b, h) + aoff + m * 2048 + k * 1024); } while (0)
#define PG8_LDB(dst, b, h) do { _Pragma("unroll") for (int n = 0; n < 2; ++n) _Pragma("unroll") for (int k = 0; k < 2; ++k) dst[n][k] = *(const LAS bf16x8*)(lds + PG8_SB(b, h) + boff + n * 2048 + k * 1024); } while (0)
#define PG8_MMA(ai, bj, At, Bt) do { __builtin_amdgcn_s_setprio(1); _Pragma("unroll") for (int m = 0; m < 4; ++m) _Pragma("unroll") for (int n = 0; n < 2; ++n) _Pragma("unroll") for (int k = 0; k < 2; ++k) \
        acc[ai][bj][m][n] = __builtin_amdgcn_mfma_f32_16x16x32_bf16(Bt[n][k], At[m][k], acc[ai][bj][m][n], 0, 0, 0); __builtin_amdgcn_s_setprio(0); } while (0)
#define PG8_WAIT_V(n) asm volatile("s_waitcnt vmcnt(" #n ")" ::: "memory")
#define PG8_WAIT_L(n) asm volatile("s_waitcnt lgkmcnt(" #n ")" ::: "memory")
#define PG8_BAR __builtin_amdgcn_s_barrier()
#define PG8_SCHED __builtin_amdgcn_sched_barrier(0)
    f32x4 acc[2][2][4][2];
#pragma unroll
    for (int a = 0; a < 2; ++a)
#pragma unroll
        for (int b = 0; b < 2; ++b)
#pragma unroll
            for (int m = 0; m < 4; ++m)
#pragma unroll
                for (int n = 0; n < 2; ++n) acc[a][b][m][n] = (f32x4){0.f, 0.f, 0.f, 0.f};
    bf16x8 At[4][2], B0[2][2], B1[2][2];
    const char* cA = cur.a; const char* cB = cur.b;
    PG8_WAIT_V(0);
    PG8_STAGE(PG8_SB(0, 0), cB, voffB); PG8_STAGE(PG8_SB(0, 1), cB + hstep, voffB); PG8_STAGE(PG8_SA(0, 0), cA, voffA0); PG8_STAGE(PG8_SA(0, 1), cA, voffA1);
    if (wr == 1) PG8_BAR;
    PG8_WAIT_V(2); PG8_BAR;
    PG8_STAGE(PG8_SB(1, 0), cB + kstep, voffB); PG8_STAGE(PG8_SA(1, 0), cA + kstep, voffA0); PG8_STAGE(PG8_SB(1, 1), cB + hstep + kstep, voffB);
    PG8_WAIT_V(6); PG8_BAR;
    for (;;) {
        const bool has_next = S.next(ui + 1, nxt);
        const char* nA = has_next ? nxt.a : cA; const char* nB = has_next ? nxt.b : cB;
        for (int t = 0; t < nt; t += 2) {
            const bool last = (t == nt - 2);
            const char* a1 = cA + (size_t)(t + 1) * kstep;
            const char* a2 = last ? nA : cA + (size_t)(t + 2) * kstep; const char* b2 = last ? nB : cB + (size_t)(t + 2) * kstep;
            const char* a3 = a2 + kstep; const char* b3 = b2 + kstep;
            PG8_LDB(B0, 0, 0); PG8_LDB(B1, 0, 1); PG8_SCHED; PG8_LDA(At, 0, 0); PG8_STAGE(PG8_SA(1, 1), a1, voffA1);
            if (GATHER) { if (last && has_next) {
#pragma unroll
                for (int i = 0; i < 2; ++i) { voffA0[i] = xoff[tid * 4 + i]; voffA1[i] = xoff[tid * 4 + 2 + i]; } } }
            PG8_WAIT_V(8); PG8_WAIT_L(0); PG8_BAR; PG8_MMA(0, 0, At, B0); PG8_MMA(0, 1, At, B1); PG8_BAR; PG8_SCHED;
            PG8_LDA(At, 0, 1); PG8_STAGE(PG8_SB(0, 0), b2, voffB); PG8_STAGE(PG8_SB(0, 1), b2 + hstep, voffB); PG8_STAGE(PG8_SA(0, 0), a2, voffA0);
            PG8_WAIT_V(8); PG8_WAIT_L(0); PG8_BAR; PG8_MMA(1, 0, At, B0); PG8_MMA(1, 1, At, B1); PG8_BAR; PG8_SCHED;
            PG8_LDB(B0, 1, 0); PG8_LDB(B1, 1, 1); PG8_SCHED; PG8_LDA(At, 1, 0); PG8_STAGE(PG8_SA(0, 1), a2, voffA1);
            PG8_WAIT_V(8); PG8_WAIT_L(0); PG8_BAR; PG8_MMA(0, 0, At, B0); PG8_MMA(0, 1, At, B1); PG8_BAR; PG8_SCHED;
            PG8_LDA(At, 1, 1); PG8_STAGE(PG8_SB(1, 0), b3, voffB); PG8_STAGE(PG8_SB(1, 1), b3 + hstep, voffB); PG8_STAGE(PG8_SA(1, 0), a3, voffA0);
            PG8_WAIT_V(8); PG8_WAIT_L(0); PG8_BAR; PG8_MMA(1, 0, At, B0); PG8_MMA(1, 1, At, B1); PG8_BAR; PG8_SCHED;
        }
        if (wr == 0) PG8_BAR;
        E(acc, cur, wr, wc, fr, fq);
        if (GATHER) {
            Unit u2; const bool h2 = S.next(ui + 2, u2);
            if (h2) {
#pragma unroll
                for (int i = 0; i < 2; ++i) { int R, C; stage_rc(tid * 16 + i * 8192, R, C);
                    xoff[tid * 4 + i] = S.arow(u2, R) + (unsigned)C * 2u; xoff[tid * 4 + 2 + i] = S.arow(u2, R + HALF) + (unsigned)C * 2u; }
            }
        }
        if (!has_next) break;
#pragma unroll
        for (int a = 0; a < 2; ++a)
#pragma unroll
            for (int b = 0; b < 2; ++b)
#pragma unroll
                for (int m = 0; m < 4; ++m)
#pragma unroll
                    for (int n = 0; n < 2; ++n) acc[a][b][m][n] = (f32x4){0.f, 0.f, 0.f, 0.f};
        cur = nxt; cA = nA; cB = nB; ++ui;
        if (wr == 1) PG8_BAR;
    }
    PG8_WAIT_V(0);
    PG8_BAR;
#undef PG8_SA
#undef PG8_SB
#undef PG8_STAGE
#undef PG8_LDA
#undef PG8_LDB
#undef PG8_MMA
#undef PG8_WAIT_V
#undef PG8_WAIT_L
#undef PG8_BAR
#undef PG8_SCHED
}

struct DenseSched {
    const char* A; const char* B; int nN, total, G, c;
    __device__ __forceinline__ bool next(int i, Unit& u) const {
        const int per = G >> 3; const int L = (i * 8 + (c & 7)) * per + (c >> 3); if (L >= total) return false;
        const int pm = L / nN, pn = L % nN; u.a = A + (size_t)pm * (BM * KD * 2); u.b = B + (size_t)pn * (BM * KD * 2); u.t = pm; u.pn = pn; u.e = 0; u.mt = pm; return true;
    }
    __device__ __forceinline__ unsigned arow(const Unit&, int) const { return 0u; }
};
struct MoeSched {
    const char* A; const char* B; size_t b_expert_stride; const int* list; LAS const int* tstart; LAS const int* ecnt; int nN, total, G, c; bool tile_major_a;
    __device__ __forceinline__ bool next(int i, Unit& u) const {
        const int per = G >> 3; const int L = (i * 8 + (c & 7)) * per + (c >> 3); if (L >= total) return false;
        const int t = L / nN, pn = L % nN; int e = 0;
        for (int q = 1; q < NE; ++q) if (tstart[q] <= t) e = q;
        u.t = t; u.pn = pn; u.e = e; u.mt = t - tstart[e];
        u.a = tile_major_a ? A + (size_t)t * (BM * KD * 2) : A; u.b = B + (size_t)e * b_expert_stride + (size_t)pn * (BM * KD * 2); return true;
    }
    __device__ __forceinline__ unsigned arow(const Unit& u, int R) const {
        const int rank = u.mt * 256 + R; const int tok = rank < ecnt[u.e] ? (list[(size_t)u.e * M + rank] >> 2) : 0; return (unsigned)tok * (unsigned)(KD * 2);
    }
};

struct EpiResidual {
    static constexpr bool PERM = false;
    const float* res; float* o;
    __device__ __forceinline__ void operator()(const f32x4 (&acc)[2][2][4][2], const Unit& u, int wr, int wc, int fr, int fq) const {
        const int col0 = u.pn * BM + wc * 32 + 4 * fq;
#pragma unroll
        for (int ai = 0; ai < 2; ++ai)
#pragma unroll
            for (int m = 0; m < 4; ++m) { const size_t off = (size_t)(u.t * BM + ai * HALF + wr * 64 + m * 16 + fr) * DM + col0;
#pragma unroll
                for (int bj = 0; bj < 2; ++bj)
#pragma unroll
                    for (int n = 0; n < 2; ++n) { const f32x4 r = *(const f32x4*)(res + off + bj * HALF + n * 16); *(f32x4*)(o + off + bj * HALF + n * 16) = r + acc[ai][bj][m][n]; }
                if (m & 1) asm volatile("" ::: "memory"); }
    }
};
struct EpiSwiglu {
    static constexpr bool PERM = true;
    bf16_t* act; const float* b1;
    __device__ __forceinline__ void operator()(const f32x4 (&acc)[2][2][4][2], const Unit& u, int wr, int wc, int fr, int fq) const {
        const int c0 = u.pn * HALF + wc * 32 + 8 * fq; const float* bg = b1 + (size_t)u.e * 2048 + c0;
        f32x4 bv[2][2];
#pragma unroll
        for (int bj = 0; bj < 2; ++bj)
#pragma unroll
            for (int n = 0; n < 2; ++n) bv[bj][n] = *(const f32x4*)(bg + bj * 1024 + 4 * n);
#pragma unroll
        for (int ai = 0; ai < 2; ++ai)
#pragma unroll
            for (int m = 0; m < 4; ++m) {
                float a8[8];
#pragma unroll
                for (int n = 0; n < 2; ++n)
#pragma unroll
                    for (int i = 0; i < 4; ++i) {
                        const float glu = fminf(acc[ai][0][m][n][i] + bv[0][n][i], 7.0f), lin = fminf(fmaxf(acc[ai][1][m][n][i] + bv[1][n][i], -7.0f), 7.0f);
                        a8[4 * n + i] = glu * __builtin_amdgcn_rcpf(1.0f + __expf(-1.702f * glu)) * (lin + 1.0f);
                    }
                u32x4 w; w.x = cvt_pk_bf16(a8[0], a8[1]); w.y = cvt_pk_bf16(a8[2], a8[3]); w.z = cvt_pk_bf16(a8[4], a8[5]); w.w = cvt_pk_bf16(a8[6], a8[7]);
                *(u32x4*)(act + ((size_t)u.t * BM + ai * HALF + wr * 64 + m * 16 + fr) * DFF + c0) = w;
            }
    }
};
struct EpiGateScatter {
    static constexpr bool PERM = true;
    bf16_t* yb; const float* b2; const int* list; const float* glist; LAS const int* ecnt;
    __device__ __forceinline__ void operator()(const f32x4 (&acc)[2][2][4][2], const Unit& u, int wr, int wc, int fr, int fq) const {
        const int c0 = u.pn * BM + wc * 32 + 8 * fq; const float* bb = b2 + (size_t)u.e * DM + c0; const int cnt = ecnt[u.e];
        f32x4 bv[2][2];
#pragma unroll
        for (int bj = 0; bj < 2; ++bj)
#pragma unroll
            for (int n = 0; n < 2; ++n) bv[bj][n] = *(const f32x4*)(bb + bj * HALF + 4 * n);
#pragma unroll
        for (int ai = 0; ai < 2; ++ai)
#pragma unroll
            for (int m = 0; m < 4; ++m) {
                const int rank = u.mt * 256 + ai * HALF + wr * 64 + m * 16 + fr;
                if (rank < cnt) {
                    const int dest = list[(size_t)u.e * M + rank]; const float g = glist[(size_t)u.e * M + rank];
#pragma unroll
                    for (int bj = 0; bj < 2; ++bj) { const f32x4 v0 = (acc[ai][bj][m][0] + bv[bj][0]) * g, v1 = (acc[ai][bj][m][1] + bv[bj][1]) * g;
                        u32x4 w; w.x = cvt_pk_bf16(v0[0], v0[1]); w.y = cvt_pk_bf16(v0[2], v0[3]); w.z = cvt_pk_bf16(v1[0], v1[1]); w.w = cvt_pk_bf16(v1[2], v1[3]);
                        *(u32x4*)(yb + (size_t)dest * DM + c0 + bj * HALF) = w; }
                }
            }
    }
};
}

__global__ void __launch_bounds__(NTHREADS, 2) mk_fwd(Args args) {
    extern __shared__ __attribute__((aligned(16))) unsigned char lds_raw[];
    LAS unsigned char* lds = (LAS unsigned char*)lds_raw;
    const int tid = threadIdx.x, lane = tid & 63, wave = __builtin_amdgcn_readfirstlane(tid >> 6);
    const int G = gridDim.x, bid = blockIdx.x;
    const int gw = bid * NWAVES + wave, NGW = G * NWAVES;
#define DECL_ALL \
    unsigned char* ws = args.ws; \
    const float* x = (const float*)args.in[0]; const float* mem = (const float*)args.in[1]; const int* positions = (const int*)args.in[2]; \
    const float* g_mix = (const float*)args.in[3]; const float* w_in = (const float*)args.in[4]; \
    const float* g_dq = (const float*)args.in[5]; const float* g_dk = (const float*)args.in[6]; \
    const float* lq1 = (const float*)args.in[7]; const float* lk1 = (const float*)args.in[8]; const float* lq2 = (const float*)args.in[9]; const float* lk2 = (const float*)args.in[10]; \
    const float* g_sub = (const float*)args.in[11]; const float* g_sgu = (const float*)args.in[12]; \
    const float* w_sp = (const float*)args.in[13]; const float* b_sp = (const float*)args.in[14]; \
    const float* g_memn = (const float*)args.in[15]; const float* w_kv = (const float*)args.in[16]; \
    const float* g_cq = (const float*)args.in[17]; const float* g_ck = (const float*)args.in[18]; \
    const float* w_out = (const float*)args.in[19]; const float* g_ffn = (const float*)args.in[20]; \
    const float* w_router = (const float*)args.in[21]; const float* b_router = (const float*)args.in[22]; \
    const float* w_mlp1 = (const float*)args.in[23]; const float* b_mlp1 = (const float*)args.in[24]; \
    const float* w_mlp2 = (const float*)args.in[25]; const float* b_mlp2 = (const float*)args.in[26]; \
    float* out = args.out; \
    unsigned* ctl = (unsigned*)(ws + WS_CTL); \
    bf16_t* WIN_T = (bf16_t*)(ws + WS_WIN); bf16_t* WO_T = (bf16_t*)(ws + WS_WO); bf16_t* WKV_T = (bf16_t*)(ws + WS_WKV); \
    float* CS = (float*)(ws + WS_CS); int* LIST = (int*)(ws + WS_LIST); float* GLIST = (float*)(ws + WS_GLIST); \
    bf16_t* MEMN = (bf16_t*)(ws + WS_MEMN); bf16_t* MEMK = (bf16_t*)(ws + WS_MEMK); bf16_t* MEMV = (bf16_t*)(ws + WS_MEMV); \
    bf16_t* W1T = (bf16_t*)(ws + WS_W1); bf16_t* W2T = (bf16_t*)(ws + WS_W2); bf16_t* H2 = (bf16_t*)(ws + WS_H2); bf16_t* ACT = (bf16_t*)(ws + WS_ACT); \
    bf16_t* XN = (bf16_t*)(ws + WS_XN); bf16_t* QB = (bf16_t*)(ws + WS_QB); bf16_t* KB = (bf16_t*)(ws + WS_KB); bf16_t* VB = (bf16_t*)(ws + WS_VB); \
    bf16_t* UB = (bf16_t*)(ws + WS_UB); bf16_t* VGB = (bf16_t*)(ws + WS_VGB); bf16_t* MQB = (bf16_t*)(ws + WS_MQB); \
    bf16_t* CAT = (bf16_t*)(ws + WS_CAT); bf16_t* YB = (bf16_t*)(ws + WS_YB); \
    float* PROJ = (float*)(ws + WS_PROJ); float* KVT = (float*)(ws + WS_KVT); \
    (void)x; (void)mem; (void)positions; (void)g_mix; (void)w_in; (void)g_dq; (void)g_dk; (void)lq1; (void)lk1; (void)lq2; (void)lk2; (void)g_sub; (void)g_sgu; (void)w_sp; (void)b_sp; \
    (void)g_memn; (void)w_kv; (void)g_cq; (void)g_ck; (void)w_out; (void)g_ffn; (void)w_router; (void)b_router; (void)w_mlp1; (void)b_mlp1; (void)w_mlp2; (void)b_mlp2; (void)out; (void)ctl; \
    (void)WIN_T; (void)WO_T; (void)WKV_T; (void)CS; (void)LIST; (void)GLIST; (void)MEMN; (void)MEMK; (void)MEMV; (void)W1T; (void)W2T; (void)H2; (void)ACT; (void)XN; (void)QB; (void)KB; (void)VB; \
    (void)UB; (void)VGB; (void)MQB; (void)CAT; (void)YB; (void)PROJ; (void)KVT;

    const int lo = args.ph_lo, hi = args.ph_hi;
#ifndef PHMASK
#define PHMASK 0x1ff
#endif
#define IN(k) (((PHMASK >> (k)) & 1) && lo <= (k) && (k) < hi)
#define BOTH(k) (IN(k) && IN((k) + 1))
#define GRID_BAR() do { __threadfence(); cg::this_grid().sync(); } while (0)

    if (IN(0)) {
        DECL_ALL
        LAS float* scr = (LAS float*)(lds + wave * 16384);
        constexpr int I_IN = 16 * (NPROJ / 32), I_O = 16 * 32, I_KV = 16 * 16, I_1 = 16 * 64, I_2 = 16 * 32;
        constexpr int NITEMS = I_IN + I_O + I_KV + NE * I_1 + NE * I_2;
        for (int it = gw; it < NITEMS; it += NGW) {
            int r = it;
            if (r < I_IN) { transpose_item(w_in, DM, NPROJ, WIN_T, scr, r, lane); continue; } r -= I_IN;
            if (r < I_O) { transpose_item(w_out, DM, DM, WO_T, scr, r, lane); continue; } r -= I_O;
            if (r < I_KV) { transpose_item(w_kv, DM, 512, WKV_T, scr, r, lane); continue; } r -= I_KV;
            if (r < NE * I_1) { const int e = r / I_1; transpose_item_p(w_mlp1 + (size_t)e * DM * 2048, DM, 2048, W1T + (size_t)e * 2048 * DM, scr, r % I_1, lane,
                                                                   [](int n) { const int half = n >> 10, q = n & 1023; return 256 * (q >> 7) + 128 * half + (q & 127); }); continue; } r -= NE * I_1;
            { const int e = r / I_2; transpose_item(w_mlp2 + (size_t)e * DFF * DM, DFF, DM, W2T + (size_t)e * DM * DFF, scr, r % I_2, lane); }
        }
        for (int m = gw; m < M; m += NGW) rms_row_to_bf16(x + (size_t)m * DM, g_mix, XN + (size_t)m * DM, lane);
        for (int m = gw; m < MM; m += NGW) rms_row_to_bf16(mem + (size_t)m * DM, g_memn, MEMN + (size_t)m * DM, lane);
        for (int i = bid * NTHREADS + tid; i < M * 8; i += G * NTHREADS) {
            const int tok = i >> 3, f = i & 7;
            const float inv = (float)exp2(-(double)f * 0.125 * 18.931568569324174);
            const float ang = (float)positions[tok] * inv;
            CS[(size_t)tok * 16 + f] = (float)cos((double)ang); CS[(size_t)tok * 16 + 8 + f] = (float)sin((double)ang);
        }
        if (bid == 0 && tid < 64) ctl[tid] = 0u;
        if (BOTH(0)) GRID_BAR();
    }

    if (IN(1)) {
        DECL_ALL
        constexpr int N1 = (M / 256) * (NPROJ / 64), N2 = (MM / 256) * (512 / 64);
        for (int it = bid; it < N1 + N2; it += G) {
            if (it < N1) {
                const int mt = it / (NPROJ / 64), nc = it % (NPROJ / 64);
                sgemm_item<1>(XN, DM, [](int r) { return r; }, WIN_T, WIN_T, DM, DM, mt * 256, nc * 64,
                              [=](int r, int c, float v, float) { PROJ[(size_t)r * NPROJ + c] = v; }, wave, lane);
            } else {
                const int j = it - N1, mt = j / 8, nc = j % 8;
                sgemm_item<1>(MEMN, DM, [](int r) { return r; }, WKV_T, WKV_T, DM, DM, mt * 256, nc * 64,
                              [=](int r, int c, float v, float) { KVT[(size_t)r * 512 + c] = v; }, wave, lane);
            }
        }
        if (BOTH(1)) GRID_BAR();
    }

    if (IN(2)) {
        DECL_ALL
        for (int m = gw; m < M; m += NGW) {
            const float* pr = PROJ + (size_t)m * NPROJ;
            const int i8 = lane & 7; const float cc = CS[(size_t)m * 16 + i8], sn = CS[(size_t)m * 16 + 8 + i8];
            for (int g = 0; g < 16; ++g) {
                const float v = pr[g * 64 + lane];
                const float rstd = 1.0f / sqrtf(wave_sum(v * v) * (1.f / 64) + EPS);
                float y = v * rstd * (g < 8 ? g_dq[lane] : g_dk[lane]);
                const float partner = __shfl_xor(y, 8);
                if (lane < 8) y = y * cc - partner * sn; else if (lane < 16) y = y * cc + partner * sn;
                if (g < 8) QB[(size_t)m * 512 + g * 64 + lane] = (bf16_t)f2bf(y * C2); else KB[(size_t)m * 512 + (g - 8) * 64 + lane] = (bf16_t)f2bf(y);
            }
            for (int j = 0; j < 8; ++j) VB[(size_t)m * 512 + j * 64 + lane] = (bf16_t)f2bf(pr[1024 + j * 64 + lane]);
            for (int j = 0; j < 4; ++j) UB[(size_t)m * 256 + j * 64 + lane] = (bf16_t)f2bf(gelu_tanh(pr[1536 + j * 64 + lane]));
            for (int j = 0; j < 4; ++j) VGB[(size_t)m * 256 + j * 64 + lane] = (bf16_t)f2bf(gelu_tanh(pr[1792 + j * 64 + lane]));
            for (int g = 0; g < 4; ++g) {
                const float v = pr[2048 + g * 64 + lane];
                const float rstd = 1.0f / sqrtf(wave_sum(v * v) * (1.f / 64) + EPS);
                MQB[(size_t)m * 256 + g * 64 + lane] = (bf16_t)f2bf(v * rstd * g_cq[lane] * C2);
            }
        }
        for (int m = gw; m < MM; m += NGW) {
            const float* pr = KVT + (size_t)m * 512;
            for (int g = 0; g < 4; ++g) {
                const float v = pr[g * 64 + lane];
                const float rstd = 1.0f / sqrtf(wave_sum(v * v) * (1.f / 64) + EPS);
                MEMK[(size_t)m * 256 + g * 64 + lane] = (bf16_t)f2bf(v * rstd * g_ck[lane]);
                MEMV[(size_t)m * 256 + g * 64 + lane] = (bf16_t)f2bf(pr[256 + g * 64 + lane]);
            }
        }
        if (BOTH(2)) GRID_BAR();
    }

    if (IN(3)) {
        DECL_ALL
        LAS bf16_t* pl = (LAS bf16_t*)(lds + wave * 2048);
        const float lam = __expf(wave_sum(lq1[lane] * lk1[lane])) - __expf(wave_sum(lq2[lane] * lk2[lane])) + 0.2f;
        const int fr = lane & 15, fq = lane >> 4;
        for (int it = bid; it < BATCH * 4 * 16; it += G) {
            const int b = it / 64, h = (it / 16) & 3, qb = it & 15;
            const int q0 = qb * 128 + wave * 16; const size_t rb = (size_t)b * SEQ;
            f32x4 o1[8], o2[8];
            sattn_wave<128, true>(QB + (rb + q0) * 512 + (h * 2 + 0) * 64, 512, KB + rb * 512 + (h * 2 + 0) * 64, 512, VB + rb * 512 + h * 128, 512, (q0 + 16 + 31) / 32, q0, pl, o1, lane);
            sattn_wave<128, true>(QB + (rb + q0) * 512 + (h * 2 + 1) * 64, 512, KB + rb * 512 + (h * 2 + 1) * 64, 512, VB + rb * 512 + h * 128, 512, (q0 + 16 + 31) / 32, q0, pl, o2, lane);
#pragma unroll
            for (int j = 0; j < 4; ++j) {
                float ss = 0.f;
#pragma unroll
                for (int nt = 0; nt < 8; ++nt) { o1[nt][j] -= lam * o2[nt][j]; ss += o1[nt][j] * o1[nt][j]; }
                ss += __shfl_xor(ss, 1); ss += __shfl_xor(ss, 2); ss += __shfl_xor(ss, 4); ss += __shfl_xor(ss, 8);
                const float rstd = 0.8f / sqrtf(ss * (1.f / 128) + EPS);
#pragma unroll
                for (int nt = 0; nt < 8; ++nt) CAT[(rb + q0 + 4 * fq + j) * 1024 + h * 128 + 16 * nt + fr] = (bf16_t)f2bf(o1[nt][j] * rstd * g_sub[16 * nt + fr]);
            }
        }
        for (int it = bid; it < BATCH * 4 * 16; it += G) {
            const int b = it / 64, h = (it / 16) & 3, qb = it & 15;
            const int q0 = qb * 128 + wave * 16; const size_t rb = (size_t)b * SEQ;
            f32x4 oc[4];
            sattn_wave<64, false>(MQB + (rb + q0) * 256 + h * 64, 256, MEMK + (size_t)b * MEML * 256 + h * 64, 256, MEMV + (size_t)b * MEML * 256 + h * 64, 256, MEML / 32, q0, pl, oc, lane);
#pragma unroll
            for (int j = 0; j < 4; ++j)
#pragma unroll
                for (int nt = 0; nt < 4; ++nt) CAT[(rb + q0 + 4 * fq + j) * 1024 + 768 + h * 64 + 16 * nt + fr] = (bf16_t)f2bf(oc[nt][j]);
        }
        __syncthreads();
        LAS float* vt = (LAS float*)lds;
        for (int it = bid; it < BATCH * 16; it += G) {
            const size_t r0 = (size_t)it * 128;
            for (int rr = wave; rr < 128; rr += NWAVES) {
                const u32x2 w = *(const u32x2*)(VGB + (r0 + rr) * 256 + 4 * lane);
                const float v0 = bf2f(w.x & 0xffffu), v1 = bf2f(w.x >> 16), v2 = bf2f(w.y & 0xffffu), v3 = bf2f(w.y >> 16);
                const float mean = wave_sum((v0 + v1) + (v2 + v3)) * (1.f / 256);
                const float d0 = v0 - mean, d1 = v1 - mean, d2 = v2 - mean, d3 = v3 - mean;
                const float rstd = 1.0f / sqrtf(wave_sum((d0 * d0 + d1 * d1) + (d2 * d2 + d3 * d3)) * (1.f / 256) + EPS);
                const f32x4 gg = *(const f32x4*)(g_sgu + 4 * lane);
                *(LAS f32x4*)(vt + rr * 256 + 4 * lane) = (f32x4){d0 * rstd * gg.x, d1 * rstd * gg.y, d2 * rstd * gg.z, d3 * rstd * gg.w};
            }
            __syncthreads();
            const int ch = tid & 255, g = ch >> 6;
            for (int i = 0; i < 64; ++i) {
                const int t = 2 * i + (tid >> 8);
                const float* wr = w_sp + ((size_t)g * 128 + t) * 128;
                float acc = 0.f;
                for (int s = 0; s <= t; ++s) acc += wr[s] * vt[s * 256 + ch];
                const float u = bf2f(UB[(r0 + t) * 256 + ch]);
                CAT[(r0 + t) * 1024 + 512 + ch] = (bf16_t)f2bf(u * (acc + b_sp[g * 128 + t]));
            }
            __syncthreads();
        }
        if (BOTH(3)) GRID_BAR();
    }

    if (IN(4)) {
        DECL_ALL
        pg8::DenseSched S{(const char*)CAT, (const char*)WO_T, DM / 256, (M / 256) * (DM / 256), G, bid};
        pg8::EpiResidual E{x, out};
        pg8::gemm_phase<pg8::EpiResidual, pg8::DenseSched, false>(lds, S, E, nullptr);
        if (BOTH(4)) GRID_BAR();
    }

    if (IN(5)) {
        DECL_ALL
        for (int m = gw; m < M; m += NGW) {
            const f32x4* xr = (const f32x4*)(out + (size_t)m * DM) + 4 * lane; const f32x4* gr = (const f32x4*)g_ffn + 4 * lane;
            f32x4 v[4]; float s = 0.f;
#pragma unroll
            for (int j = 0; j < 4; ++j) { v[j] = xr[j]; s += (v[j].x * v[j].x + v[j].y * v[j].y) + (v[j].z * v[j].z + v[j].w * v[j].w); }
            const float rstd = 1.0f / sqrtf(wave_sum(s) * (1.f / DM) + EPS);
            u32x2* o8 = (u32x2*)(H2 + (size_t)m * DM) + 4 * lane;
#pragma unroll
            for (int j = 0; j < 4; ++j) { const f32x4 gg = gr[j]; v[j].x *= rstd * gg.x; v[j].y *= rstd * gg.y; v[j].z *= rstd * gg.z; v[j].w *= rstd * gg.w;
                u32x2 w; w.x = pk2(v[j].x, v[j].y); w.y = pk2(v[j].z, v[j].w); o8[j] = w; }
            const f32x4* wr = (const f32x4*)(w_router + (size_t)lane * 16 * 32);
            LAS float* scr = (LAS float*)(lds + wave * 12800);
            LAS float* hs = scr + 2112 + lane * 17;
#pragma unroll
            for (int j = 0; j < 4; ++j)
#pragma unroll
                for (int i = 0; i < 4; ++i) hs[4 * j + i] = v[j][i];
            asm volatile("s_waitcnt lgkmcnt(0)" ::: "memory");
            float lg[32];
#pragma unroll
            for (int e = 0; e < 32; ++e) lg[e] = 0.f;
#pragma unroll 1
            for (int c = 0; c < 16; ++c) {
                const float hv = hs[c];
#pragma unroll
                for (int e4 = 0; e4 < 8; ++e4) { const f32x4 w = wr[c * 8 + e4]; lg[4 * e4] += hv * w.x; lg[4 * e4 + 1] += hv * w.y; lg[4 * e4 + 2] += hv * w.z; lg[4 * e4 + 3] += hv * w.w; }
            }
#pragma unroll
            for (int e = 0; e < 32; ++e) scr[e * 65 + lane] = lg[e];
            asm volatile("s_waitcnt lgkmcnt(0)" ::: "memory");
            const int e_me = lane & 31, half = lane >> 5;
            float tot = 0.f;
#pragma unroll
            for (int i = 0; i < 32; ++i) tot += scr[e_me * 65 + half * 32 + i];
            asm volatile("s_waitcnt lgkmcnt(0)" ::: "memory");
            tot += __shfl_xor(tot, 32);
            float myv = tot + b_router[e_me];
            float tv[4]; int ti[4];
#pragma unroll
            for (int k = 0; k < 4; ++k) {
                float bv = myv; int bi = e_me;
#pragma unroll
                for (int o = 1; o < 32; o <<= 1) { const float ov = __shfl_xor(bv, o); const int oi = __shfl_xor(bi, o); const bool take = (ov > bv) || (ov == bv && oi < bi); bv = take ? ov : bv; bi = take ? oi : bi; }
                tv[k] = bv; ti[k] = bi;
                if (e_me == bi) myv = -3.0e38f;
            }
            float ex[4], sum = 0.f;
#pragma unroll
            for (int k = 0; k < 4; ++k) { ex[k] = __expf(tv[k] - tv[0]); sum += ex[k]; }
            if (lane == 0) {
#pragma unroll
                for (int k = 0; k < 4; ++k) {
                    const unsigned r = atomicAdd(&ctl[ti[k]], 1u);
                    LIST[(size_t)ti[k] * M + r] = m * 4 + k; GLIST[(size_t)ti[k] * M + r] = ex[k] / sum;
                }
            }
        }
        if (BOTH(5)) GRID_BAR();
    }

    LAS int* tstart = (LAS int*)(lds + 140 * 1024); LAS int* ecnt = tstart + 40;
    if (IN(6) || IN(7)) {
        DECL_ALL
        __syncthreads();
        if (tid == 0) { int acc = 0; for (int e = 0; e < NE; ++e) { const int c = (int)__hip_atomic_load(&ctl[e], __ATOMIC_RELAXED, __HIP_MEMORY_SCOPE_AGENT); tstart[e] = acc; ecnt[e] = c; acc += (c + 255) / 256; } tstart[NE] = acc; }
        __syncthreads();
    }
    if (IN(6)) {
        DECL_ALL
        const int ntiles = tstart[NE];
        pg8::MoeSched S{(const char*)H2, (const char*)W1T, (size_t)2048 * DM * 2, LIST, tstart, ecnt, 8, ntiles * 8, G, bid, false};
        pg8::EpiSwiglu E{ACT, b_mlp1};
        pg8::gemm_phase<pg8::EpiSwiglu, pg8::MoeSched, true>(lds, S, E, (LAS unsigned*)(lds + 131072));
        if (BOTH(6)) GRID_BAR();
    }
    if (IN(7)) {
        DECL_ALL
        const int ntiles = tstart[NE];
        pg8::MoeSched S{(const char*)ACT, (const char*)W2T, (size_t)DM * DFF * 2, LIST, tstart, ecnt, 4, ntiles * 4, G, bid, true};
        pg8::EpiGateScatter E{YB, b_mlp2, LIST, GLIST, ecnt};
        pg8::gemm_phase<pg8::EpiGateScatter, pg8::MoeSched, false>(lds, S, E, nullptr);
        if (BOTH(7)) GRID_BAR();
    }
    if (IN(8)) {
        DECL_ALL
        for (size_t i = (size_t)bid * NTHREADS + tid; i < (size_t)M * DM / 4; i += (size_t)G * NTHREADS) {
            const size_t tok = i / (DM / 4); const int c = (int)(i % (DM / 4)) * 4;
            f32x4 a = *(const f32x4*)(out + tok * DM + c);
#pragma unroll
            for (int k = 0; k < 4; ++k) {
                const u32x2 w = *(const u32x2*)(YB + (tok * 4 + k) * DM + c);
                a.x += bf2f(w.x & 0xffffu); a.y += bf2f(w.x >> 16); a.z += bf2f(w.y & 0xffffu); a.w += bf2f(w.y >> 16);
            }
            *(f32x4*)(out + tok * DM + c) = a;
        }
    }
#undef IN
#undef BOTH
}

extern "C" void kernel_launch(void* const* d_in, const int* in_sizes, int n_in, void* d_out, int out_size, void* d_ws, size_t ws_size, hipStream_t stream) {
    static int grid = 0;
    if (grid == 0) {
        if (n_in != 27 || out_size != M * DM || ws_size < WS_END) { fprintf(stderr, "kernel_launch: unexpected problem (n_in %d out %d ws %zu)\n", n_in, out_size, ws_size); grid = -1; return; }
        int dev = 0, cus = 0, per_cu = 0;
        hipGetDevice(&dev); hipDeviceGetAttribute(&cus, hipDeviceAttributeMultiprocessorCount, dev);
        if (hipFuncSetAttribute((const void*)mk_fwd, hipFuncAttributeMaxDynamicSharedMemorySize, LDS_BYTES) != hipSuccess) { fprintf(stderr, "kernel_launch: hipFuncSetAttribute failed\n"); grid = -1; return; }
        hipOccupancyMaxActiveBlocksPerMultiprocessor(&per_cu, (const void*)mk_fwd, NTHREADS, LDS_BYTES);
        (void)hipGetLastError();
        if (per_cu < 1) { fprintf(stderr, "kernel_launch: occupancy query says %d blocks per CU\n", per_cu); per_cu = 1; }
        grid = cus;
    }
    if (grid < 0) return;
    Args a{};
    for (int i = 0; i < 27; ++i) a.in[i] = d_in[i];
    a.out = (float*)d_out; a.ws = (unsigned char*)d_ws;
    constexpr int NPH = 9;
    if (MK_N_LAUNCHES == 1) {
        a.ph_lo = 0; a.ph_hi = NPH;
        void* kargs[] = {&a};
        hipError_t e = hipLaunchCooperativeKernel((const void*)mk_fwd, dim3(grid), dim3(NTHREADS), kargs, LDS_BYTES, stream);
        if (e != hipSuccess) fprintf(stderr, "cooperative launch failed: %s (grid %d)\n", hipGetErrorString(e), grid);
    } else {
        for (int p = 0; p < NPH; ++p) { a.ph_lo = p; a.ph_hi = p + 1; hipLaunchKernelGGL(mk_fwd, dim3(grid), dim3(NTHREADS), LDS_BYTES, stream, a); }
    }
}
```

```cpp
#include <hip/hip_runtime.h>
#include <hip/hip_cooperative_groups.h>
#include <cstdio>
#include <cstdint>
namespace cg = cooperative_groups;

#ifndef MK_N_LAUNCHES
#define MK_N_LAUNCHES 1
#endif

constexpr int BATCH = 16, SEQ = 2048, DM = 1024, M = BATCH * SEQ;
constexpr int NPROJ = 2304;
constexpr int MEML = 256, MM = BATCH * MEML;
constexpr int NE = 32, TOPK = 4, DFF = 1024;
constexpr int MAXTILES = (M * TOPK) / 256 + NE;
constexpr int NSLOT = MAXTILES * 256;
constexpr float EPS = 1e-6f;
constexpr float C2 = 0.125f * 1.4426950408889634f;
constexpr int NWAVES = 8, NTHREADS = 512;
constexpr int LDS_BYTES = 147456;

constexpr size_t MiB = 1u << 20;
constexpr size_t WS_CTL = 0;
constexpr size_t WS_WIN = 2 * MiB, WS_WO = 7 * MiB, WS_WKV = 9 * MiB, WS_CS = 10 * MiB, WS_LIST = 12 * MiB, WS_GLIST = 16 * MiB;
constexpr size_t WS_MEMN = 20 * MiB, WS_MEMK = 28 * MiB, WS_MEMV = 30 * MiB;
constexpr size_t WS_W1 = 32 * MiB, WS_W2 = 160 * MiB, WS_H2 = 224 * MiB, WS_ACT = 288 * MiB;
constexpr size_t WS_XN = 560 * MiB, WS_QB = 624 * MiB, WS_KB = 656 * MiB, WS_VB = 688 * MiB, WS_UB = 720 * MiB, WS_VGB = 736 * MiB, WS_MQB = 752 * MiB;
constexpr size_t WS_OT = 768 * MiB, WS_CAT = 832 * MiB, WS_END = 896 * MiB;
constexpr size_t WS_YB = 560 * MiB;
constexpr size_t WS_PROJ = 224 * MiB;
constexpr size_t WS_KVT = 512 * MiB;
static_assert(WS_ACT + (size_t)NSLOT * DFF * 2 <= WS_XN, "act");
static_assert(WS_PROJ + (size_t)M * NPROJ * 4 <= WS_KVT && WS_KVT + (size_t)MM * 512 * 4 <= WS_XN, "proj temp");

#define LAS __attribute__((address_space(3)))
typedef unsigned short bf16_t;
typedef short bf16x8 __attribute__((ext_vector_type(8)));
typedef float f32x4 __attribute__((ext_vector_type(4)));
typedef unsigned u32x4 __attribute__((ext_vector_type(4)));
typedef unsigned u32x2 __attribute__((ext_vector_type(2)));

__device__ __forceinline__ unsigned f2bf(float f) { unsigned u = __float_as_uint(f); return (u + 0x7fffu + ((u >> 16) & 1u)) >> 16; }
__device__ __forceinline__ float bf2f(unsigned h) { return __uint_as_float(h << 16); }
__device__ __forceinline__ unsigned pk2(float lo, float hi) { return f2bf(lo) | (f2bf(hi) << 16); }
__device__ __forceinline__ float wave_sum(float v) {
#pragma unroll
    for (int o = 1; o < 64; o <<= 1) v += __shfl_xor(v, o);
    return v;
}
__device__ __forceinline__ float gelu_tanh(float x) {
    const float y = 0.7978845608028654f * (x + 0.044715f * x * x * x);
    const float t = 1.f - 2.f / (1.f + __expf(2.f * y));
    return 0.5f * x * (1.f + t);
}

struct Args {
    const void* in[27]; float* out; unsigned char* ws; int ph_lo, ph_hi;
};

template <class RowMap>
__device__ __forceinline__ void transpose_item_p(const float* W, int K, int N, bf16_t* WT, LAS float* scr, int item, int lane, RowMap rm) {
    const int nblk = N / 32, kb = item / nblk, nb = item % nblk, k0 = 64 * kb, n0 = 32 * nb;
#pragma unroll 8
    for (int i = 0; i < 32; ++i) { const int kk = 2 * i + (lane >> 5); scr[kk * 33 + (lane & 31)] = W[(size_t)(k0 + kk) * N + n0 + (lane & 31)]; }
    asm volatile("s_waitcnt lgkmcnt(0)" ::: "memory");
    const int c = lane & 7;
#pragma unroll
    for (int j = 0; j < 4; ++j) { const int n = (lane >> 3) + 8 * j; const LAS float* s = scr + (8 * c) * 33 + n;
        u32x4 o; o.x = pk2(s[0 * 33], s[1 * 33]); o.y = pk2(s[2 * 33], s[3 * 33]); o.z = pk2(s[4 * 33], s[5 * 33]); o.w = pk2(s[6 * 33], s[7 * 33]);
        *(u32x4*)(WT + (size_t)rm(n0 + n) * K + k0 + 8 * c) = o; }
    asm volatile("s_waitcnt lgkmcnt(0)" ::: "memory");
}
__device__ __forceinline__ void transpose_item(const float* W, int K, int N, bf16_t* WT, LAS float* scr, int item, int lane) {
    const int nblk = N / 32, kb = item / nblk, nb = item % nblk, k0 = 64 * kb, n0 = 32 * nb;
#pragma unroll 8
    for (int i = 0; i < 32; ++i) { const int kk = 2 * i + (lane >> 5); scr[kk * 33 + (lane & 31)] = W[(size_t)(k0 + kk) * N + n0 + (lane & 31)]; }
    asm volatile("s_waitcnt lgkmcnt(0)" ::: "memory");
    const int c = lane & 7;
#pragma unroll
    for (int j = 0; j < 4; ++j) { const int n = (lane >> 3) + 8 * j; const LAS float* s = scr + (8 * c) * 33 + n;
        u32x4 o; o.x = pk2(s[0 * 33], s[1 * 33]); o.y = pk2(s[2 * 33], s[3 * 33]); o.z = pk2(s[4 * 33], s[5 * 33]); o.w = pk2(s[6 * 33], s[7 * 33]);
        *(u32x4*)(WT + (size_t)(n0 + n) * K + k0 + 8 * c) = o; }
    asm volatile("s_waitcnt lgkmcnt(0)" ::: "memory");
}
__device__ __forceinline__ void rms_row_to_bf16(const float* xrow, const float* g, bf16_t* orow, int lane) {
    const f32x4* xr = (const f32x4*)xrow + lane; const f32x4* gr = (const f32x4*)g + lane;
    f32x4 v[4]; float s = 0.f;
#pragma unroll
    for (int j = 0; j < 4; ++j) { v[j] = xr[64 * j]; s += (v[j].x * v[j].x + v[j].y * v[j].y) + (v[j].z * v[j].z + v[j].w * v[j].w); }
    const float rstd = 1.0f / sqrtf(wave_sum(s) * (1.f / DM) + EPS);
    u32x2* o8 = (u32x2*)orow + lane;
#pragma unroll
    for (int j = 0; j < 4; ++j) { const f32x4 gg = gr[64 * j]; u32x2 w; w.x = pk2(v[j].x * rstd * gg.x, v[j].y * rstd * gg.y); w.y = pk2(v[j].z * rstd * gg.z, v[j].w * rstd * gg.w); o8[64 * j] = w; }
}

template <int NB, class RowFn, class Epi>
__device__ __forceinline__ void sgemm_item(const bf16_t* A, int lda, RowFn rowfn, const bf16_t* Bt0, const bf16_t* Bt1, int ldb, int K, int m0, int n0, Epi epi, int wave, int lane) {
    const int fr = lane & 15, fq = lane >> 4;
    unsigned aoff[2], boff[4];
#pragma unroll
    for (int mi = 0; mi < 2; ++mi) aoff[mi] = (unsigned)rowfn(m0 + 32 * wave + 16 * mi + fr) * (unsigned)lda + 8u * fq;
#pragma unroll
    for (int ni = 0; ni < 4; ++ni) boff[ni] = (unsigned)(n0 + 16 * ni + fr) * (unsigned)ldb + 8u * fq;
    f32x4 acc[NB][2][4];
#pragma unroll
    for (int b = 0; b < NB; ++b)
#pragma unroll
        for (int mi = 0; mi < 2; ++mi)
#pragma unroll
            for (int ni = 0; ni < 4; ++ni) acc[b][mi][ni] = (f32x4){0.f, 0.f, 0.f, 0.f};
#pragma unroll 2
    for (int k0 = 0; k0 < K; k0 += 32) {
        bf16x8 a[2], bb[NB][4];
#pragma unroll
        for (int mi = 0; mi < 2; ++mi) a[mi] = *(const bf16x8*)(A + k0 + aoff[mi]);
#pragma unroll
        for (int ni = 0; ni < 4; ++ni) { bb[0][ni] = *(const bf16x8*)(Bt0 + k0 + boff[ni]); if (NB == 2) bb[NB - 1][ni] = *(const bf16x8*)(Bt1 + k0 + boff[ni]); }
#pragma unroll
        for (int b = 0; b < NB; ++b)
#pragma unroll
            for (int mi = 0; mi < 2; ++mi)
#pragma unroll
                for (int ni = 0; ni < 4; ++ni) acc[b][mi][ni] = __builtin_amdgcn_mfma_f32_16x16x32_bf16(a[mi], bb[b][ni], acc[b][mi][ni], 0, 0, 0);
    }
#pragma unroll
    for (int mi = 0; mi < 2; ++mi)
#pragma unroll
        for (int ni = 0; ni < 4; ++ni)
#pragma unroll
            for (int j = 0; j < 4; ++j) epi(m0 + 32 * wave + 16 * mi + 4 * fq + j, n0 + 16 * ni + fr, acc[0][mi][ni][j], acc[NB - 1][mi][ni][j]);
}

template <int DV, bool CAUSAL>
__device__ __forceinline__ void sattn_wave(const bf16_t* Qw, int ldq, const bf16_t* Kp, int ldk, const bf16_t* Vp, int ldv, int nblk, int q0, LAS bf16_t* pl, f32x4 (&o)[DV / 16], int lane) {
    const int fr = lane & 15, fq = lane >> 4;
    bf16x8 qa[2];
#pragma unroll
    for (int ks = 0; ks < 2; ++ks) qa[ks] = *(const bf16x8*)(Qw + (size_t)fr * ldq + 32 * ks + 8 * fq);
    float mrow[4], lpart[4];
#pragma unroll
    for (int j = 0; j < 4; ++j) { mrow[j] = -1e30f; lpart[j] = 0.f; }
#pragma unroll
    for (int nt = 0; nt < DV / 16; ++nt) o[nt] = (f32x4){0.f, 0.f, 0.f, 0.f};
    for (int kb = 0; kb < nblk; ++kb) {
        f32x4 s[2];
#pragma unroll
        for (int nt = 0; nt < 2; ++nt) {
            s[nt] = (f32x4){0.f, 0.f, 0.f, 0.f};
            const bf16_t* kr = Kp + (size_t)(kb * 32 + 16 * nt + fr) * ldk + 8 * fq;
#pragma unroll
            for (int ks = 0; ks < 2; ++ks) { const bf16x8 kf = *(const bf16x8*)(kr + 32 * ks); s[nt] = __builtin_amdgcn_mfma_f32_16x16x32_bf16(qa[ks], kf, s[nt], 0, 0, 0); }
        }
        if (CAUSAL) {
#pragma unroll
            for (int nt = 0; nt < 2; ++nt)
#pragma unroll
                for (int j = 0; j < 4; ++j) if (kb * 32 + 16 * nt + fr > q0 + 4 * fq + j) s[nt][j] = -1e30f;
        }
        float alpha[4];
#pragma unroll
        for (int j = 0; j < 4; ++j) {
            float mx = fmaxf(s[0][j], s[1][j]);
            mx = fmaxf(mx, __shfl_xor(mx, 1)); mx = fmaxf(mx, __shfl_xor(mx, 2)); mx = fmaxf(mx, __shfl_xor(mx, 4)); mx = fmaxf(mx, __shfl_xor(mx, 8));
            const float mn = fmaxf(mrow[j], mx);
            alpha[j] = exp2f(mrow[j] - mn); mrow[j] = mn;
            const float p0 = exp2f(s[0][j] - mn), p1 = exp2f(s[1][j] - mn);
            lpart[j] = lpart[j] * alpha[j] + p0 + p1;
            pl[(4 * fq + j) * 40 + fr] = (bf16_t)f2bf(p0); pl[(4 * fq + j) * 40 + 16 + fr] = (bf16_t)f2bf(p1);
        }
#pragma unroll
        for (int nt = 0; nt < DV / 16; ++nt)
#pragma unroll
            for (int j = 0; j < 4; ++j) o[nt][j] *= alpha[j];
        asm volatile("s_waitcnt lgkmcnt(0)" ::: "memory");
        const bf16x8 pa = *(const LAS bf16x8*)(pl + fr * 40 + 8 * fq);
        asm volatile("s_waitcnt lgkmcnt(0)" ::: "memory");
#pragma unroll
        for (int nt = 0; nt < DV / 16; ++nt) {
            bf16x8 vf;
#pragma unroll
            for (int jj = 0; jj < 8; ++jj) vf[jj] = (short)Vp[(size_t)(kb * 32 + 8 * fq + jj) * ldv + 16 * nt + fr];
            o[nt] = __builtin_amdgcn_mfma_f32_16x16x32_bf16(pa, vf, o[nt], 0, 0, 0);
        }
    }
#pragma unroll
    for (int j = 0; j < 4; ++j) {
        float l = lpart[j];
        l += __shfl_xor(l, 1); l += __shfl_xor(l, 2); l += __shfl_xor(l, 4); l += __shfl_xor(l, 8);
        const float rl = 1.0f / l;
#pragma unroll
        for (int nt = 0; nt < DV / 16; ++nt) o[nt][j] *= rl;
    }
}


namespace pg8 {
constexpr int BM = 256, BK = 64, HALF = 128, HTB = HALF * BK * 2, STAGE_BYTES = 8 * HTB, KD = 1024;
__device__ __forceinline__ int lds_byte(int r, int c) { const int st = (r >> 4) * 2 + (c >> 5), rr = r & 15, cc = c & 31, ob = rr * 64 + cc * 2; return st * 1024 + (ob ^ (((ob >> 9) & 1) << 5)); }
__device__ __forceinline__ void stage_rc(int b, int& R, int& C) { const int st = b / 1024, sb = b % 1024, swz = sb ^ (((sb >> 9) & 1) << 5); R = (st >> 1) * 16 + swz / 64; C = (st & 1) * 32 + (swz % 64) / 2; }
__device__ __forceinline__ int perm32(int rho) { const int n = rho >> 4, i = rho & 15; return 8 * (i >> 2) + 4 * n + (i & 3); }
__device__ __forceinline__ unsigned cvt_pk_bf16(float lo, float hi) { unsigned r; asm volatile("v_cvt_pk_bf16_f32 %0, %1, %2" : "=v"(r) : "v"(lo), "v"(hi)); return r; }

struct Unit { const char* a; const char* b; int t, pn, e, mt; };

template <class Epi, class Sched, bool GATHER>
__device__ __forceinline__ void gemm_phase(LAS unsigned char* lds, const Sched& S, const Epi& E, LAS unsigned* xoff) {
    const int tid = threadIdx.x, wid = __builtin_amdgcn_readfirstlane(tid >> 6), lane = tid & 63, wr = wid >> 2, wc = wid & 3, fr = lane & 15, fq = lane >> 4;
    constexpr int K = KD, nt = K / BK;
    unsigned voffA0[2], voffA1[2], voffB[2];
    Unit cur, nxt; int ui = 0;
    if (!S.next(0, cur)) return;
#pragma unroll
    for (int i = 0; i < 2; ++i) { int R, C; stage_rc(tid * 16 + i * 8192, R, C); const int Rb = Epi::PERM ? ((R & ~31) + perm32(R & 31)) : R;
        voffB[i] = (unsigned)(Rb * K + C) * 2u;
        if (GATHER) { voffA0[i] = S.arow(cur, R) + (unsigned)C * 2u; voffA1[i] = S.arow(cur, R + HALF) + (unsigned)C * 2u; }
        else { voffA0[i] = (unsigned)(R * K + C) * 2u; voffA1[i] = voffA0[i] + (unsigned)(HALF * K * 2); } }
    if (GATHER) {
        Unit u1; const bool h1 = S.next(1, u1);
#pragma unroll
        for (int i = 0; i < 2; ++i) { int R, C; stage_rc(tid * 16 + i * 8192, R, C);
            xoff[tid * 4 + i] = h1 ? S.arow(u1, R) + (unsigned)C * 2u : voffA0[i]; xoff[tid * 4 + 2 + i] = h1 ? S.arow(u1, R + HALF) + (unsigned)C * 2u : voffA1[i]; }
    }
    const size_t kstep = (size_t)(BK * 2);
    const size_t hstep = (size_t)HALF * K * 2;
    const unsigned ldsw = (unsigned)wid * 1024u;
    const int aoff = lds_byte(wr * 64 + fr, fq * 8), boff = lds_byte(wc * 32 + fr, fq * 8);
#define PG8_SA(b, h) (((b) * 2 + (h)) * HTB)
#define PG8_SB(b, h) ((4 + (b) * 2 + (h)) * HTB)
#define PG8_STAGE(bufoff, gbase, voff) do { _Pragma("unroll") for (int _i = 0; _i < 2; ++_i) \
        __builtin_amdgcn_global_load_lds((const unsigned*)((const char*)(gbase) + (voff)[_i]), (LAS unsigned*)(lds + (bufoff) + ldsw + _i * 8192), 16, 0, 0); } while (0)
#define PG8_LDA(dst, b, h) do { _Pragma("unroll") for (int m = 0; m < 4; ++m) _Pragma("unroll") for (int k = 0; k < 2; ++k) dst[m][k] = *(const LAS bf16x8*)(lds + PG8_SA(b, h) + aoff + m * 2048 + k * 1024); } while (0)
#define PG8_LDB(dst, b, h) do { _Pragma("unroll") for (int n = 0; n < 2; ++n) _Pragma("unroll") for (int k = 0; k < 2; ++k) dst[n][k] = *(const LAS bf16x8*)(lds + PG8_SB(b, h) + boff + n * 2048 + k * 1024); } while (0)
#define PG8_MMA(ai, bj, At, Bt) do { __builtin_amdgcn_s_setprio(1); _Pragma("unroll") for (int m = 0; m < 4; ++m) _Pragma("unroll") for (int n = 0; n < 2; ++n) _Pragma("unroll") for (int k = 0; k < 2; ++k) \
        acc[ai][bj][m][n] = __builtin_amdgcn_mfma_f32_16x16x32_bf16(Bt[n][k], At[m][k], acc[ai][bj][m][n], 0, 0, 0); __builtin_amdgcn_s_setprio(0); } while (0)
#define PG8_WAIT_V(n) asm volatile("s_waitcnt vmcnt(" #n ")" ::: "memory")
#define PG8_WAIT_L(n) asm volatile("s_waitcnt lgkmcnt(" #n ")" ::: "memory")
#define PG8_BAR __builtin_amdgcn_s_barrier()
#define PG8_SCHED __builtin_amdgcn_sched_barrier(0)
    f32x4 acc[2][2][4][2];
#pragma unroll
    for (int a = 0; a < 2; ++a)
#pragma unroll
        for (int b = 0; b < 2; ++b)
#pragma unroll
            for (int m = 0; m < 4; ++m)
#pragma unroll
                for (int n = 0; n < 2; ++n) acc[a][b][m][n] = (f32x4){0.f, 0.f, 0.f, 0.f};
    bf16x8 At[4][2], B0[2][2], B1[2][2];
    const char* cA = cur.a; const char* cB = cur.b;
    PG8_WAIT_V(0);
    PG8_STAGE(PG8_SB(0, 0), cB, voffB); PG8_STAGE(PG8_SB(0, 1), cB + hstep, voffB); PG8_STAGE(PG8_SA(0, 0), cA, voffA0); PG8_STAGE(PG8_SA(0, 1), cA, voffA1);
    if (wr == 1) PG8_BAR;
    PG8_WAIT_V(2); PG8_BAR;
    PG8_STAGE(PG8_SB(1, 0), cB + kstep, voffB); PG8_STAGE(PG8_SA(1, 0), cA + kstep, voffA0); PG8_STAGE(PG8_SB(1, 1), cB + hstep + kstep, voffB);
    PG8_WAIT_V(6); PG8_BAR;
    for (;;) {
        const bool has_next = S.next(ui + 1, nxt);
        const char* nA = has_next ? nxt.a : cA; const char* nB = has_next ? nxt.b : cB;
        for (int t = 0; t < nt; t += 2) {
            const bool last = (t == nt - 2);
            const char* a1 = cA + (size_t)(t + 1) * kstep;
            const char* a2 = last ? nA : cA + (size_t)(t + 2) * kstep; const char* b2 = last ? nB : cB + (size_t)(t + 2) * kstep;
            const char* a3 = a2 + kstep; const char* b3 = b2 + kstep;
            PG8_LDB(B0, 0, 0); PG8_LDB(B1, 0, 1); PG8_SCHED; PG8_LDA(At, 0, 0); PG8_STAGE(PG8_SA(1, 1), a1, voffA1);
            if (GATHER) { if (last && has_next) {
#pragma unroll
                for (int i = 0; i < 2; ++i) { voffA0[i] = xoff[tid * 4 + i]; voffA1[i] = xoff[tid * 4 + 2 + i]; } } }
            PG8_WAIT_V(8); PG8_WAIT_L(0); PG8_BAR; PG8_MMA(0, 0, At, B0); PG8_MMA(0, 1, At, B1); PG8_BAR; PG8_SCHED;
            PG8_LDA(At, 0, 1); PG8_STAGE(PG8_SB(0, 0), b2, voffB); PG8_STAGE(PG8_SB(0, 1), b2 + hstep, voffB); PG8_STAGE(PG8_SA(0, 0), a2, voffA0);
            PG8_WAIT_V(8); PG8_WAIT_L(0); PG8_BAR; PG8_MMA(1, 0, At, B0); PG8_MMA(1, 1, At, B1); PG8_BAR; PG8_SCHED;
            PG8_LDB(B0, 1, 0); PG8_LDB(B1, 1, 1); PG8_SCHED; PG8_LDA(At, 1, 0); PG8_STAGE(PG8_SA(0, 1), a2, voffA1);
            PG8_WAIT_V(8); PG8_WAIT_L(0); PG8_BAR; PG8_MMA(0, 0, At, B0); PG8_MMA(0, 1, At, B1); PG8_BAR; PG8_SCHED;
            PG8_LDA(At, 1, 1); PG8_STAGE(PG8_SB(1, 0), b3, voffB); PG8_STAGE(PG8_SB(1, 1), b3 + hstep, voffB); PG8_STAGE(PG8_SA(1, 0), a3, voffA0);
            PG8_WAIT_V(8); PG8_WAIT_L(0); PG8_BAR; PG8_MMA(1, 0, At, B0); PG8_MMA(1, 1, At, B1); PG8_BAR; PG8_SCHED;
        }
        if (wr == 0) PG8_BAR;
        E(acc, cur, wr, wc, fr, fq);
        if (GATHER) {
            Unit u2; const bool h2 = S.next(ui + 2, u2);
            if (h2) {
#pragma unroll
                for (int i = 0; i < 2; ++i) { int R, C; stage_rc(tid * 16 + i * 8192, R, C);
                    xoff[tid * 4 + i] = S.arow(u2, R) + (unsigned)C * 2u; xoff[tid * 4 + 2 + i] = S.arow(u2, R + HALF) + (unsigned)C * 2u; }
            }
        }
        if (!has_next) break;
#pragma unroll
        for (int a = 0; a < 2; ++a)
#pragma unroll
            for (int b = 0; b < 2; ++b)
#pragma unroll
                for (int m = 0; m < 4; ++m)
#pragma unroll
                    for (int n = 0; n < 2; ++n) acc[a][b][m][n] = (f32x4){0.f, 0.f, 0.f, 0.f};
        cur = nxt; cA = nA; cB = nB; ++ui;
        if (wr == 1) PG8_BAR;
    }
    PG8_WAIT_V(0);
    PG8_BAR;
#undef PG8_SA
#undef PG8_SB
#undef PG8_STAGE
#undef PG8_LDA
#undef PG8_LDB
#undef PG8_MMA
#undef PG8_WAIT_V
#undef PG8_WAIT_L
#undef PG8_BAR
#undef PG8_SCHED
}

struct DenseSched {
    const char* A; const char* B; int nN, total, G, c;
    __device__ __forceinline__ bool next(int i, Unit& u) const {
        const int per = G >> 3; const int L = (i * 8 + (c & 7)) * per + (c >> 3); if (L >= total) return false;
        const int pm = L / nN, pn = L % nN; u.a = A + (size_t)pm * (BM * KD * 2); u.b = B + (size_t)pn * (BM * KD * 2); u.t = pm; u.pn = pn; u.e = 0; u.mt = pm; return true;
    }
    __device__ __forceinline__ unsigned arow(const Unit&, int) const { return 0u; }
};
struct MoeSched {
    const char* A; const char* B; size_t b_expert_stride; const int* list; LAS const int* tstart; LAS const int* ecnt; int nN, total, G, c; bool tile_major_a;
    __device__ __forceinline__ bool next(int i, Unit& u) const {
        const int per = G >> 3; const int L = (i * 8 + (c & 7)) * per + (c >> 3); if (L >= total) return false;
        const int t = L / nN, pn = L % nN; int e = 0;
        for (int q = 1; q < NE; ++q) if (tstart[q] <= t) e = q;
        u.t = t; u.pn = pn; u.e = e; u.mt = t - tstart[e];
        u.a = tile_major_a ? A + (size_t)t * (BM * KD * 2) : A; u.b = B + (size_t)e * b_expert_stride + (size_t)pn * (BM * KD * 2); return true;
    }
    __device__ __forceinline__ unsigned arow(const Unit& u, int R) const {
        const int rank = u.mt * 256 + R; const int tok = rank < ecnt[u.e] ? (list[(size_t)u.e * M + rank] >> 2) : 0; return (unsigned)tok * (unsigned)(KD * 2);
    }
};

struct EpiResidual {
    static constexpr bool PERM = false;
    const float* res; float* o;
    __device__ __forceinline__ void operator()(const f32x4 (&acc)[2][2][4][2], const Unit& u, int wr, int wc, int fr, int fq) const {
        const int col0 = u.pn * BM + wc * 32 + 4 * fq;
#pragma unroll
        for (int ai = 0; ai < 2; ++ai)
#pragma unroll
            for (int m = 0; m < 4; ++m) { const size_t off = (size_t)(u.t * BM + ai * HALF + wr * 64 + m * 16 + fr) * DM + col0;
#pragma unroll
                for (int bj = 0; bj < 2; ++bj)
#pragma unroll
                    for (int n = 0; n < 2; ++n) { const f32x4 r = *(const f32x4*)(res + off + bj * HALF + n * 16); *(f32x4*)(o + off + bj * HALF + n * 16) = r + acc[ai][bj][m][n]; }
                if (m & 1) asm volatile("" ::: "memory"); }
    }
};
struct EpiSwiglu {
    static constexpr bool PERM = true;
    bf16_t* act; const float* b1;
    __device__ __forceinline__ void operator()(const f32x4 (&acc)[2][2][4][2], const Unit& u, int wr, int wc, int fr, int fq) const {
        const int c0 = u.pn * HALF + wc * 32 + 8 * fq; const float* bg = b1 + (size_t)u.e * 2048 + c0;
        f32x4 bv[2][2];
#pragma unroll
        for (int bj = 0; bj < 2; ++bj)
#pragma unroll
            for (int n = 0; n < 2; ++n) bv[bj][n] = *(const f32x4*)(bg + bj * 1024 + 4 * n);
#pragma unroll
        for (int ai = 0; ai < 2; ++ai)
#pragma unroll
            for (int m = 0; m < 4; ++m) {
                float a8[8];
#pragma unroll
                for (int n = 0; n < 2; ++n)
#pragma unroll
                    for (int i = 0; i < 4; ++i) {
                        const float glu = fminf(acc[ai][0][m][n][i] + bv[0][n][i], 7.0f), lin = fminf(fmaxf(acc[ai][1][m][n][i] + bv[1][n][i], -7.0f), 7.0f);
                        a8[4 * n + i] = glu * __builtin_amdgcn_rcpf(1.0f + __expf(-1.702f * glu)) * (lin + 1.0f);
                    }
                u32x4 w; w.x = cvt_pk_bf16(a8[0], a8[1]); w.y = cvt_pk_bf16(a8[2], a8[3]); w.z = cvt_pk_bf16(a8[4], a8[5]); w.w = cvt_pk_bf16(a8[6], a8[7]);
                *(u32x4*)(act + ((size_t)u.t * BM + ai * HALF + wr * 64 + m * 16 + fr) * DFF + c0) = w;
            }
    }
};
struct EpiGateScatter {
    static constexpr bool PERM = true;
    bf16_t* yb; const float* b2; const int* list; const float* glist; LAS const int* ecnt;
    __device__ __forceinline__ void operator()(const f32x4 (&acc)[2][2][4][2], const Unit& u, int wr, int wc, int fr, int fq) const {
        const int c0 = u.pn * BM + wc * 32 + 8 * fq; const float* bb = b2 + (size_t)u.e * DM + c0; const int cnt = ecnt[u.e];
        f32x4 bv[2][2];
#pragma unroll
        for (int bj = 0; bj < 2; ++bj)
#pragma unroll
            for (int n = 0; n < 2; ++n) bv[bj][n] = *(const f32x4*)(bb + bj * HALF + 4 * n);
#pragma unroll
        for (int ai = 0; ai < 2; ++ai)
#pragma unroll
            for (int m = 0; m < 4; ++m) {
                const int rank = u.mt * 256 + ai * HALF + wr * 64 + m * 16 + fr;
                if (rank < cnt) {
                    const int dest = list[(size_t)u.e * M + rank]; const float g = glist[(size_t)u.e * M + rank];
#pragma unroll
                    for (int bj = 0; bj < 2; ++bj) { const f32x4 v0 = (acc[ai][bj][m][0] + bv[bj][0]) * g, v1 = (acc[ai][bj][m][1] + bv[bj][1]) * g;
                        u32x4 w; w.x = cvt_pk_bf16(v0[0], v0[1]); w.y = cvt_pk_bf16(v0[2], v0[3]); w.z = cvt_pk_bf16(v1[0], v1[1]); w.w = cvt_pk_bf16(v1[2], v1[3]);
                        *(u32x4*)(yb + (size_t)dest * DM + c0 + bj * HALF) = w; }
                }
            }
    }
};
}

namespace attn_body {
typedef unsigned short bf16;
using bf16x8=__attribute__((ext_vector_type(8)))short;
using s16x4=__attribute__((ext_vector_type(4)))short;
using f32x16=__attribute__((ext_vector_type(16)))float;
using u32x4=__attribute__((ext_vector_type(4)))unsigned;
constexpr int D=64;
constexpr int NW=8,QBLK=32,QB=QBLK*NW,KVBLK=64;
__device__ __forceinline__ int crow(int r,int hi){return (r&3)+8*(r>>2)+4*hi;}
#define SBAR() __builtin_amdgcn_sched_barrier(0)
__device__ __forceinline__ void cmask(f32x16&p0,f32x16&p1,int jb,int qrel,int hi){
  const float NEG=-INFINITY; const int lim=qrel-(64*jb+4*hi);
  #pragma unroll
  for(int r=0;r<16;++r){const int kc=(r&3)+8*(r>>2); if(kc>lim)p0[r]=NEG; if(kc+32>lim)p1[r]=NEG;}
}

constexpr int NSLOT=3, SLOTB=8192;
constexpr int LDS_K=0, LDS_V=NSLOT*SLOTB, LDS_WS=2*NSLOT*SLOTB, LDS_OST=LDS_WS+NW*64*4, LDS_BYTES=LDS_OST+NW*4096;
constexpr float C2=0.125f*1.4426950408889634f;
__device__ __forceinline__ void glds16(const void*gsrc,unsigned lds_dst){unsigned keep;
  asm volatile("s_mov_b32 %0, m0\n\ts_mov_b32 m0, %2\n\ts_nop 0\n\tglobal_load_lds_dwordx4 %1, off\n\ts_mov_b32 m0, %0":"=&s"(keep):"v"(gsrc),"s"(lds_dst):"memory");}
__device__ __forceinline__ float max3f(float a,float b,float c){float r;asm("v_max3_f32 %0, %1, %2, %3":"=v"(r):"v"(a),"v"(b),"v"(c));return r;}
__device__ __forceinline__ float max2f(float a,float b){float r;asm("v_max_f32_e32 %0, %1, %2":"=v"(r):"v"(a),"v"(b));return r;}
__device__ __forceinline__ float fadd_s(float a,float b){float r;asm("v_add_f32_e32 %0, %1, %2":"=v"(r):"v"(a),"v"(b));return r;}
__device__ __forceinline__ float fsub_s(float a,float b){float r;asm("v_sub_f32_e32 %0, %1, %2":"=v"(r):"v"(a),"v"(b));return r;}
typedef float f32x2_t __attribute__((ext_vector_type(2))); typedef __bf16 bf16x2_t __attribute__((ext_vector_type(2)));
__device__ __forceinline__ unsigned cvtpk_s(float lo,float hi){f32x2_t v={lo,hi};bf16x2_t b=__builtin_convertvector(v,bf16x2_t);return __builtin_bit_cast(unsigned,b);}
#define WAIT_BAR(N) asm volatile("s_waitcnt vmcnt(" #N ") lgkmcnt(0)\n\ts_barrier":::"memory")

__device__ __forceinline__ void qkt(f32x16&p0,f32x16&p1,const char*Kslot,const bf16x8*qr,const f32x16&negm,int r32,int hi){
  const char*kb=Kslot+hi*1024+r32*16;
  #pragma unroll
  for(int d0=0;d0<4;++d0){
    const bf16x8 b0=*reinterpret_cast<const bf16x8*>(kb+d0*2048);
    const bf16x8 b1=*reinterpret_cast<const bf16x8*>(kb+d0*2048+512);
    if(d0==0){p0=__builtin_amdgcn_mfma_f32_32x32x16_bf16(b0,qr[0],negm,0,0,0);p1=__builtin_amdgcn_mfma_f32_32x32x16_bf16(b1,qr[0],negm,0,0,0);}
    else{p0=__builtin_amdgcn_mfma_f32_32x32x16_bf16(b0,qr[d0],p0,0,0,0);p1=__builtin_amdgcn_mfma_f32_32x32x16_bf16(b1,qr[d0],p1,0,0,0);}}
}
typedef __attribute__((address_space(3))) const char* lds_cptr;
typedef short v4i16_t __attribute__((ext_vector_type(4)));
__device__ __forceinline__ void kload8(bf16x8*kf,lds_cptr kp){
  kf[0]=*(const __attribute__((address_space(3))) bf16x8*)(kp);      kf[1]=*(const __attribute__((address_space(3))) bf16x8*)(kp+512);
  kf[2]=*(const __attribute__((address_space(3))) bf16x8*)(kp+2048); kf[3]=*(const __attribute__((address_space(3))) bf16x8*)(kp+2560);
  kf[4]=*(const __attribute__((address_space(3))) bf16x8*)(kp+4096); kf[5]=*(const __attribute__((address_space(3))) bf16x8*)(kp+4608);
  kf[6]=*(const __attribute__((address_space(3))) bf16x8*)(kp+6144); kf[7]=*(const __attribute__((address_space(3))) bf16x8*)(kp+6656);
}
__device__ __forceinline__ void kload2(bf16x8*kf,lds_cptr kp,int j){ kf[2*j]=*(const __attribute__((address_space(3))) bf16x8*)(kp+j*2048); kf[2*j+1]=*(const __attribute__((address_space(3))) bf16x8*)(kp+j*2048+512); }
__device__ __forceinline__ s16x4 vtr(lds_cptr p){ return __builtin_bit_cast(s16x4,__builtin_amdgcn_ds_read_tr16_b64_v4i16((__attribute__((address_space(3))) v4i16_t*)p)); }
__device__ __forceinline__ float rowmax(const f32x16&p0,const f32x16&p1){
  float a=max3f(p0[0],p0[1],p1[0]),b=max3f(p0[2],p0[3],p1[1]);a=max3f(a,p1[2],p1[3]);
  #pragma unroll
  for(int r=4;r<16;r+=4){a=max3f(a,p0[r],p0[r+1]);b=max3f(b,p0[r+2],p0[r+3]);a=max3f(a,p1[r],p1[r+1]);b=max3f(b,p1[r+2],p1[r+3]);}
  const float m=max2f(a,b);
  auto rr=__builtin_amdgcn_permlane32_swap(__float_as_uint(m),__float_as_uint(m),false,false);
  return max2f(__uint_as_float(rr[0]),__uint_as_float(rr[1]));
}
__device__ __forceinline__ void pv(f32x16*o,int vb,bf16x8 pa0,bf16x8 pa1,bf16x8 pa2,bf16x8 pa3){
  #pragma unroll
  for(int d0=0;d0<2;++d0){s16x4 lo[4],hi[4];
    #pragma unroll
    for(int ks=0;ks<4;++ks){
      asm volatile("ds_read_b64_tr_b16 %0,%1 offset:%c2":"=&v"(lo[ks]):"v"(vb),"i"(d0*4096+ks*1024):"memory");
      asm volatile("ds_read_b64_tr_b16 %0,%1 offset:%c2":"=&v"(hi[ks]):"v"(vb),"i"(d0*4096+ks*1024+512):"memory");}
    asm volatile("s_waitcnt lgkmcnt(0)":::"memory");SBAR();
    #define PK(k) (bf16x8){lo[k][0],lo[k][1],lo[k][2],lo[k][3],hi[k][0],hi[k][1],hi[k][2],hi[k][3]}
    o[d0]=__builtin_amdgcn_mfma_f32_32x32x16_bf16(pa0,PK(0),o[d0],0,0,0);
    o[d0]=__builtin_amdgcn_mfma_f32_32x32x16_bf16(pa1,PK(1),o[d0],0,0,0);
    o[d0]=__builtin_amdgcn_mfma_f32_32x32x16_bf16(pa2,PK(2),o[d0],0,0,0);
    o[d0]=__builtin_amdgcn_mfma_f32_32x32x16_bf16(pa3,PK(3),o[d0],0,0,0);
    #undef PK
  }
}

#ifndef ATTN_STORE16
#define ATTN_STORE16(p,v) (*(u32x4*)(p)=(v))
#endif
template<int THRL,int LDQ,int LDK,int LDV,int LDO,bool CAUSAL> __device__ __forceinline__ void attn_unit(const bf16*Qu,const bf16*__restrict__ Kh,const bf16*__restrict__ Vh,bf16*Ou,const int NT,char*shm){
  const int tid=threadIdx.x,lane=tid&63,r32=lane&31,hi=lane>>5; const int wid=__builtin_amdgcn_readfirstlane(tid>>6);
  const bf16*Qw=Qu+(long)(wid*QBLK)*LDQ;
  const unsigned lds0=(unsigned)(uintptr_t)shm;
  float*wsf=(float*)(shm+LDS_WS)+wid*64;
  const bf16*ksrc=Kh+(long)lane*LDK+wid*8;
  const bf16*vsrc=Vh+(long)(16*(wid&3)+(lane>>2))*LDV+(wid>>2)*32+(lane&3)*8;
  const unsigned kdst=lds0+LDS_K+wid*1024, vdst=lds0+LDS_V+wid*1024;
  #define DMA_K(t,slot) glds16(ksrc+(long)(t)*KVBLK*LDK,(unsigned)__builtin_amdgcn_readfirstlane(kdst+(slot)))
  #define DMA_V(t,slot) glds16(vsrc+(long)(t)*KVBLK*LDV,(unsigned)__builtin_amdgcn_readfirstlane(vdst+(slot)))
  const int vb0=(int)(lds0+LDS_V)+((lane>>4)&1)*32+(lane&3)*8+(4*hi+((lane&15)>>2))*64;
  const char*Kbase=shm+LDS_K; bf16x8 kf[8];
  const lds_cptr shm3=(lds_cptr)shm; const lds_cptr kp0=shm3+LDS_K+hi*1024+r32*16; const lds_cptr vp0=shm3+LDS_V+((lane>>4)&1)*32+(lane&3)*8+(4*hi+((lane&15)>>2))*64;
  DMA_K(0,0);DMA_V(0,0);DMA_K(1,SLOTB);
  bf16x8 qr[4];
  #pragma unroll
  for(int d0=0;d0<4;++d0)qr[d0]=*reinterpret_cast<const bf16x8*>(&Qw[(long)r32*LDQ+d0*16+hi*8]);
  float mhat=0.f,l_reg=0.f;f32x16 o[2];o[0]=f32x16{};o[1]=f32x16{};float nms=0.f; const f32x16 zero16=f32x16{};
  const int qrel=wid*QBLK+r32;
  #define CMASK(P0,P1,t) do{ if(CAUSAL){int jb_=(t)-(NT-4); if(jb_>=0)cmask(P0,P1,jb_,qrel,hi);} }while(0)
  bool resc=false;
  #define START(P0,P1) do{ const float rm=rowmax(P0,P1); resc=false; \
    { const float dl=rm; mhat=fadd_s(mhat,dl); \
      _Pragma("unroll") for(int r=0;r<16;++r){P0[r]=fsub_s(P0[r],dl);P1[r]=fsub_s(P1[r],dl);} \
      nms=-mhat; } \
    _Pragma("unroll") for(int r=0;r<16;++r)P0[r]=__builtin_amdgcn_exp2f(P0[r]); }while(0)
  #define RESC() do{ if(resc){ asm volatile("s_waitcnt lgkmcnt(0)":::"memory"); \
      _Pragma("unroll") for(int d_=0;d_<2;++d_) _Pragma("unroll") for(int r=0;r<16;++r)o[d_][r]*=wsf[crow(r,hi)]; } }while(0)
  f32x16 pA0,pA1,pB0,pB1;
  int sl_prev=0,sl_cur=0,sl_next=SLOTB;
  #define ROT() do{sl_prev=sl_cur;sl_cur=sl_next;sl_next=(sl_next==(NSLOT-1)*SLOTB)?0:sl_next+SLOTB;}while(0)
  DMA_K(2,2*SLOTB);
  WAIT_BAR(3);
  qkt(pA0,pA1,Kbase,qr,zero16,r32,hi);asm volatile("s_nop 15\n\ts_nop 7":"+v"(pA0),"+v"(pA1));CMASK(pA0,pA1,0);
  START(pA0,pA1);
  _Pragma("unroll") for(int r=0;r<16;++r)pA1[r]=__builtin_amdgcn_exp2f(pA1[r]);
  WAIT_BAR(0);
  DMA_K(3,0);DMA_V(1,SLOTB);
  ROT();
  kload8(kf,kp0+sl_cur);
  WAIT_BAR(2);
  s16x4 vlo[8],vhi[8]; u32x4 pw0,pw1,pw2,pw3;
  #define PKW(P,B) cvtpk_s(P[B],P[B+1])
  #define PAF(k) __builtin_bit_cast(bf16x8,pw##k)
  #define VFR(i) (bf16x8){vlo[i][0],vlo[i][1],vlo[i][2],vlo[i][3],vhi[i][0],vhi[i][1],vhi[i][2],vhi[i][3]}
  #define PIN(x) asm volatile("":"+v"(x))
  #define MX3(a,b,c) __builtin_fmaxf(__builtin_fmaxf((a),(b)),(c))
  #define GAPA(MF,A0,A1,A2,A3,W0,W1,PW) do{ MF; sacc+=A0; sacc+=A1; sacc+=A2; sacc+=A3; PIN(sacc); W0; W1; PIN(PW); SBAR(); }while(0)
  #define EX(v) __builtin_amdgcn_exp2f(v)
  #define GAPB(MF,X,B) do{ MF; X[B]=EX(X[B]); X[B+1]=EX(X[B+1]); X[B+2]=EX(X[B+2]); X[B+3]=EX(X[B+3]); PIN(X); SBAR(); }while(0)
  #define VRD(i) do{ vlo[i]=vtr(vp_+(((i)>>2)*4096+((i)&3)*1024)); vhi[i]=vtr(vp_+(((i)>>2)*4096+((i)&3)*1024+512)); }while(0)
  #define KRD(G,j) do{ if(G){ kload2(kf,kp0+sl_next,j); SBAR(); } }while(0)
  #define STEP(C0,C1,P0,P1,t,GK,GV,GL) do{ SBAR(); \
    const lds_cptr vp_=vp0+sl_prev; \
    VRD(0); SBAR(); float sacc=(P0[0]+P0[1]); \
    GAPA(C0=__builtin_amdgcn_mfma_f32_32x32x16_bf16(kf[0],qr[0],zero16,0,0,0), P0[2],P0[3],P0[4],P0[5],     pw0[0]=PKW(P0,0), pw0[1]=PKW(P0,2), pw0); \
    VRD(4); SBAR(); GAPA(C1=__builtin_amdgcn_mfma_f32_32x32x16_bf16(kf[1],qr[0],zero16,0,0,0), P0[6],P0[7],P0[8],P0[9],     pw0[2]=PKW(P0,4), pw0[3]=PKW(P0,6), pw0); \
    VRD(1); SBAR(); GAPA(C0=__builtin_amdgcn_mfma_f32_32x32x16_bf16(kf[2],qr[1],C0,0,0,0),   P0[10],P0[11],P0[12],P0[13], pw1[0]=PKW(P0,8), pw1[1]=PKW(P0,10), pw1); \
    VRD(5); SBAR(); GAPA(C1=__builtin_amdgcn_mfma_f32_32x32x16_bf16(kf[3],qr[1],C1,0,0,0),   P0[14],P0[15],P1[0],P1[1],   pw1[2]=PKW(P0,12),pw1[3]=PKW(P0,14), pw1); \
    VRD(2); SBAR(); GAPA(C0=__builtin_amdgcn_mfma_f32_32x32x16_bf16(kf[4],qr[2],C0,0,0,0),   P1[2],P1[3],P1[4],P1[5],     pw2[0]=PKW(P1,0), pw2[1]=PKW(P1,2), pw2); \
    VRD(6); SBAR(); GAPA(C1=__builtin_amdgcn_mfma_f32_32x32x16_bf16(kf[5],qr[2],C1,0,0,0),   P1[6],P1[7],P1[8],P1[9],     pw2[2]=PKW(P1,4), pw2[3]=PKW(P1,6), pw2); \
    VRD(3); SBAR(); GAPA(C0=__builtin_amdgcn_mfma_f32_32x32x16_bf16(kf[6],qr[3],C0,0,0,0),   P1[10],P1[11],P1[12],P1[13], pw3[0]=PKW(P1,8), pw3[1]=PKW(P1,10), pw3); \
    VRD(7); SBAR(); GAPA(C1=__builtin_amdgcn_mfma_f32_32x32x16_bf16(kf[7],qr[3],C1,0,0,0),   P1[14],P1[15],0.f,0.f,       pw3[2]=PKW(P1,12),pw3[3]=PKW(P1,14), pw3); \
    l_reg+=sacc; \
    _Pragma("unroll") for(int r=0;r<16;++r){C0[r]+=nms;C1[r]+=nms;} \
    if(GK){DMA_K((t)+3,sl_cur);} if(GV){DMA_V((t)+1,sl_next);} \
    CMASK(C0,C1,t); \
    { float a=MX3(C0[0],C0[1],C1[0]),b=MX3(C0[2],C0[3],C1[1]); a=MX3(a,C1[2],C1[3]); \
      _Pragma("unroll") for(int r=4;r<16;r+=4){a=MX3(a,C0[r],C0[r+1]);b=MX3(b,C0[r+2],C0[r+3]);a=MX3(a,C1[r],C1[r+1]);b=MX3(b,C1[r+2],C1[r+3]);} \
      float rm=__builtin_fmaxf(a,b); { auto rr=__builtin_amdgcn_permlane32_swap(__float_as_uint(rm),__float_as_uint(rm),false,false); rm=__builtin_fmaxf(__uint_as_float(rr[0]),__uint_as_float(rr[1])); } \
      resc=false; \
      if(__builtin_expect(__any(rm>(float)THRL),0)){ const float dl=__builtin_fmaxf(rm,0.f); mhat+=dl; \
        _Pragma("unroll") for(int r=0;r<16;++r){C0[r]-=dl;C1[r]-=dl;} \
        nms=-mhat; \
        const float f=__builtin_amdgcn_exp2f(-dl); l_reg*=f; if(hi==0)wsf[r32]=f; resc=true; } } \
    SBAR(); \
    GAPB(o[0]=__builtin_amdgcn_mfma_f32_32x32x16_bf16(PAF(0),VFR(0),o[0],0,0,0), C0,0); \
    GAPB(o[1]=__builtin_amdgcn_mfma_f32_32x32x16_bf16(PAF(0),VFR(4),o[1],0,0,0), C0,4); \
    KRD(GL,0); GAPB(o[0]=__builtin_amdgcn_mfma_f32_32x32x16_bf16(PAF(1),VFR(1),o[0],0,0,0), C0,8); \
    KRD(GL,1); GAPB(o[1]=__builtin_amdgcn_mfma_f32_32x32x16_bf16(PAF(1),VFR(5),o[1],0,0,0), C0,12); \
    KRD(GL,2); GAPB(o[0]=__builtin_amdgcn_mfma_f32_32x32x16_bf16(PAF(2),VFR(2),o[0],0,0,0), C1,0); \
    KRD(GL,3); GAPB(o[1]=__builtin_amdgcn_mfma_f32_32x32x16_bf16(PAF(2),VFR(6),o[1],0,0,0), C1,4); \
    GAPB(o[0]=__builtin_amdgcn_mfma_f32_32x32x16_bf16(PAF(3),VFR(3),o[0],0,0,0), C1,8); \
    GAPB(o[1]=__builtin_amdgcn_mfma_f32_32x32x16_bf16(PAF(3),VFR(7),o[1],0,0,0), C1,12); \
    }while(0)
  int t=1;
  #undef CMASK
  #define CMASK(P0,P1,t) do{}while(0)
  for(;t+5<NT;t+=2){
    STEP(pB0,pB1,pA0,pA1,t,true,true,true);     WAIT_BAR(2); RESC(); ROT();
    STEP(pA0,pA1,pB0,pB1,t+1,true,true,true);   WAIT_BAR(2); RESC(); ROT();
  }
  #undef CMASK
  #define CMASK(P0,P1,t) do{ if(CAUSAL){int jb_=(t)-(NT-4); if(jb_>=0)cmask(P0,P1,jb_,qrel,hi);} }while(0)
  #define ENDW(tt) do{ if((tt)+3<NT){WAIT_BAR(2);} else if((tt)+2<NT){WAIT_BAR(1);} else {WAIT_BAR(0);} }while(0)
  for(;t+1<NT;t+=2){
    STEP(pB0,pB1,pA0,pA1,t,(t+3<NT),(t+1<NT),(t+1<NT));       ENDW(t);   RESC(); ROT();
    STEP(pA0,pA1,pB0,pB1,t+1,(t+4<NT),(t+2<NT),(t+2<NT));     ENDW(t+1); RESC(); ROT();
  }
  STEP(pB0,pB1,pA0,pA1,NT-1,false,false,false); RESC();
  { float sacc=pB0[0]+pB0[1]; _Pragma("unroll") for(int r=2;r<16;++r)sacc+=pB0[r]; _Pragma("unroll") for(int r=0;r<16;++r)sacc+=pB1[r]; l_reg+=sacc;
    pw0=(u32x4){PKW(pB0,0),PKW(pB0,2),PKW(pB0,4),PKW(pB0,6)};pw1=(u32x4){PKW(pB0,8),PKW(pB0,10),PKW(pB0,12),PKW(pB0,14)};pw2=(u32x4){PKW(pB1,0),PKW(pB1,2),PKW(pB1,4),PKW(pB1,6)};pw3=(u32x4){PKW(pB1,8),PKW(pB1,10),PKW(pB1,12),PKW(pB1,14)};
    SBAR(); pv(o,vb0+sl_cur,PAF(0),PAF(1),PAF(2),PAF(3)); }
  #undef PKW
  #undef PAF
  #undef VFR
  #undef PIN
  #undef MX3
  #undef GAPA
  #undef GAPB
  #undef EX
  #undef VRD
  #undef KRD
  #undef STEP
  #undef ENDW
  {auto rr=__builtin_amdgcn_permlane32_swap(__float_as_uint(l_reg),__float_as_uint(l_reg),false,false);l_reg=__uint_as_float(rr[0])+__uint_as_float(rr[1]);}
  if(hi==0)wsf[32+r32]=l_reg;asm volatile("s_waitcnt lgkmcnt(0)":::"memory");
  float rli[16];
  #pragma unroll
  for(int r=0;r<16;++r)rli[r]=__builtin_amdgcn_rcpf(wsf[32+crow(r,hi)]);
  bf16*Ow=Ou+(long)(wid*QBLK)*LDO;
  { bf16*stg=(bf16*)(shm+LDS_OST)+wid*2048;
    unsigned sbase=lds0+LDS_OST+(unsigned)wid*4096u+(unsigned)hi*512u+(unsigned)r32*2u; asm volatile("":"+v"(sbase));
    typedef __attribute__((address_space(3))) bf16* lds_hptr;
    #pragma unroll
    for(int r=0;r<16;++r){
      #pragma unroll
      for(int d0=0;d0<2;++d0)*(lds_hptr)(sbase+(unsigned)(((r&3)+8*(r>>2))*128+d0*64))=(bf16)(cvtpk_s(o[d0][r]*rli[r],0.f)&0xffffu);}
    asm volatile("s_waitcnt lgkmcnt(0)":::"memory");
    #pragma unroll
    for(int i=0;i<4;++i){const int row=i*8+(lane>>3),ch=lane&7; const u32x4 v=*(const u32x4*)(stg+row*64+ch*8); ATTN_STORE16(Ow+(long)row*LDO+ch*8,v);} }
  asm volatile("s_waitcnt lgkmcnt(0)\n\ts_barrier":::"memory");
  #undef DMA_K
  #undef DMA_V
  #undef CMASK
  #undef START
  #undef RESC
  #undef ROT
}
constexpr int ATTN_LDS_BYTES=LDS_BYTES;
#undef SBAR
#undef WAIT_BAR
}

__global__ void __launch_bounds__(NTHREADS, 2) mk_fwd(Args args) {
    extern __shared__ __attribute__((aligned(16))) unsigned char lds_raw[];
    LAS unsigned char* lds = (LAS unsigned char*)lds_raw;
    const int tid = threadIdx.x, lane = tid & 63, wave = __builtin_amdgcn_readfirstlane(tid >> 6);
    const int G = gridDim.x, bid = blockIdx.x;
    const int gw = bid * NWAVES + wave, NGW = G * NWAVES;
#define DECL_ALL \
    unsigned char* ws = args.ws; \
    const float* x = (const float*)args.in[0]; const float* mem = (const float*)args.in[1]; const int* positions = (const int*)args.in[2]; \
    const float* g_mix = (const float*)args.in[3]; const float* w_in = (const float*)args.in[4]; \
    const float* g_dq = (const float*)args.in[5]; const float* g_dk = (const float*)args.in[6]; \
    const float* lq1 = (const float*)args.in[7]; const float* lk1 = (const float*)args.in[8]; const float* lq2 = (const float*)args.in[9]; const float* lk2 = (const float*)args.in[10]; \
    const float* g_sub = (const float*)args.in[11]; const float* g_sgu = (const float*)args.in[12]; \
    const float* w_sp = (const float*)args.in[13]; const float* b_sp = (const float*)args.in[14]; \
    const float* g_memn = (const float*)args.in[15]; const float* w_kv = (const float*)args.in[16]; \
    const float* g_cq = (const float*)args.in[17]; const float* g_ck = (const float*)args.in[18]; \
    const float* w_out = (const float*)args.in[19]; const float* g_ffn = (const float*)args.in[20]; \
    const float* w_router = (const float*)args.in[21]; const float* b_router = (const float*)args.in[22]; \
    const float* w_mlp1 = (const float*)args.in[23]; const float* b_mlp1 = (const float*)args.in[24]; \
    const float* w_mlp2 = (const float*)args.in[25]; const float* b_mlp2 = (const float*)args.in[26]; \
    float* out = args.out; \
    unsigned* ctl = (unsigned*)(ws + WS_CTL); \
    bf16_t* WIN_T = (bf16_t*)(ws + WS_WIN); bf16_t* WO_T = (bf16_t*)(ws + WS_WO); bf16_t* WKV_T = (bf16_t*)(ws + WS_WKV); \
    float* CS = (float*)(ws + WS_CS); int* LIST = (int*)(ws + WS_LIST); float* GLIST = (float*)(ws + WS_GLIST); \
    bf16_t* MEMN = (bf16_t*)(ws + WS_MEMN); bf16_t* MEMK = (bf16_t*)(ws + WS_MEMK); bf16_t* MEMV = (bf16_t*)(ws + WS_MEMV); \
    bf16_t* W1T = (bf16_t*)(ws + WS_W1); bf16_t* W2T = (bf16_t*)(ws + WS_W2); bf16_t* H2 = (bf16_t*)(ws + WS_H2); bf16_t* ACT = (bf16_t*)(ws + WS_ACT); \
    bf16_t* XN = (bf16_t*)(ws + WS_XN); bf16_t* QB = (bf16_t*)(ws + WS_QB); bf16_t* KB = (bf16_t*)(ws + WS_KB); bf16_t* VB = (bf16_t*)(ws + WS_VB); \
    bf16_t* UB = (bf16_t*)(ws + WS_UB); bf16_t* VGB = (bf16_t*)(ws + WS_VGB); bf16_t* MQB = (bf16_t*)(ws + WS_MQB); \
    bf16_t* CAT = (bf16_t*)(ws + WS_CAT); bf16_t* YB = (bf16_t*)(ws + WS_YB); bf16_t* OT = (bf16_t*)(ws + WS_OT); (void)OT; \
    float* PROJ = (float*)(ws + WS_PROJ); float* KVT = (float*)(ws + WS_KVT); \
    (void)x; (void)mem; (void)positions; (void)g_mix; (void)w_in; (void)g_dq; (void)g_dk; (void)lq1; (void)lk1; (void)lq2; (void)lk2; (void)g_sub; (void)g_sgu; (void)w_sp; (void)b_sp; \
    (void)g_memn; (void)w_kv; (void)g_cq; (void)g_ck; (void)w_out; (void)g_ffn; (void)w_router; (void)b_router; (void)w_mlp1; (void)b_mlp1; (void)w_mlp2; (void)b_mlp2; (void)out; (void)ctl; \
    (void)WIN_T; (void)WO_T; (void)WKV_T; (void)CS; (void)LIST; (void)GLIST; (void)MEMN; (void)MEMK; (void)MEMV; (void)W1T; (void)W2T; (void)H2; (void)ACT; (void)XN; (void)QB; (void)KB; (void)VB; \
    (void)UB; (void)VGB; (void)MQB; (void)CAT; (void)YB; (void)PROJ; (void)KVT;

    const int lo = args.ph_lo, hi = args.ph_hi;
#ifndef PHMASK
#define PHMASK 0x1ff
#endif
#define IN(k) (((PHMASK >> (k)) & 1) && lo <= (k) && (k) < hi)
#define BOTH(k) (IN(k) && IN((k) + 1))
#define GRID_BAR() do { __threadfence(); cg::this_grid().sync(); } while (0)

    if (IN(0)) {
        DECL_ALL
        LAS float* scr = (LAS float*)(lds + wave * 16384);
        constexpr int I_IN = 16 * (NPROJ / 32), I_O = 16 * 32, I_KV = 16 * 16, I_1 = 16 * 64, I_2 = 16 * 32;
        constexpr int NITEMS = I_IN + I_O + I_KV + NE * I_1 + NE * I_2;
        for (int it = gw; it < NITEMS; it += NGW) {
            int r = it;
            if (r < I_IN) { transpose_item(w_in, DM, NPROJ, WIN_T, scr, r, lane); continue; } r -= I_IN;
            if (r < I_O) { transpose_item(w_out, DM, DM, WO_T, scr, r, lane); continue; } r -= I_O;
            if (r < I_KV) { transpose_item(w_kv, DM, 512, WKV_T, scr, r, lane); continue; } r -= I_KV;
            if (r < NE * I_1) { const int e = r / I_1; transpose_item_p(w_mlp1 + (size_t)e * DM * 2048, DM, 2048, W1T + (size_t)e * 2048 * DM, scr, r % I_1, lane,
                                                                   [](int n) { const int half = n >> 10, q = n & 1023; return 256 * (q >> 7) + 128 * half + (q & 127); }); continue; } r -= NE * I_1;
            { const int e = r / I_2; transpose_item(w_mlp2 + (size_t)e * DFF * DM, DFF, DM, W2T + (size_t)e * DM * DFF, scr, r % I_2, lane); }
        }
        for (int m = gw; m < M; m += NGW) rms_row_to_bf16(x + (size_t)m * DM, g_mix, XN + (size_t)m * DM, lane);
        for (int m = gw; m < MM; m += NGW) rms_row_to_bf16(mem + (size_t)m * DM, g_memn, MEMN + (size_t)m * DM, lane);
        for (int i = bid * NTHREADS + tid; i < M * 8; i += G * NTHREADS) {
            const int tok = i >> 3, f = i & 7;
            const float inv = (float)exp2(-(double)f * 0.125 * 18.931568569324174);
            const float ang = (float)positions[tok] * inv;
            CS[(size_t)tok * 16 + f] = (float)cos((double)ang); CS[(size_t)tok * 16 + 8 + f] = (float)sin((double)ang);
        }
        if (bid == 0 && tid < 64) ctl[tid] = 0u;
        if (BOTH(0)) GRID_BAR();
    }

    if (IN(1)) {
        DECL_ALL
        constexpr int N1 = (M / 256) * (NPROJ / 64), N2 = (MM / 256) * (512 / 64);
        for (int it = bid; it < N1 + N2; it += G) {
            if (it < N1) {
                const int mt = it / (NPROJ / 64), nc = it % (NPROJ / 64);
                sgemm_item<1>(XN, DM, [](int r) { return r; }, WIN_T, WIN_T, DM, DM, mt * 256, nc * 64,
                              [=](int r, int c, float v, float) { PROJ[(size_t)r * NPROJ + c] = v; }, wave, lane);
            } else {
                const int j = it - N1, mt = j / 8, nc = j % 8;
                sgemm_item<1>(MEMN, DM, [](int r) { return r; }, WKV_T, WKV_T, DM, DM, mt * 256, nc * 64,
                              [=](int r, int c, float v, float) { KVT[(size_t)r * 512 + c] = v; }, wave, lane);
            }
        }
        if (BOTH(1)) GRID_BAR();
    }

    if (IN(2)) {
        DECL_ALL
        for (int m = gw; m < M; m += NGW) {
            const float* pr = PROJ + (size_t)m * NPROJ;
            const int i8 = lane & 7; const float cc = CS[(size_t)m * 16 + i8], sn = CS[(size_t)m * 16 + 8 + i8];
            for (int g = 0; g < 16; ++g) {
                const float v = pr[g * 64 + lane];
                const float rstd = 1.0f / sqrtf(wave_sum(v * v) * (1.f / 64) + EPS);
                float y = v * rstd * (g < 8 ? g_dq[lane] : g_dk[lane]);
                const float partner = __shfl_xor(y, 8);
                if (lane < 8) y = y * cc - partner * sn; else if (lane < 16) y = y * cc + partner * sn;
                if (g < 8) QB[(size_t)m * 512 + g * 64 + lane] = (bf16_t)f2bf(y * C2); else KB[(size_t)m * 512 + (g - 8) * 64 + lane] = (bf16_t)f2bf(y);
            }
            for (int j = 0; j < 8; ++j) VB[(size_t)m * 512 + j * 64 + lane] = (bf16_t)f2bf(pr[1024 + j * 64 + lane]);
            for (int j = 0; j < 4; ++j) UB[(size_t)m * 256 + j * 64 + lane] = (bf16_t)f2bf(gelu_tanh(pr[1536 + j * 64 + lane]));
            for (int j = 0; j < 4; ++j) VGB[(size_t)m * 256 + j * 64 + lane] = (bf16_t)f2bf(gelu_tanh(pr[1792 + j * 64 + lane]));
            for (int g = 0; g < 4; ++g) {
                const float v = pr[2048 + g * 64 + lane];
                const float rstd = 1.0f / sqrtf(wave_sum(v * v) * (1.f / 64) + EPS);
                MQB[(size_t)m * 256 + g * 64 + lane] = (bf16_t)f2bf(v * rstd * g_cq[lane] * C2);
            }
        }
        for (int m = gw; m < MM; m += NGW) {
            const float* pr = KVT + (size_t)m * 512;
            for (int g = 0; g < 4; ++g) {
                const float v = pr[g * 64 + lane];
                const float rstd = 1.0f / sqrtf(wave_sum(v * v) * (1.f / 64) + EPS);
                MEMK[(size_t)m * 256 + g * 64 + lane] = (bf16_t)f2bf(v * rstd * g_ck[lane]);
                MEMV[(size_t)m * 256 + g * 64 + lane] = (bf16_t)f2bf(pr[256 + g * 64 + lane]);
            }
        }
        if (BOTH(2)) GRID_BAR();
    }

    if (IN(3)) {
        DECL_ALL
        const int vcu = (G % 8 == 0) ? (bid % 8) * (G / 8) + bid / 8 : bid;
        for (int pair = vcu; pair < BATCH * 4 * 4; pair += G) {
            const int bh = pair >> 2, s4 = pair & 3, b = bh >> 2, h = bh & 3; const size_t rb = (size_t)b * SEQ;
            for (int u = 0; u < 8; ++u) {
                const int qb = (u & 4) ? 7 - s4 : s4, c = (u >> 1) & 1, half = u & 1;
                attn_body::attn_unit<8, 512, 512, 512, 1024, true>(QB + (rb + qb * 256) * 512 + (h * 2 + c) * 64, KB + rb * 512 + (h * 2 + c) * 64, VB + rb * 512 + h * 128 + half * 64,
                                                                   OT + (rb + qb * 256) * 1024 + h * 256 + c * 128 + half * 64, 4 * qb + 4, (char*)lds_raw);
            }
            asm volatile("s_waitcnt vmcnt(0)" ::: "memory");
            __builtin_amdgcn_fence(__ATOMIC_RELEASE, "agent"); __builtin_amdgcn_fence(__ATOMIC_ACQUIRE, "agent");
            asm volatile("s_waitcnt vmcnt(0)" ::: "memory");
            __syncthreads();
            int ln = lane; asm volatile("" : "+v"(ln));
            const float lam = __expf(wave_sum(lq1[ln] * lk1[ln])) - __expf(wave_sum(lq2[ln] * lk2[ln])) + 0.2f;
            const float gs0 = g_sub[2 * ln], gs1 = g_sub[2 * ln + 1];
            for (int rr = wave; rr < 512; rr += NWAVES) {
                const int qb = (rr & 256) ? 7 - s4 : s4; const size_t row = rb + qb * 256 + (rr & 255);
                const unsigned w1 = *(const unsigned*)(OT + row * 1024 + h * 256 + 2 * ln), w2 = *(const unsigned*)(OT + row * 1024 + h * 256 + 128 + 2 * ln);
                const float a0 = bf2f(w1 & 0xffffu) - lam * bf2f(w2 & 0xffffu), a1 = bf2f(w1 >> 16) - lam * bf2f(w2 >> 16);
                const float rstd = 0.8f / sqrtf(wave_sum(a0 * a0 + a1 * a1) * (1.f / 128) + EPS);
                *(unsigned*)(CAT + row * 1024 + h * 128 + 2 * ln) = pk2(a0 * rstd * gs0, a1 * rstd * gs1);
            }
        }
        for (int j = vcu; j < BATCH * 4 * 8; j += G) {
            const int bh = j >> 3, qb = j & 7, b = bh >> 2, h = bh & 3; const size_t rb = (size_t)b * SEQ;
            attn_body::attn_unit<8, 256, 256, 256, 1024, false>(MQB + (rb + qb * 256) * 256 + h * 64, MEMK + (size_t)b * MEML * 256 + h * 64, MEMV + (size_t)b * MEML * 256 + h * 64,
                                                                CAT + (rb + qb * 256) * 1024 + 768 + h * 64, MEML / 64, (char*)lds_raw);
        }
        __syncthreads();
        LAS float* vt = (LAS float*)lds;
        for (int it = bid; it < BATCH * 16; it += G) {
            const size_t r0 = (size_t)it * 128;
            for (int rr = wave; rr < 128; rr += NWAVES) {
                const u32x2 w = *(const u32x2*)(VGB + (r0 + rr) * 256 + 4 * lane);
                const float v0 = bf2f(w.x & 0xffffu), v1 = bf2f(w.x >> 16), v2 = bf2f(w.y & 0xffffu), v3 = bf2f(w.y >> 16);
                const float mean = wave_sum((v0 + v1) + (v2 + v3)) * (1.f / 256);
                const float d0 = v0 - mean, d1 = v1 - mean, d2 = v2 - mean, d3 = v3 - mean;
                const float rstd = 1.0f / sqrtf(wave_sum((d0 * d0 + d1 * d1) + (d2 * d2 + d3 * d3)) * (1.f / 256) + EPS);
                const f32x4 gg = *(const f32x4*)(g_sgu + 4 * lane);
                *(LAS f32x4*)(vt + rr * 256 + 4 * lane) = (f32x4){d0 * rstd * gg.x, d1 * rstd * gg.y, d2 * rstd * gg.z, d3 * rstd * gg.w};
            }
            __syncthreads();
            const int ch = tid & 255, g = ch >> 6;
            for (int i = 0; i < 64; ++i) {
                const int t = 2 * i + (tid >> 8);
                const float* wr = w_sp + ((size_t)g * 128 + t) * 128;
                float acc = 0.f;
                for (int s = 0; s <= t; ++s) acc += wr[s] * vt[s * 256 + ch];
                const float u = bf2f(UB[(r0 + t) * 256 + ch]);
                CAT[(r0 + t) * 1024 + 512 + ch] = (bf16_t)f2bf(u * (acc + b_sp[g * 128 + t]));
            }
            __syncthreads();
        }
        if (BOTH(3)) GRID_BAR();
    }

    if (IN(4)) {
        DECL_ALL
        pg8::DenseSched S{(const char*)CAT, (const char*)WO_T, DM / 256, (M / 256) * (DM / 256), G, bid};
        pg8::EpiResidual E{x, out};
        pg8::gemm_phase<pg8::EpiResidual, pg8::DenseSched, false>(lds, S, E, nullptr);
        if (BOTH(4)) GRID_BAR();
    }

    if (IN(5)) {
        DECL_ALL
        for (int m = gw; m < M; m += NGW) {
            const f32x4* xr = (const f32x4*)(out + (size_t)m * DM) + 4 * lane; const f32x4* gr = (const f32x4*)g_ffn + 4 * lane;
            f32x4 v[4]; float s = 0.f;
#pragma unroll
            for (int j = 0; j < 4; ++j) { v[j] = xr[j]; s += (v[j].x * v[j].x + v[j].y * v[j].y) + (v[j].z * v[j].z + v[j].w * v[j].w); }
            const float rstd = 1.0f / sqrtf(wave_sum(s) * (1.f / DM) + EPS);
            u32x2* o8 = (u32x2*)(H2 + (size_t)m * DM) + 4 * lane;
#pragma unroll
            for (int j = 0; j < 4; ++j) { const f32x4 gg = gr[j]; v[j].x *= rstd * gg.x; v[j].y *= rstd * gg.y; v[j].z *= rstd * gg.z; v[j].w *= rstd * gg.w;
                u32x2 w; w.x = pk2(v[j].x, v[j].y); w.y = pk2(v[j].z, v[j].w); o8[j] = w; }
            const f32x4* wr = (const f32x4*)(w_router + (size_t)lane * 16 * 32);
            LAS float* scr = (LAS float*)(lds + wave * 12800);
            LAS float* hs = scr + 2112 + lane * 17;
#pragma unroll
            for (int j = 0; j < 4; ++j)
#pragma unroll
                for (int i = 0; i < 4; ++i) hs[4 * j + i] = v[j][i];
            asm volatile("s_waitcnt lgkmcnt(0)" ::: "memory");
            float lg[32];
#pragma unroll
            for (int e = 0; e < 32; ++e) lg[e] = 0.f;
#pragma unroll 1
            for (int c = 0; c < 16; ++c) {
                const float hv = hs[c];
#pragma unroll
                for (int e4 = 0; e4 < 8; ++e4) { const f32x4 w = wr[c * 8 + e4]; lg[4 * e4] += hv * w.x; lg[4 * e4 + 1] += hv * w.y; lg[4 * e4 + 2] += hv * w.z; lg[4 * e4 + 3] += hv * w.w; }
            }
#pragma unroll
            for (int e = 0; e < 32; ++e) scr[e * 65 + lane] = lg[e];
            asm volatile("s_waitcnt lgkmcnt(0)" ::: "memory");
            const int e_me = lane & 31, half = lane >> 5;
            float tot = 0.f;
#pragma unroll
            for (int i = 0; i < 32; ++i) tot += scr[e_me * 65 + half * 32 + i];
            asm volatile("s_waitcnt lgkmcnt(0)" ::: "memory");
            tot += __shfl_xor(tot, 32);
            float myv = tot + b_router[e_me];
            float tv[4]; int ti[4];
#pragma unroll
            for (int k = 0; k < 4; ++k) {
                float bv = myv; int bi = e_me;
#pragma unroll
                for (int o = 1; o < 32; o <<= 1) { const float ov = __shfl_xor(bv, o); const int oi = __shfl_xor(bi, o); const bool take = (ov > bv) || (ov == bv && oi < bi); bv = take ? ov : bv; bi = take ? oi : bi; }
                tv[k] = bv; ti[k] = bi;
                if (e_me == bi) myv = -3.0e38f;
            }
            float ex[4], sum = 0.f;
#pragma unroll
            for (int k = 0; k < 4; ++k) { ex[k] = __expf(tv[k] - tv[0]); sum += ex[k]; }
            if (lane == 0) {
#pragma unroll
                for (int k = 0; k < 4; ++k) {
                    const unsigned r = atomicAdd(&ctl[ti[k]], 1u);
                    LIST[(size_t)ti[k] * M + r] = m * 4 + k; GLIST[(size_t)ti[k] * M + r] = ex[k] / sum;
                }
            }
        }
        if (BOTH(5)) GRID_BAR();
    }

    LAS int* tstart = (LAS int*)(lds + 140 * 1024); LAS int* ecnt = tstart + 40;
    if (IN(6) || IN(7)) {
        DECL_ALL
        __syncthreads();
        if (tid == 0) { int acc = 0; for (int e = 0; e < NE; ++e) { const int c = (int)__hip_atomic_load(&ctl[e], __ATOMIC_RELAXED, __HIP_MEMORY_SCOPE_AGENT); tstart[e] = acc; ecnt[e] = c; acc += (c + 255) / 256; } tstart[NE] = acc; }
        __syncthreads();
    }
    if (IN(6)) {
        DECL_ALL
        const int ntiles = tstart[NE];
        pg8::MoeSched S{(const char*)H2, (const char*)W1T, (size_t)2048 * DM * 2, LIST, tstart, ecnt, 8, ntiles * 8, G, bid, false};
        pg8::EpiSwiglu E{ACT, b_mlp1};
        pg8::gemm_phase<pg8::EpiSwiglu, pg8::MoeSched, true>(lds, S, E, (LAS unsigned*)(lds + 131072));
        if (BOTH(6)) GRID_BAR();
    }
    if (IN(7)) {
        DECL_ALL
        const int ntiles = tstart[NE];
        pg8::MoeSched S{(const char*)ACT, (const char*)W2T, (size_t)DM * DFF * 2, LIST, tstart, ecnt, 4, ntiles * 4, G, bid, true};
        pg8::EpiGateScatter E{YB, b_mlp2, LIST, GLIST, ecnt};
        pg8::gemm_phase<pg8::EpiGateScatter, pg8::MoeSched, false>(lds, S, E, nullptr);
        if (BOTH(7)) GRID_BAR();
    }
    if (IN(8)) {
        DECL_ALL
        for (size_t i = (size_t)bid * NTHREADS + tid; i < (size_t)M * DM / 4; i += (size_t)G * NTHREADS) {
            const size_t tok = i / (DM / 4); const int c = (int)(i % (DM / 4)) * 4;
            f32x4 a = *(const f32x4*)(out + tok * DM + c);
#pragma unroll
            for (int k = 0; k < 4; ++k) {
                const u32x2 w = *(const u32x2*)(YB + (tok * 4 + k) * DM + c);
                a.x += bf2f(w.x & 0xffffu); a.y += bf2f(w.x >> 16); a.z += bf2f(w.y & 0xffffu); a.w += bf2f(w.y >> 16);
            }
            *(f32x4*)(out + tok * DM + c) = a;
        }
    }
#undef IN
#undef BOTH
}

extern "C" void kernel_launch(void* const* d_in, const int* in_sizes, int n_in, void* d_out, int out_size, void* d_ws, size_t ws_size, hipStream_t stream) {
    static int grid = 0;
    if (grid == 0) {
        if (n_in != 27 || out_size != M * DM || ws_size < WS_END) { fprintf(stderr, "kernel_launch: unexpected problem (n_in %d out %d ws %zu)\n", n_in, out_size, ws_size); grid = -1; return; }
        int dev = 0, cus = 0, per_cu = 0;
        hipGetDevice(&dev); hipDeviceGetAttribute(&cus, hipDeviceAttributeMultiprocessorCount, dev);
        if (hipFuncSetAttribute((const void*)mk_fwd, hipFuncAttributeMaxDynamicSharedMemorySize, LDS_BYTES) != hipSuccess) { fprintf(stderr, "kernel_launch: hipFuncSetAttribute failed\n"); grid = -1; return; }
        hipOccupancyMaxActiveBlocksPerMultiprocessor(&per_cu, (const void*)mk_fwd, NTHREADS, LDS_BYTES);
        (void)hipGetLastError();
        if (per_cu < 1) { fprintf(stderr, "kernel_launch: occupancy query says %d blocks per CU\n", per_cu); per_cu = 1; }
        grid = cus;
    }
    if (grid < 0) return;
    Args a{};
    for (int i = 0; i < 27; ++i) a.in[i] = d_in[i];
    a.out = (float*)d_out; a.ws = (unsigned char*)d_ws;
    constexpr int NPH = 9;
    if (MK_N_LAUNCHES == 1) {
        a.ph_lo = 0; a.ph_hi = NPH;
        void* kargs[] = {&a};
        hipError_t e = hipLaunchCooperativeKernel((const void*)mk_fwd, dim3(grid), dim3(NTHREADS), kargs, LDS_BYTES, stream);
        if (e != hipSuccess) fprintf(stderr, "cooperative launch failed: %s (grid %d)\n", hipGetErrorString(e), grid);
    } else {
        for (int p = 0; p < NPH; ++p) { a.ph_lo = p; a.ph_hi = p + 1; hipLaunchKernelGGL(mk_fwd, dim3(grid), dim3(NTHREADS), LDS_BYTES, stream, a); }
    }
}
```

```cpp
#include <hip/hip_runtime.h>
#include <hip/hip_cooperative_groups.h>
#include <cstdio>
#include <cstdint>
namespace cg = cooperative_groups;

#ifndef MK_N_LAUNCHES
#define MK_N_LAUNCHES 1
#endif

constexpr int BATCH = 16, SEQ = 2048, DM = 1024, M = BATCH * SEQ;
constexpr int NPROJ = 2304;
constexpr int MEML = 256, MM = BATCH * MEML;
constexpr int NE = 32, TOPK = 4, DFF = 1024;
constexpr int MAXTILES = (M * TOPK) / 256 + NE;
constexpr int NSLOT = MAXTILES * 256;
constexpr float EPS = 1e-6f;
constexpr float C2 = 0.125f * 1.4426950408889634f;
constexpr int NWAVES = 8, NTHREADS = 512;
constexpr int LDS_BYTES = 147456;

constexpr size_t MiB = 1u << 20;
constexpr size_t WS_CTL = 0;
constexpr size_t WS_WIN = 2 * MiB, WS_WKV = WS_WIN + (size_t)NPROJ * DM * 2  , WS_WO = 8 * MiB, WS_CS = 10 * MiB, WS_LIST = 12 * MiB, WS_GLIST = 16 * MiB;
constexpr size_t WS_MEMN = 20 * MiB, WS_MEMK = 28 * MiB, WS_MEMV = 30 * MiB;
constexpr size_t WS_W1 = 32 * MiB, WS_W2 = 160 * MiB, WS_H2 = 224 * MiB, WS_ACT = 288 * MiB;
constexpr size_t WS_XN = 560 * MiB, WS_QB = 624 * MiB, WS_KB = 656 * MiB, WS_VB = 688 * MiB, WS_UB = 720 * MiB, WS_VGB = 736 * MiB, WS_MQB = 752 * MiB;
constexpr size_t WS_OT = 768 * MiB, WS_CAT = 832 * MiB, WS_END = 896 * MiB;
constexpr size_t WS_YB = 560 * MiB;
constexpr size_t WS_PROJ = 224 * MiB;
constexpr size_t WS_KVT = 512 * MiB;
static_assert(WS_ACT + (size_t)NSLOT * DFF * 2 <= WS_XN, "act");
static_assert(WS_PROJ + (size_t)M * NPROJ * 4 <= WS_KVT && WS_KVT + (size_t)MM * 512 * 4 <= WS_XN, "proj temp");

#define LAS __attribute__((address_space(3)))
typedef unsigned short bf16_t;
typedef short bf16x8 __attribute__((ext_vector_type(8)));
typedef float f32x4 __attribute__((ext_vector_type(4)));
typedef unsigned u32x4 __attribute__((ext_vector_type(4)));
typedef unsigned u32x2 __attribute__((ext_vector_type(2)));

__device__ __forceinline__ unsigned f2bf(float f) { unsigned u = __float_as_uint(f); return (u + 0x7fffu + ((u >> 16) & 1u)) >> 16; }
__device__ __forceinline__ float bf2f(unsigned h) { return __uint_as_float(h << 16); }
__device__ __forceinline__ unsigned pk2(float lo, float hi) { return f2bf(lo) | (f2bf(hi) << 16); }
__device__ __forceinline__ float wave_sum(float v) {
#pragma unroll
    for (int o = 1; o < 64; o <<= 1) v += __shfl_xor(v, o);
    return v;
}
__device__ __forceinline__ float gelu_tanh(float x) {
    const float y = 0.7978845608028654f * (x + 0.044715f * x * x * x);
    const float t = 1.f - 2.f / (1.f + __expf(2.f * y));
    return 0.5f * x * (1.f + t);
}

struct Args {
    const void* in[27]; float* out; unsigned char* ws; int ph_lo, ph_hi;
};

template <class RowMap>
__device__ __forceinline__ void transpose_item_p(const float* W, int K, int N, bf16_t* WT, LAS float* scr, int item, int lane, RowMap rm) {
    const int nblk = N / 32, kb = item / nblk, nb = item % nblk, k0 = 64 * kb, n0 = 32 * nb;
#pragma unroll 8
    for (int i = 0; i < 32; ++i) { const int kk = 2 * i + (lane >> 5); scr[kk * 33 + (lane & 31)] = W[(size_t)(k0 + kk) * N + n0 + (lane & 31)]; }
    asm volatile("s_waitcnt lgkmcnt(0)" ::: "memory");
    const int c = lane & 7;
#pragma unroll
    for (int j = 0; j < 4; ++j) { const int n = (lane >> 3) + 8 * j; const LAS float* s = scr + (8 * c) * 33 + n;
        u32x4 o; o.x = pk2(s[0 * 33], s[1 * 33]); o.y = pk2(s[2 * 33], s[3 * 33]); o.z = pk2(s[4 * 33], s[5 * 33]); o.w = pk2(s[6 * 33], s[7 * 33]);
        *(u32x4*)(WT + (size_t)rm(n0 + n) * K + k0 + 8 * c) = o; }
    asm volatile("s_waitcnt lgkmcnt(0)" ::: "memory");
}
__device__ __forceinline__ void transpose_item(const float* W, int K, int N, bf16_t* WT, LAS float* scr, int item, int lane) {
    const int nblk = N / 32, kb = item / nblk, nb = item % nblk, k0 = 64 * kb, n0 = 32 * nb;
#pragma unroll 8
    for (int i = 0; i < 32; ++i) { const int kk = 2 * i + (lane >> 5); scr[kk * 33 + (lane & 31)] = W[(size_t)(k0 + kk) * N + n0 + (lane & 31)]; }
    asm volatile("s_waitcnt lgkmcnt(0)" ::: "memory");
    const int c = lane & 7;
#pragma unroll
    for (int j = 0; j < 4; ++j) { const int n = (lane >> 3) + 8 * j; const LAS float* s = scr + (8 * c) * 33 + n;
        u32x4 o; o.x = pk2(s[0 * 33], s[1 * 33]); o.y = pk2(s[2 * 33], s[3 * 33]); o.z = pk2(s[4 * 33], s[5 * 33]); o.w = pk2(s[6 * 33], s[7 * 33]);
        *(u32x4*)(WT + (size_t)(n0 + n) * K + k0 + 8 * c) = o; }
    asm volatile("s_waitcnt lgkmcnt(0)" ::: "memory");
}
__device__ __forceinline__ void rms_row_to_bf16(const float* xrow, const float* g, bf16_t* orow, int lane) {
    const f32x4* xr = (const f32x4*)xrow + lane; const f32x4* gr = (const f32x4*)g + lane;
    f32x4 v[4]; float s = 0.f;
#pragma unroll
    for (int j = 0; j < 4; ++j) { v[j] = xr[64 * j]; s += (v[j].x * v[j].x + v[j].y * v[j].y) + (v[j].z * v[j].z + v[j].w * v[j].w); }
    const float rstd = 1.0f / sqrtf(wave_sum(s) * (1.f / DM) + EPS);
    u32x2* o8 = (u32x2*)orow + lane;
#pragma unroll
    for (int j = 0; j < 4; ++j) { const f32x4 gg = gr[64 * j]; u32x2 w; w.x = pk2(v[j].x * rstd * gg.x, v[j].y * rstd * gg.y); w.y = pk2(v[j].z * rstd * gg.z, v[j].w * rstd * gg.w); o8[64 * j] = w; }
}

template <int NB, class RowFn, class Epi>
__device__ __forceinline__ void sgemm_item(const bf16_t* A, int lda, RowFn rowfn, const bf16_t* Bt0, const bf16_t* Bt1, int ldb, int K, int m0, int n0, Epi epi, int wave, int lane) {
    const int fr = lane & 15, fq = lane >> 4;
    unsigned aoff[2], boff[4];
#pragma unroll
    for (int mi = 0; mi < 2; ++mi) aoff[mi] = (unsigned)rowfn(m0 + 32 * wave + 16 * mi + fr) * (unsigned)lda + 8u * fq;
#pragma unroll
    for (int ni = 0; ni < 4; ++ni) boff[ni] = (unsigned)(n0 + 16 * ni + fr) * (unsigned)ldb + 8u * fq;
    f32x4 acc[NB][2][4];
#pragma unroll
    for (int b = 0; b < NB; ++b)
#pragma unroll
        for (int mi = 0; mi < 2; ++mi)
#pragma unroll
            for (int ni = 0; ni < 4; ++ni) acc[b][mi][ni] = (f32x4){0.f, 0.f, 0.f, 0.f};
#pragma unroll 2
    for (int k0 = 0; k0 < K; k0 += 32) {
        bf16x8 a[2], bb[NB][4];
#pragma unroll
        for (int mi = 0; mi < 2; ++mi) a[mi] = *(const bf16x8*)(A + k0 + aoff[mi]);
#pragma unroll
        for (int ni = 0; ni < 4; ++ni) { bb[0][ni] = *(const bf16x8*)(Bt0 + k0 + boff[ni]); if (NB == 2) bb[NB - 1][ni] = *(const bf16x8*)(Bt1 + k0 + boff[ni]); }
#pragma unroll
        for (int b = 0; b < NB; ++b)
#pragma unroll
            for (int mi = 0; mi < 2; ++mi)
#pragma unroll
                for (int ni = 0; ni < 4; ++ni) acc[b][mi][ni] = __builtin_amdgcn_mfma_f32_16x16x32_bf16(a[mi], bb[b][ni], acc[b][mi][ni], 0, 0, 0);
    }
#pragma unroll
    for (int mi = 0; mi < 2; ++mi)
#pragma unroll
        for (int ni = 0; ni < 4; ++ni)
#pragma unroll
            for (int j = 0; j < 4; ++j) epi(m0 + 32 * wave + 16 * mi + 4 * fq + j, n0 + 16 * ni + fr, acc[0][mi][ni][j], acc[NB - 1][mi][ni][j]);
}

template <int DV, bool CAUSAL>
__device__ __forceinline__ void sattn_wave(const bf16_t* Qw, int ldq, const bf16_t* Kp, int ldk, const bf16_t* Vp, int ldv, int nblk, int q0, LAS bf16_t* pl, f32x4 (&o)[DV / 16], int lane) {
    const int fr = lane & 15, fq = lane >> 4;
    bf16x8 qa[2];
#pragma unroll
    for (int ks = 0; ks < 2; ++ks) qa[ks] = *(const bf16x8*)(Qw + (size_t)fr * ldq + 32 * ks + 8 * fq);
    float mrow[4], lpart[4];
#pragma unroll
    for (int j = 0; j < 4; ++j) { mrow[j] = -1e30f; lpart[j] = 0.f; }
#pragma unroll
    for (int nt = 0; nt < DV / 16; ++nt) o[nt] = (f32x4){0.f, 0.f, 0.f, 0.f};
    for (int kb = 0; kb < nblk; ++kb) {
        f32x4 s[2];
#pragma unroll
        for (int nt = 0; nt < 2; ++nt) {
            s[nt] = (f32x4){0.f, 0.f, 0.f, 0.f};
            const bf16_t* kr = Kp + (size_t)(kb * 32 + 16 * nt + fr) * ldk + 8 * fq;
#pragma unroll
            for (int ks = 0; ks < 2; ++ks) { const bf16x8 kf = *(const bf16x8*)(kr + 32 * ks); s[nt] = __builtin_amdgcn_mfma_f32_16x16x32_bf16(qa[ks], kf, s[nt], 0, 0, 0); }
        }
        if (CAUSAL) {
#pragma unroll
            for (int nt = 0; nt < 2; ++nt)
#pragma unroll
                for (int j = 0; j < 4; ++j) if (kb * 32 + 16 * nt + fr > q0 + 4 * fq + j) s[nt][j] = -1e30f;
        }
        float alpha[4];
#pragma unroll
        for (int j = 0; j < 4; ++j) {
            float mx = fmaxf(s[0][j], s[1][j]);
            mx = fmaxf(mx, __shfl_xor(mx, 1)); mx = fmaxf(mx, __shfl_xor(mx, 2)); mx = fmaxf(mx, __shfl_xor(mx, 4)); mx = fmaxf(mx, __shfl_xor(mx, 8));
            const float mn = fmaxf(mrow[j], mx);
            alpha[j] = exp2f(mrow[j] - mn); mrow[j] = mn;
            const float p0 = exp2f(s[0][j] - mn), p1 = exp2f(s[1][j] - mn);
            lpart[j] = lpart[j] * alpha[j] + p0 + p1;
            pl[(4 * fq + j) * 40 + fr] = (bf16_t)f2bf(p0); pl[(4 * fq + j) * 40 + 16 + fr] = (bf16_t)f2bf(p1);
        }
#pragma unroll
        for (int nt = 0; nt < DV / 16; ++nt)
#pragma unroll
            for (int j = 0; j < 4; ++j) o[nt][j] *= alpha[j];
        asm volatile("s_waitcnt lgkmcnt(0)" ::: "memory");
        const bf16x8 pa = *(const LAS bf16x8*)(pl + fr * 40 + 8 * fq);
        asm volatile("s_waitcnt lgkmcnt(0)" ::: "memory");
#pragma unroll
        for (int nt = 0; nt < DV / 16; ++nt) {
            bf16x8 vf;
#pragma unroll
            for (int jj = 0; jj < 8; ++jj) vf[jj] = (short)Vp[(size_t)(kb * 32 + 8 * fq + jj) * ldv + 16 * nt + fr];
            o[nt] = __builtin_amdgcn_mfma_f32_16x16x32_bf16(pa, vf, o[nt], 0, 0, 0);
        }
    }
#pragma unroll
    for (int j = 0; j < 4; ++j) {
        float l = lpart[j];
        l += __shfl_xor(l, 1); l += __shfl_xor(l, 2); l += __shfl_xor(l, 4); l += __shfl_xor(l, 8);
        const float rl = 1.0f / l;
#pragma unroll
        for (int nt = 0; nt < DV / 16; ++nt) o[nt][j] *= rl;
    }
}


namespace pg8 {
constexpr int BM = 256, BK = 64, HALF = 128, HTB = HALF * BK * 2, STAGE_BYTES = 8 * HTB, KD = 1024;
__device__ __forceinline__ int lds_byte(int r, int c) { const int st = (r >> 4) * 2 + (c >> 5), rr = r & 15, cc = c & 31, ob = rr * 64 + cc * 2; return st * 1024 + (ob ^ (((ob >> 9) & 1) << 5)); }
__device__ __forceinline__ void stage_rc(int b, int& R, int& C) { const int st = b / 1024, sb = b % 1024, swz = sb ^ (((sb >> 9) & 1) << 5); R = (st >> 1) * 16 + swz / 64; C = (st & 1) * 32 + (swz % 64) / 2; }
__device__ __forceinline__ int perm32(int rho) { const int n = rho >> 4, i = rho & 15; return 8 * (i >> 2) + 4 * n + (i & 3); }
__device__ __forceinline__ unsigned cvt_pk_bf16(float lo, float hi) { unsigned r; asm volatile("v_cvt_pk_bf16_f32 %0, %1, %2" : "=v"(r) : "v"(lo), "v"(hi)); return r; }

struct Unit { const char* a; const char* b; int t, pn, e, mt; };

template <class Epi, class Sched, bool GATHER>
__device__ __forceinline__ void gemm_phase(LAS unsigned char* lds, const Sched& S, const Epi& E, LAS unsigned* xoff) {
    const int tid = threadIdx.x, wid = __builtin_amdgcn_readfirstlane(tid >> 6), lane = tid & 63, wr = wid >> 2, wc = wid & 3, fr = lane & 15, fq = lane >> 4;
    constexpr int K = KD, nt = K / BK;
    unsigned voffA0[2], voffA1[2], voffB[2];
    Unit cur, nxt; int ui = 0;
    if (!S.next(0, cur)) return;
#pragma unroll
    for (int i = 0; i < 2; ++i) { int R, C; stage_rc(tid * 16 + i * 8192, R, C); const int Rb = Epi::PERM ? ((R & ~31) + perm32(R & 31)) : R;
        voffB[i] = (unsigned)(Rb * K + C) * 2u;
        if (GATHER) { voffA0[i] = S.arow(cur, R) + (unsigned)C * 2u; voffA1[i] = S.arow(cur, R + HALF) + (unsigned)C * 2u; }
        else { voffA0[i] = (unsigned)(R * K + C) * 2u; voffA1[i] = voffA0[i] + (unsigned)(HALF * K * 2); } }
    if (GATHER) {
        Unit u1; const bool h1 = S.next(1, u1);
#pragma unroll
        for (int i = 0; i < 2; ++i) { int R, C; stage_rc(tid * 16 + i * 8192, R, C);
            xoff[tid * 4 + i] = h1 ? S.arow(u1, R) + (unsigned)C * 2u : voffA0[i]; xoff[tid * 4 + 2 + i] = h1 ? S.arow(u1, R + HALF) + (unsigned)C * 2u : voffA1[i]; }
    }
    const size_t kstep = (size_t)(BK * 2);
    const size_t hstep = (size_t)HALF * K * 2;
    const unsigned ldsw = (unsigned)wid * 1024u;
    const int aoff = lds_byte(wr * 64 + fr, fq * 8), boff = lds_byte(wc * 32 + fr, fq * 8);
#define PG8_SA(b, h) (((b) * 2 + (h)) * HTB)
#define PG8_SB(b, h) ((4 + (b) * 2 + (h)) * HTB)
#define PG8_STAGE(bufoff, gbase, voff) do { _Pragma("unroll") for (int _i = 0; _i < 2; ++_i) \
        __builtin_amdgcn_global_load_lds((const unsigned*)((const char*)(gbase) + (voff)[_i]), (LAS unsigned*)(lds + (bufoff) + ldsw + _i * 8192), 16, 0, 0); } while (0)
#define PG8_LDA(dst, b, h) do { _Pragma("unroll") for (int m = 0; m < 4; ++m) _Pragma("unroll") for (int k = 0; k < 2; ++k) dst[m][k] = *(const LAS bf16x8*)(lds + PG8_SA(b, h) + aoff + m * 2048 + k * 1024); } while (0)
#define PG8_LDB(dst, b, h) do { _Pragma("unroll") for (int n = 0; n < 2; ++n) _Pragma("unroll") for (int k = 0; k < 2; ++k) dst[n][k] = *(const LAS bf16x8*)(lds + PG8_SB(b, h) + boff + n * 2048 + k * 1024); } while (0)
#define PG8_MMA(ai, bj, At, Bt) do { __builtin_amdgcn_s_setprio(1); _Pragma("unroll") for (int m = 0; m < 4; ++m) _Pragma("unroll") for (int n = 0; n < 2; ++n) _Pragma("unroll") for (int k = 0; k < 2; ++k) \
        acc[ai][bj][m][n] = __builtin_amdgcn_mfma_f32_16x16x32_bf16(Bt[n][k], At[m][k], acc[ai][bj][m][n], 0, 0, 0); __builtin_amdgcn_s_setprio(0); } while (0)
#define PG8_WAIT_V(n) asm volatile("s_waitcnt vmcnt(" #n ")" ::: "memory")
#define PG8_WAIT_L(n) asm volatile("s_waitcnt lgkmcnt(" #n ")" ::: "memory")
#define PG8_BAR __builtin_amdgcn_s_barrier()
#define PG8_SCHED __builtin_amdgcn_sched_barrier(0)
    f32x4 acc[2][2][4][2];
#pragma unroll
    for (int a = 0; a < 2; ++a)
#pragma unroll
        for (int b = 0; b < 2; ++b)
#pragma unroll
            for (int m = 0; m < 4; ++m)
#pragma unroll
                for (int n = 0; n < 2; ++n) acc[a][b][m][n] = (f32x4){0.f, 0.f, 0.f, 0.f};
    bf16x8 At[4][2], B0[2][2], B1[2][2];
    const char* cA = cur.a; const char* cB = cur.b;
    PG8_WAIT_V(0);
    PG8_STAGE(PG8_SB(0, 0), cB, voffB); PG8_STAGE(PG8_SB(0, 1), cB + hstep, voffB); PG8_STAGE(PG8_SA(0, 0), cA, voffA0); PG8_STAGE(PG8_SA(0, 1), cA, voffA1);
    if (wr == 1) PG8_BAR;
    PG8_WAIT_V(2); PG8_BAR;
    PG8_STAGE(PG8_SB(1, 0), cB + kstep, voffB); PG8_STAGE(PG8_SA(1, 0), cA + kstep, voffA0); PG8_STAGE(PG8_SB(1, 1), cB + hstep + kstep, voffB);
    PG8_WAIT_V(6); PG8_BAR;
    for (;;) {
        const bool has_next = S.next(ui + 1, nxt);
        const char* nA = has_next ? nxt.a : cA; const char* nB = has_next ? nxt.b : cB;
        for (int t = 0; t < nt; t += 2) {
            const bool last = (t == nt - 2);
            const char* a1 = cA + (size_t)(t + 1) * kstep;
            const char* a2 = last ? nA : cA + (size_t)(t + 2) * kstep; const char* b2 = last ? nB : cB + (size_t)(t + 2) * kstep;
            const char* a3 = a2 + kstep; const char* b3 = b2 + kstep;
            PG8_LDB(B0, 0, 0); PG8_LDB(B1, 0, 1); PG8_SCHED; PG8_LDA(At, 0, 0); PG8_STAGE(PG8_SA(1, 1), a1, voffA1);
            if (GATHER) { if (last && has_next) {
#pragma unroll
                for (int i = 0; i < 2; ++i) { voffA0[i] = xoff[tid * 4 + i]; voffA1[i] = xoff[tid * 4 + 2 + i]; } } }
            PG8_WAIT_V(8); PG8_WAIT_L(0); PG8_BAR; PG8_MMA(0, 0, At, B0); PG8_MMA(0, 1, At, B1); PG8_BAR; PG8_SCHED;
            PG8_LDA(At, 0, 1); PG8_STAGE(PG8_SB(0, 0), b2, voffB); PG8_STAGE(PG8_SB(0, 1), b2 + hstep, voffB); PG8_STAGE(PG8_SA(0, 0), a2, voffA0);
            PG8_WAIT_V(8); PG8_WAIT_L(0); PG8_BAR; PG8_MMA(1, 0, At, B0); PG8_MMA(1, 1, At, B1); PG8_BAR; PG8_SCHED;
            PG8_LDB(B0, 1, 0); PG8_LDB(B1, 1, 1); PG8_SCHED; PG8_LDA(At, 1, 0); PG8_STAGE(PG8_SA(0, 1), a2, voffA1);
            PG8_WAIT_V(8); PG8_WAIT_L(0); PG8_BAR; PG8_MMA(0, 0, At, B0); PG8_MMA(0, 1, At, B1); PG8_BAR; PG8_SCHED;
            PG8_LDA(At, 1, 1); PG8_STAGE(PG8_SB(1, 0), b3, voffB); PG8_STAGE(PG8_SB(1, 1), b3 + hstep, voffB); PG8_STAGE(PG8_SA(1, 0), a3, voffA0);
            PG8_WAIT_V(8); PG8_WAIT_L(0); PG8_BAR; PG8_MMA(1, 0, At, B0); PG8_MMA(1, 1, At, B1); PG8_BAR; PG8_SCHED;
        }
        if (wr == 0) PG8_BAR;
        E(acc, cur, wr, wc, fr, fq);
        if (GATHER) {
            Unit u2; const bool h2 = S.next(ui + 2, u2);
            if (h2) {
#pragma unroll
                for (int i = 0; i < 2; ++i) { int R, C; stage_rc(tid * 16 + i * 8192, R, C);
                    xoff[tid * 4 + i] = S.arow(u2, R) + (unsigned)C * 2u; xoff[tid * 4 + 2 + i] = S.arow(u2, R + HALF) + (unsigned)C * 2u; }
            }
        }
        if (!has_next) break;
#pragma unroll
        for (int a = 0; a < 2; ++a)
#pragma unroll
            for (int b = 0; b < 2; ++b)
#pragma unroll
                for (int m = 0; m < 4; ++m)
#pragma unroll
                    for (int n = 0; n < 2; ++n) acc[a][b][m][n] = (f32x4){0.f, 0.f, 0.f, 0.f};
        cur = nxt; cA = nA; cB = nB; ++ui;
        if (wr == 1) PG8_BAR;
    }
    PG8_WAIT_V(0);
    PG8_BAR;
#undef PG8_SA
#undef PG8_SB
#undef PG8_STAGE
#undef PG8_LDA
#undef PG8_LDB
#undef PG8_MMA
#undef PG8_WAIT_V
#undef PG8_WAIT_L
#undef PG8_BAR
#undef PG8_SCHED
}

struct DenseSched {
    const char* A; const char* B; int nN, total, G, c;
    __device__ __forceinline__ bool next(int i, Unit& u) const {
        const int per = G >> 3; const int L = (i * 8 + (c & 7)) * per + (c >> 3); if (L >= total) return false;
        const int pm = L / nN, pn = L % nN; u.a = A + (size_t)pm * (BM * KD * 2); u.b = B + (size_t)pn * (BM * KD * 2); u.t = pm; u.pn = pn; u.e = 0; u.mt = pm; return true;
    }
    __device__ __forceinline__ unsigned arow(const Unit&, int) const { return 0u; }
};
struct MoeSched {
    const char* A; const char* B; size_t b_expert_stride; const int* list; LAS const int* tstart; LAS const int* ecnt; int nN, total, G, c; bool tile_major_a;
    __device__ __forceinline__ bool next(int i, Unit& u) const {
        const int per = G >> 3; const int L = (i * 8 + (c & 7)) * per + (c >> 3); if (L >= total) return false;
        const int t = L / nN, pn = L % nN; int e = 0;
        for (int q = 1; q < NE; ++q) if (tstart[q] <= t) e = q;
        u.t = t; u.pn = pn; u.e = e; u.mt = t - tstart[e];
        u.a = tile_major_a ? A + (size_t)t * (BM * KD * 2) : A; u.b = B + (size_t)e * b_expert_stride + (size_t)pn * (BM * KD * 2); return true;
    }
    __device__ __forceinline__ unsigned arow(const Unit& u, int R) const {
        const int rank = u.mt * 256 + R; const int tok = rank < ecnt[u.e] ? (list[(size_t)u.e * M + rank] >> 2) : 0; return (unsigned)tok * (unsigned)(KD * 2);
    }
};

struct EpiResidual {
    static constexpr bool PERM = false;
    const float* res; float* o;
    __device__ __forceinline__ void operator()(const f32x4 (&acc)[2][2][4][2], const Unit& u, int wr, int wc, int fr, int fq) const {
        const int col0 = u.pn * BM + wc * 32 + 4 * fq;
#pragma unroll
        for (int ai = 0; ai < 2; ++ai)
#pragma unroll
            for (int m = 0; m < 4; ++m) { const size_t off = (size_t)(u.t * BM + ai * HALF + wr * 64 + m * 16 + fr) * DM + col0;
#pragma unroll
                for (int bj = 0; bj < 2; ++bj)
#pragma unroll
                    for (int n = 0; n < 2; ++n) { const f32x4 r = *(const f32x4*)(res + off + bj * HALF + n * 16); *(f32x4*)(o + off + bj * HALF + n * 16) = r + acc[ai][bj][m][n]; }
                if (m & 1) asm volatile("" ::: "memory"); }
    }
};
struct EpiSwiglu {
    static constexpr bool PERM = true;
    bf16_t* act; const float* b1;
    __device__ __forceinline__ void operator()(const f32x4 (&acc)[2][2][4][2], const Unit& u, int wr, int wc, int fr, int fq) const {
        const int c0 = u.pn * HALF + wc * 32 + 8 * fq; const float* bg = b1 + (size_t)u.e * 2048 + c0;
        f32x4 bv[2][2];
#pragma unroll
        for (int bj = 0; bj < 2; ++bj)
#pragma unroll
            for (int n = 0; n < 2; ++n) bv[bj][n] = *(const f32x4*)(bg + bj * 1024 + 4 * n);
#pragma unroll
        for (int ai = 0; ai < 2; ++ai)
#pragma unroll
            for (int m = 0; m < 4; ++m) {
                float a8[8];
#pragma unroll
                for (int n = 0; n < 2; ++n)
#pragma unroll
                    for (int i = 0; i < 4; ++i) {
                        const float glu = fminf(acc[ai][0][m][n][i] + bv[0][n][i], 7.0f), lin = fminf(fmaxf(acc[ai][1][m][n][i] + bv[1][n][i], -7.0f), 7.0f);
                        a8[4 * n + i] = glu * __builtin_amdgcn_rcpf(1.0f + __expf(-1.702f * glu)) * (lin + 1.0f);
                    }
                u32x4 w; w.x = cvt_pk_bf16(a8[0], a8[1]); w.y = cvt_pk_bf16(a8[2], a8[3]); w.z = cvt_pk_bf16(a8[4], a8[5]); w.w = cvt_pk_bf16(a8[6], a8[7]);
                *(u32x4*)(act + ((size_t)u.t * BM + ai * HALF + wr * 64 + m * 16 + fr) * DFF + c0) = w;
            }
    }
};
struct EpiGateScatter {
    static constexpr bool PERM = true;
    bf16_t* yb; const float* b2; const int* list; const float* glist; LAS const int* ecnt;
    __device__ __forceinline__ void operator()(const f32x4 (&acc)[2][2][4][2], const Unit& u, int wr, int wc, int fr, int fq) const {
        const int c0 = u.pn * BM + wc * 32 + 8 * fq; const float* bb = b2 + (size_t)u.e * DM + c0; const int cnt = ecnt[u.e];
        f32x4 bv[2][2];
#pragma unroll
        for (int bj = 0; bj < 2; ++bj)
#pragma unroll
            for (int n = 0; n < 2; ++n) bv[bj][n] = *(const f32x4*)(bb + bj * HALF + 4 * n);
#pragma unroll
        for (int ai = 0; ai < 2; ++ai)
#pragma unroll
            for (int m = 0; m < 4; ++m) {
                const int rank = u.mt * 256 + ai * HALF + wr * 64 + m * 16 + fr;
                if (rank < cnt) {
                    const int dest = list[(size_t)u.e * M + rank]; const float g = glist[(size_t)u.e * M + rank];
#pragma unroll
                    for (int bj = 0; bj < 2; ++bj) { const f32x4 v0 = (acc[ai][bj][m][0] + bv[bj][0]) * g, v1 = (acc[ai][bj][m][1] + bv[bj][1]) * g;
                        u32x4 w; w.x = cvt_pk_bf16(v0[0], v0[1]); w.y = cvt_pk_bf16(v0[2], v0[3]); w.z = cvt_pk_bf16(v1[0], v1[1]); w.w = cvt_pk_bf16(v1[2], v1[3]);
                        *(u32x4*)(yb + (size_t)dest * DM + c0 + bj * HALF) = w; }
                }
            }
    }
};

struct EpiInProj {
    static constexpr bool PERM = true;
    unsigned char* wsb;
    __device__ __forceinline__ void operator()(const f32x4 (&acc)[2][2][4][2], const Unit& u, int wr, int wc, int fr, int fq) const {
        const int pn = u.pn; const int row0 = u.t * BM + wr * 64 + fr;
        if (pn < 4 || pn == 8 || pn == 9) {
            const float* gp = (const float*)(wsb + WS_CTL + 4096) + 64 * (pn < 2 ? 0 : pn < 4 ? 1 : pn == 8 ? 2 : 3);
            const bool rope = pn < 4; const float sc = (pn < 2 || pn == 8) ? C2 : 1.0f;
            const size_t doff = pn < 2 ? WS_QB + (size_t)pn * 512 : pn < 4 ? WS_KB + (size_t)(pn - 2) * 512 : pn == 8 ? WS_MQB : WS_MEMK;
            bf16_t* dst = (bf16_t*)(wsb + doff); const int pitch = pn < 4 ? 512 : 256;
            const float* cs = (const float*)(wsb + WS_CS);
            f32x4 gv[2][2];
#pragma unroll
            for (int bj = 0; bj < 2; ++bj)
#pragma unroll
                for (int n = 0; n < 2; ++n) gv[bj][n] = *(const f32x4*)(gp + 16 * fq + 8 * bj + 4 * n) * sc;
#pragma unroll
            for (int ai = 0; ai < 2; ++ai)
#pragma unroll
                for (int m = 0; m < 4; ++m) {
                    const int row = row0 + ai * HALF + m * 16;
                    float ss = 0.f;
#pragma unroll
                    for (int bj = 0; bj < 2; ++bj)
#pragma unroll
                        for (int n = 0; n < 2; ++n) { const f32x4 v = acc[ai][bj][m][n]; ss += (v[0] * v[0] + v[1] * v[1]) + (v[2] * v[2] + v[3] * v[3]); }
                    ss += __shfl_xor(ss, 16); ss += __shfl_xor(ss, 32);
                    const float rstd = 1.0f / sqrtf(ss * (1.f / 64) + EPS);
                    f32x4 y[2][2];
#pragma unroll
                    for (int bj = 0; bj < 2; ++bj)
#pragma unroll
                        for (int n = 0; n < 2; ++n) y[bj][n] = acc[ai][bj][m][n] * rstd * gv[bj][n];
                    if (rope && fq == 0) {
#pragma unroll
                        for (int n = 0; n < 2; ++n) { const f32x4 c = *(const f32x4*)(cs + (size_t)row * 16 + 4 * n), sn = *(const f32x4*)(cs + (size_t)row * 16 + 8 + 4 * n);
                            const f32x4 x1 = y[0][n], x2 = y[1][n]; y[0][n] = x1 * c - x2 * sn; y[1][n] = x2 * c + x1 * sn; }
                    }
                    bf16_t* o = dst + (size_t)row * pitch + wc * 64 + 16 * fq;
#pragma unroll
                    for (int bj = 0; bj < 2; ++bj) { u32x4 w; w.x = cvt_pk_bf16(y[bj][0][0], y[bj][0][1]); w.y = cvt_pk_bf16(y[bj][0][2], y[bj][0][3]); w.z = cvt_pk_bf16(y[bj][1][0], y[bj][1][1]); w.w = cvt_pk_bf16(y[bj][1][2], y[bj][1][3]);
                        *(u32x4*)(o + 8 * bj) = w; }
                }
        } else {
            const bool act = (pn == 6 || pn == 7);
            const size_t doff = pn < 6 ? WS_VB + (size_t)(pn - 4) * 512 : pn == 6 ? WS_UB : pn == 7 ? WS_VGB : WS_MEMV;
            bf16_t* dst = (bf16_t*)(wsb + doff); const int pitch = pn < 6 ? 512 : 256;
#pragma unroll
            for (int ai = 0; ai < 2; ++ai)
#pragma unroll
                for (int m = 0; m < 4; ++m) {
                    bf16_t* o = dst + (size_t)(row0 + ai * HALF + m * 16) * pitch + wc * 32 + 8 * fq;
#pragma unroll
                    for (int bj = 0; bj < 2; ++bj) { f32x4 v0 = acc[ai][bj][m][0], v1 = acc[ai][bj][m][1];
                        if (act) {
#pragma unroll
                            for (int i = 0; i < 4; ++i) { v0[i] = gelu_tanh(v0[i]); v1[i] = gelu_tanh(v1[i]); } }
                        u32x4 w; w.x = cvt_pk_bf16(v0[0], v0[1]); w.y = cvt_pk_bf16(v0[2], v0[3]); w.z = cvt_pk_bf16(v1[0], v1[1]); w.w = cvt_pk_bf16(v1[2], v1[3]);
                        *(u32x4*)(o + bj * HALF) = w; }
                }
        }
    }
};
struct InProjSched {
    const char* XNb; const char* MEMNb; const char* B; int G, c;
    __device__ __forceinline__ bool next(int i, Unit& u) const {
        constexpr int N1 = (M / 256) * 9, N2 = (MM / 256) * 2;
        const int per = G >> 3; const int L = (i * 8 + (c & 7)) * per + (c >> 3); if (L >= N1 + N2) return false;
        int pm, pn; const char* a;
        if (L < N1) { pm = L / 9; pn = L % 9; a = XNb; } else { const int j = L - N1; pm = j >> 1; pn = 9 + (j & 1); a = MEMNb; }
        u.a = a + (size_t)pm * (BM * KD * 2); u.b = B + (size_t)pn * (BM * KD * 2); u.t = pm; u.pn = pn; u.e = 0; u.mt = pm; return true;
    }
    __device__ __forceinline__ unsigned arow(const Unit&, int) const { return 0u; }
};
}

namespace attn_body {
typedef unsigned short bf16;
using bf16x8=__attribute__((ext_vector_type(8)))short;
using s16x4=__attribute__((ext_vector_type(4)))short;
using f32x16=__attribute__((ext_vector_type(16)))float;
using u32x4=__attribute__((ext_vector_type(4)))unsigned;
constexpr int D=64;
constexpr int NW=8,QBLK=32,QB=QBLK*NW,KVBLK=64;
__device__ __forceinline__ int crow(int r,int hi){return (r&3)+8*(r>>2)+4*hi;}
#define SBAR() __builtin_amdgcn_sched_barrier(0)
__device__ __forceinline__ void cmask(f32x16&p0,f32x16&p1,int jb,int qrel,int hi){
  const float NEG=-INFINITY; const int lim=qrel-(64*jb+4*hi);
  #pragma unroll
  for(int r=0;r<16;++r){const int kc=(r&3)+8*(r>>2); if(kc>lim)p0[r]=NEG; if(kc+32>lim)p1[r]=NEG;}
}

constexpr int NSLOT=3, SLOTB=8192;
constexpr int LDS_K=0, LDS_V=NSLOT*SLOTB, LDS_WS=2*NSLOT*SLOTB, LDS_OST=LDS_WS+NW*64*4, LDS_BYTES=LDS_OST+NW*4096;
constexpr float C2=0.125f*1.4426950408889634f;
__device__ __forceinline__ void glds16(const void*gsrc,unsigned lds_dst){unsigned keep;
  asm volatile("s_mov_b32 %0, m0\n\ts_mov_b32 m0, %2\n\ts_nop 0\n\tglobal_load_lds_dwordx4 %1, off\n\ts_mov_b32 m0, %0":"=&s"(keep):"v"(gsrc),"s"(lds_dst):"memory");}
__device__ __forceinline__ float max3f(float a,float b,float c){float r;asm("v_max3_f32 %0, %1, %2, %3":"=v"(r):"v"(a),"v"(b),"v"(c));return r;}
__device__ __forceinline__ float max2f(float a,float b){float r;asm("v_max_f32_e32 %0, %1, %2":"=v"(r):"v"(a),"v"(b));return r;}
__device__ __forceinline__ float fadd_s(float a,float b){float r;asm("v_add_f32_e32 %0, %1, %2":"=v"(r):"v"(a),"v"(b));return r;}
__device__ __forceinline__ float fsub_s(float a,float b){float r;asm("v_sub_f32_e32 %0, %1, %2":"=v"(r):"v"(a),"v"(b));return r;}
typedef float f32x2_t __attribute__((ext_vector_type(2))); typedef __bf16 bf16x2_t __attribute__((ext_vector_type(2)));
__device__ __forceinline__ unsigned cvtpk_s(float lo,float hi){f32x2_t v={lo,hi};bf16x2_t b=__builtin_convertvector(v,bf16x2_t);return __builtin_bit_cast(unsigned,b);}
#define WAIT_BAR(N) asm volatile("s_waitcnt vmcnt(" #N ") lgkmcnt(0)\n\ts_barrier":::"memory")

__device__ __forceinline__ void qkt(f32x16&p0,f32x16&p1,const char*Kslot,const bf16x8*qr,const f32x16&negm,int r32,int hi){
  const char*kb=Kslot+hi*1024+r32*16;
  #pragma unroll
  for(int d0=0;d0<4;++d0){
    const bf16x8 b0=*reinterpret_cast<const bf16x8*>(kb+d0*2048);
    const bf16x8 b1=*reinterpret_cast<const bf16x8*>(kb+d0*2048+512);
    if(d0==0){p0=__builtin_amdgcn_mfma_f32_32x32x16_bf16(b0,qr[0],negm,0,0,0);p1=__builtin_amdgcn_mfma_f32_32x32x16_bf16(b1,qr[0],negm,0,0,0);}
    else{p0=__builtin_amdgcn_mfma_f32_32x32x16_bf16(b0,qr[d0],p0,0,0,0);p1=__builtin_amdgcn_mfma_f32_32x32x16_bf16(b1,qr[d0],p1,0,0,0);}}
}
typedef __attribute__((address_space(3))) const char* lds_cptr;
typedef short v4i16_t __attribute__((ext_vector_type(4)));
__device__ __forceinline__ void kload8(bf16x8*kf,lds_cptr kp){
  kf[0]=*(const __attribute__((address_space(3))) bf16x8*)(kp);      kf[1]=*(const __attribute__((address_space(3))) bf16x8*)(kp+512);
  kf[2]=*(const __attribute__((address_space(3))) bf16x8*)(kp+2048); kf[3]=*(const __attribute__((address_space(3))) bf16x8*)(kp+2560);
  kf[4]=*(const __attribute__((address_space(3))) bf16x8*)(kp+4096); kf[5]=*(const __attribute__((address_space(3))) bf16x8*)(kp+4608);
  kf[6]=*(const __attribute__((address_space(3))) bf16x8*)(kp+6144); kf[7]=*(const __attribute__((address_space(3))) bf16x8*)(kp+6656);
}
__device__ __forceinline__ void kload2(bf16x8*kf,lds_cptr kp,int j){ kf[2*j]=*(const __attribute__((address_space(3))) bf16x8*)(kp+j*2048); kf[2*j+1]=*(const __attribute__((address_space(3))) bf16x8*)(kp+j*2048+512); }
__device__ __forceinline__ s16x4 vtr(lds_cptr p){ return __builtin_bit_cast(s16x4,__builtin_amdgcn_ds_read_tr16_b64_v4i16((__attribute__((address_space(3))) v4i16_t*)p)); }
__device__ __forceinline__ float rowmax(const f32x16&p0,const f32x16&p1){
  float a=max3f(p0[0],p0[1],p1[0]),b=max3f(p0[2],p0[3],p1[1]);a=max3f(a,p1[2],p1[3]);
  #pragma unroll
  for(int r=4;r<16;r+=4){a=max3f(a,p0[r],p0[r+1]);b=max3f(b,p0[r+2],p0[r+3]);a=max3f(a,p1[r],p1[r+1]);b=max3f(b,p1[r+2],p1[r+3]);}
  const float m=max2f(a,b);
  auto rr=__builtin_amdgcn_permlane32_swap(__float_as_uint(m),__float_as_uint(m),false,false);
  return max2f(__uint_as_float(rr[0]),__uint_as_float(rr[1]));
}
__device__ __forceinline__ void pv(f32x16*o,int vb,bf16x8 pa0,bf16x8 pa1,bf16x8 pa2,bf16x8 pa3){
  #pragma unroll
  for(int d0=0;d0<2;++d0){s16x4 lo[4],hi[4];
    #pragma unroll
    for(int ks=0;ks<4;++ks){
      asm volatile("ds_read_b64_tr_b16 %0,%1 offset:%c2":"=&v"(lo[ks]):"v"(vb),"i"(d0*4096+ks*1024):"memory");
      asm volatile("ds_read_b64_tr_b16 %0,%1 offset:%c2":"=&v"(hi[ks]):"v"(vb),"i"(d0*4096+ks*1024+512):"memory");}
    asm volatile("s_waitcnt lgkmcnt(0)":::"memory");SBAR();
    #define PK(k) (bf16x8){lo[k][0],lo[k][1],lo[k][2],lo[k][3],hi[k][0],hi[k][1],hi[k][2],hi[k][3]}
    o[d0]=__builtin_amdgcn_mfma_f32_32x32x16_bf16(pa0,PK(0),o[d0],0,0,0);
    o[d0]=__builtin_amdgcn_mfma_f32_32x32x16_bf16(pa1,PK(1),o[d0],0,0,0);
    o[d0]=__builtin_amdgcn_mfma_f32_32x32x16_bf16(pa2,PK(2),o[d0],0,0,0);
    o[d0]=__builtin_amdgcn_mfma_f32_32x32x16_bf16(pa3,PK(3),o[d0],0,0,0);
    #undef PK
  }
}

#ifndef ATTN_STORE16
#define ATTN_STORE16(p,v) (*(u32x4*)(p)=(v))
#endif
template<int THRL,int LDQ,int LDK,int LDV,int LDO,bool CAUSAL> __device__ __forceinline__ void attn_unit(const bf16*Qu,const bf16*__restrict__ Kh,const bf16*__restrict__ Vh,bf16*Ou,const int NT,char*shm){
  const int tid=threadIdx.x,lane=tid&63,r32=lane&31,hi=lane>>5; const int wid=__builtin_amdgcn_readfirstlane(tid>>6);
  const bf16*Qw=Qu+(long)(wid*QBLK)*LDQ;
  const unsigned lds0=(unsigned)(uintptr_t)shm;
  float*wsf=(float*)(shm+LDS_WS)+wid*64;
  const bf16*ksrc=Kh+(long)lane*LDK+wid*8;
  const bf16*vsrc=Vh+(long)(16*(wid&3)+(lane>>2))*LDV+(wid>>2)*32+(lane&3)*8;
  const unsigned kdst=lds0+LDS_K+wid*1024, vdst=lds0+LDS_V+wid*1024;
  #define DMA_K(t,slot) glds16(ksrc+(long)(t)*KVBLK*LDK,(unsigned)__builtin_amdgcn_readfirstlane(kdst+(slot)))
  #define DMA_V(t,slot) glds16(vsrc+(long)(t)*KVBLK*LDV,(unsigned)__builtin_amdgcn_readfirstlane(vdst+(slot)))
  const int vb0=(int)(lds0+LDS_V)+((lane>>4)&1)*32+(lane&3)*8+(4*hi+((lane&15)>>2))*64;
  const char*Kbase=shm+LDS_K; bf16x8 kf[8];
  const lds_cptr shm3=(lds_cptr)shm; const lds_cptr kp0=shm3+LDS_K+hi*1024+r32*16; const lds_cptr vp0=shm3+LDS_V+((lane>>4)&1)*32+(lane&3)*8+(4*hi+((lane&15)>>2))*64;
  DMA_K(0,0);DMA_V(0,0);DMA_K(1,SLOTB);
  bf16x8 qr[4];
  #pragma unroll
  for(int d0=0;d0<4;++d0)qr[d0]=*reinterpret_cast<const bf16x8*>(&Qw[(long)r32*LDQ+d0*16+hi*8]);
  float mhat=0.f,l_reg=0.f;f32x16 o[2];o[0]=f32x16{};o[1]=f32x16{};float nms=0.f; const f32x16 zero16=f32x16{};
  const int qrel=wid*QBLK+r32;
  #define CMASK(P0,P1,t) do{ if(CAUSAL){int jb_=(t)-(NT-4); if(jb_>=0)cmask(P0,P1,jb_,qrel,hi);} }while(0)
  bool resc=false;
  #define START(P0,P1) do{ const float rm=rowmax(P0,P1); resc=false; \
    { const float dl=rm; mhat=fadd_s(mhat,dl); \
      _Pragma("unroll") for(int r=0;r<16;++r){P0[r]=fsub_s(P0[r],dl);P1[r]=fsub_s(P1[r],dl);} \
      nms=-mhat; } \
    _Pragma("unroll") for(int r=0;r<16;++r)P0[r]=__builtin_amdgcn_exp2f(P0[r]); }while(0)
  #define RESC() do{ if(resc){ asm volatile("s_waitcnt lgkmcnt(0)":::"memory"); \
      _Pragma("unroll") for(int d_=0;d_<2;++d_) _Pragma("unroll") for(int r=0;r<16;++r)o[d_][r]*=wsf[crow(r,hi)]; } }while(0)
  f32x16 pA0,pA1,pB0,pB1;
  int sl_prev=0,sl_cur=0,sl_next=SLOTB;
  #define ROT() do{sl_prev=sl_cur;sl_cur=sl_next;sl_next=(sl_next==(NSLOT-1)*SLOTB)?0:sl_next+SLOTB;}while(0)
  DMA_K(2,2*SLOTB);
  WAIT_BAR(3);
  qkt(pA0,pA1,Kbase,qr,zero16,r32,hi);asm volatile("s_nop 15\n\ts_nop 7":"+v"(pA0),"+v"(pA1));CMASK(pA0,pA1,0);
  START(pA0,pA1);
  _Pragma("unroll") for(int r=0;r<16;++r)pA1[r]=__builtin_amdgcn_exp2f(pA1[r]);
  WAIT_BAR(0);
  DMA_K(3,0);DMA_V(1,SLOTB);
  ROT();
  kload8(kf,kp0+sl_cur);
  WAIT_BAR(2);
  s16x4 vlo[8],vhi[8]; u32x4 pw0,pw1,pw2,pw3;
  #define PKW(P,B) cvtpk_s(P[B],P[B+1])
  #define PAF(k) __builtin_bit_cast(bf16x8,pw##k)
  #define VFR(i) (bf16x8){vlo[i][0],vlo[i][1],vlo[i][2],vlo[i][3],vhi[i][0],vhi[i][1],vhi[i][2],vhi[i][3]}
  #define PIN(x) asm volatile("":"+v"(x))
  #define MX3(a,b,c) __builtin_fmaxf(__builtin_fmaxf((a),(b)),(c))
  #define GAPA(MF,A0,A1,A2,A3,W0,W1,PW) do{ MF; sacc+=A0; sacc+=A1; sacc+=A2; sacc+=A3; PIN(sacc); W0; W1; PIN(PW); SBAR(); }while(0)
  #define EX(v) __builtin_amdgcn_exp2f(v)
  #define GAPB(MF,X,B) do{ MF; X[B]=EX(X[B]); X[B+1]=EX(X[B+1]); X[B+2]=EX(X[B+2]); X[B+3]=EX(X[B+3]); PIN(X); SBAR(); }while(0)
  #define VRD(i) do{ vlo[i]=vtr(vp_+(((i)>>2)*4096+((i)&3)*1024)); vhi[i]=vtr(vp_+(((i)>>2)*4096+((i)&3)*1024+512)); }while(0)
  #define KRD(G,j) do{ if(G){ kload2(kf,kp0+sl_next,j); SBAR(); } }while(0)
  #define STEP(C0,C1,P0,P1,t,GK,GV,GL) do{ SBAR(); \
    const lds_cptr vp_=vp0+sl_prev; \
    VRD(0); SBAR(); float sacc=(P0[0]+P0[1]); \
    GAPA(C0=__builtin_amdgcn_mfma_f32_32x32x16_bf16(kf[0],qr[0],zero16,0,0,0), P0[2],P0[3],P0[4],P0[5],     pw0[0]=PKW(P0,0), pw0[1]=PKW(P0,2), pw0); \
    VRD(4); SBAR(); GAPA(C1=__builtin_amdgcn_mfma_f32_32x32x16_bf16(kf[1],qr[0],zero16,0,0,0), P0[6],P0[7],P0[8],P0[9],     pw0[2]=PKW(P0,4), pw0[3]=PKW(P0,6), pw0); \
    VRD(1); SBAR(); GAPA(C0=__builtin_amdgcn_mfma_f32_32x32x16_bf16(kf[2],qr[1],C0,0,0,0),   P0[10],P0[11],P0[12],P0[13], pw1[0]=PKW(P0,8), pw1[1]=PKW(P0,10), pw1); \
    VRD(5); SBAR(); GAPA(C1=__builtin_amdgcn_mfma_f32_32x32x16_bf16(kf[3],qr[1],C1,0,0,0),   P0[14],P0[15],P1[0],P1[1],   pw1[2]=PKW(P0,12),pw1[3]=PKW(P0,14), pw1); \
    VRD(2); SBAR(); GAPA(C0=__builtin_amdgcn_mfma_f32_32x32x16_bf16(kf[4],qr[2],C0,0,0,0),   P1[2],P1[3],P1[4],P1[5],     pw2[0]=PKW(P1,0), pw2[1]=PKW(P1,2), pw2); \
    VRD(6); SBAR(); GAPA(C1=__builtin_amdgcn_mfma_f32_32x32x16_bf16(kf[5],qr[2],C1,0,0,0),   P1[6],P1[7],P1[8],P1[9],     pw2[2]=PKW(P1,4), pw2[3]=PKW(P1,6), pw2); \
    VRD(3); SBAR(); GAPA(C0=__builtin_amdgcn_mfma_f32_32x32x16_bf16(kf[6],qr[3],C0,0,0,0),   P1[10],P1[11],P1[12],P1[13], pw3[0]=PKW(P1,8), pw3[1]=PKW(P1,10), pw3); \
    VRD(7); SBAR(); GAPA(C1=__builtin_amdgcn_mfma_f32_32x32x16_bf16(kf[7],qr[3],C1,0,0,0),   P1[14],P1[15],0.f,0.f,       pw3[2]=PKW(P1,12),pw3[3]=PKW(P1,14), pw3); \
    l_reg+=sacc; \
    _Pragma("unroll") for(int r=0;r<16;++r){C0[r]+=nms;C1[r]+=nms;} \
    if(GK){DMA_K((t)+3,sl_cur);} if(GV){DMA_V((t)+1,sl_next);} \
    CMASK(C0,C1,t); \
    { float a=MX3(C0[0],C0[1],C1[0]),b=MX3(C0[2],C0[3],C1[1]); a=MX3(a,C1[2],C1[3]); \
      _Pragma("unroll") for(int r=4;r<16;r+=4){a=MX3(a,C0[r],C0[r+1]);b=MX3(b,C0[r+2],C0[r+3]);a=MX3(a,C1[r],C1[r+1]);b=MX3(b,C1[r+2],C1[r+3]);} \
      float rm=__builtin_fmaxf(a,b); { auto rr=__builtin_amdgcn_permlane32_swap(__float_as_uint(rm),__float_as_uint(rm),false,false); rm=__builtin_fmaxf(__uint_as_float(rr[0]),__uint_as_float(rr[1])); } \
      resc=false; \
      if(__builtin_expect(__any(rm>(float)THRL),0)){ const float dl=__builtin_fmaxf(rm,0.f); mhat+=dl; \
        _Pragma("unroll") for(int r=0;r<16;++r){C0[r]-=dl;C1[r]-=dl;} \
        nms=-mhat; \
        const float f=__builtin_amdgcn_exp2f(-dl); l_reg*=f; if(hi==0)wsf[r32]=f; resc=true; } } \
    SBAR(); \
    GAPB(o[0]=__builtin_amdgcn_mfma_f32_32x32x16_bf16(PAF(0),VFR(0),o[0],0,0,0), C0,0); \
    GAPB(o[1]=__builtin_amdgcn_mfma_f32_32x32x16_bf16(PAF(0),VFR(4),o[1],0,0,0), C0,4); \
    KRD(GL,0); GAPB(o[0]=__builtin_amdgcn_mfma_f32_32x32x16_bf16(PAF(1),VFR(1),o[0],0,0,0), C0,8); \
    KRD(GL,1); GAPB(o[1]=__builtin_amdgcn_mfma_f32_32x32x16_bf16(PAF(1),VFR(5),o[1],0,0,0), C0,12); \
    KRD(GL,2); GAPB(o[0]=__builtin_amdgcn_mfma_f32_32x32x16_bf16(PAF(2),VFR(2),o[0],0,0,0), C1,0); \
    KRD(GL,3); GAPB(o[1]=__builtin_amdgcn_mfma_f32_32x32x16_bf16(PAF(2),VFR(6),o[1],0,0,0), C1,4); \
    GAPB(o[0]=__builtin_amdgcn_mfma_f32_32x32x16_bf16(PAF(3),VFR(3),o[0],0,0,0), C1,8); \
    GAPB(o[1]=__builtin_amdgcn_mfma_f32_32x32x16_bf16(PAF(3),VFR(7),o[1],0,0,0), C1,12); \
    }while(0)
  int t=1;
  #undef CMASK
  #define CMASK(P0,P1,t) do{}while(0)
  for(;t+5<NT;t+=2){
    STEP(pB0,pB1,pA0,pA1,t,true,true,true);     WAIT_BAR(2); RESC(); ROT();
    STEP(pA0,pA1,pB0,pB1,t+1,true,true,true);   WAIT_BAR(2); RESC(); ROT();
  }
  #undef CMASK
  #define CMASK(P0,P1,t) do{ if(CAUSAL){int jb_=(t)-(NT-4); if(jb_>=0)cmask(P0,P1,jb_,qrel,hi);} }while(0)
  #define ENDW(tt) do{ if((tt)+3<NT){WAIT_BAR(2);} else if((tt)+2<NT){WAIT_BAR(1);} else {WAIT_BAR(0);} }while(0)
  for(;t+1<NT;t+=2){
    STEP(pB0,pB1,pA0,pA1,t,(t+3<NT),(t+1<NT),(t+1<NT));       ENDW(t);   RESC(); ROT();
    STEP(pA0,pA1,pB0,pB1,t+1,(t+4<NT),(t+2<NT),(t+2<NT));     ENDW(t+1); RESC(); ROT();
  }
  STEP(pB0,pB1,pA0,pA1,NT-1,false,false,false); RESC();
  { float sacc=pB0[0]+pB0[1]; _Pragma("unroll") for(int r=2;r<16;++r)sacc+=pB0[r]; _Pragma("unroll") for(int r=0;r<16;++r)sacc+=pB1[r]; l_reg+=sacc;
    pw0=(u32x4){PKW(pB0,0),PKW(pB0,2),PKW(pB0,4),PKW(pB0,6)};pw1=(u32x4){PKW(pB0,8),PKW(pB0,10),PKW(pB0,12),PKW(pB0,14)};pw2=(u32x4){PKW(pB1,0),PKW(pB1,2),PKW(pB1,4),PKW(pB1,6)};pw3=(u32x4){PKW(pB1,8),PKW(pB1,10),PKW(pB1,12),PKW(pB1,14)};
    SBAR(); pv(o,vb0+sl_cur,PAF(0),PAF(1),PAF(2),PAF(3)); }
  #undef PKW
  #undef PAF
  #undef VFR
  #undef PIN
  #undef MX3
  #undef GAPA
  #undef GAPB
  #undef EX
  #undef VRD
  #undef KRD
  #undef STEP
  #undef ENDW
  {auto rr=__builtin_amdgcn_permlane32_swap(__float_as_uint(l_reg),__float_as_uint(l_reg),false,false);l_reg=__uint_as_float(rr[0])+__uint_as_float(rr[1]);}
  if(hi==0)wsf[32+r32]=l_reg;asm volatile("s_waitcnt lgkmcnt(0)":::"memory");
  float rli[16];
  #pragma unroll
  for(int r=0;r<16;++r)rli[r]=__builtin_amdgcn_rcpf(wsf[32+crow(r,hi)]);
  bf16*Ow=Ou+(long)(wid*QBLK)*LDO;
  { bf16*stg=(bf16*)(shm+LDS_OST)+wid*2048;
    unsigned sbase=lds0+LDS_OST+(unsigned)wid*4096u+(unsigned)hi*512u+(unsigned)r32*2u; asm volatile("":"+v"(sbase));
    typedef __attribute__((address_space(3))) bf16* lds_hptr;
    #pragma unroll
    for(int r=0;r<16;++r){
      #pragma unroll
      for(int d0=0;d0<2;++d0)*(lds_hptr)(sbase+(unsigned)(((r&3)+8*(r>>2))*128+d0*64))=(bf16)(cvtpk_s(o[d0][r]*rli[r],0.f)&0xffffu);}
    asm volatile("s_waitcnt lgkmcnt(0)":::"memory");
    #pragma unroll
    for(int i=0;i<4;++i){const int row=i*8+(lane>>3),ch=lane&7; const u32x4 v=*(const u32x4*)(stg+row*64+ch*8); ATTN_STORE16(Ow+(long)row*LDO+ch*8,v);} }
  asm volatile("s_waitcnt lgkmcnt(0)\n\ts_barrier":::"memory");
  #undef DMA_K
  #undef DMA_V
  #undef CMASK
  #undef START
  #undef RESC
  #undef ROT
}
constexpr int ATTN_LDS_BYTES=LDS_BYTES;
#undef SBAR
#undef WAIT_BAR
}

__global__ void __launch_bounds__(NTHREADS, 2) mk_fwd(Args args) {
    extern __shared__ __attribute__((aligned(16))) unsigned char lds_raw[];
    LAS unsigned char* lds = (LAS unsigned char*)lds_raw;
    const int tid = threadIdx.x, lane = tid & 63, wave = __builtin_amdgcn_readfirstlane(tid >> 6);
    const int G = gridDim.x, bid = blockIdx.x;
    const int gw = bid * NWAVES + wave, NGW = G * NWAVES;
#define DECL_ALL \
    unsigned char* ws = args.ws; \
    const float* x = (const float*)args.in[0]; const float* mem = (const float*)args.in[1]; const int* positions = (const int*)args.in[2]; \
    const float* g_mix = (const float*)args.in[3]; const float* w_in = (const float*)args.in[4]; \
    const float* g_dq = (const float*)args.in[5]; const float* g_dk = (const float*)args.in[6]; \
    const float* lq1 = (const float*)args.in[7]; const float* lk1 = (const float*)args.in[8]; const float* lq2 = (const float*)args.in[9]; const float* lk2 = (const float*)args.in[10]; \
    const float* g_sub = (const float*)args.in[11]; const float* g_sgu = (const float*)args.in[12]; \
    const float* w_sp = (const float*)args.in[13]; const float* b_sp = (const float*)args.in[14]; \
    const float* g_memn = (const float*)args.in[15]; const float* w_kv = (const float*)args.in[16]; \
    const float* g_cq = (const float*)args.in[17]; const float* g_ck = (const float*)args.in[18]; \
    const float* w_out = (const float*)args.in[19]; const float* g_ffn = (const float*)args.in[20]; \
    const float* w_router = (const float*)args.in[21]; const float* b_router = (const float*)args.in[22]; \
    const float* w_mlp1 = (const float*)args.in[23]; const float* b_mlp1 = (const float*)args.in[24]; \
    const float* w_mlp2 = (const float*)args.in[25]; const float* b_mlp2 = (const float*)args.in[26]; \
    float* out = args.out; \
    unsigned* ctl = (unsigned*)(ws + WS_CTL); \
    bf16_t* WIN_T = (bf16_t*)(ws + WS_WIN); bf16_t* WO_T = (bf16_t*)(ws + WS_WO); bf16_t* WKV_T = (bf16_t*)(ws + WS_WKV); \
    float* CS = (float*)(ws + WS_CS); int* LIST = (int*)(ws + WS_LIST); float* GLIST = (float*)(ws + WS_GLIST); \
    bf16_t* MEMN = (bf16_t*)(ws + WS_MEMN); bf16_t* MEMK = (bf16_t*)(ws + WS_MEMK); bf16_t* MEMV = (bf16_t*)(ws + WS_MEMV); \
    bf16_t* W1T = (bf16_t*)(ws + WS_W1); bf16_t* W2T = (bf16_t*)(ws + WS_W2); bf16_t* H2 = (bf16_t*)(ws + WS_H2); bf16_t* ACT = (bf16_t*)(ws + WS_ACT); \
    bf16_t* XN = (bf16_t*)(ws + WS_XN); bf16_t* QB = (bf16_t*)(ws + WS_QB); bf16_t* KB = (bf16_t*)(ws + WS_KB); bf16_t* VB = (bf16_t*)(ws + WS_VB); \
    bf16_t* UB = (bf16_t*)(ws + WS_UB); bf16_t* VGB = (bf16_t*)(ws + WS_VGB); bf16_t* MQB = (bf16_t*)(ws + WS_MQB); \
    bf16_t* CAT = (bf16_t*)(ws + WS_CAT); bf16_t* YB = (bf16_t*)(ws + WS_YB); bf16_t* OT = (bf16_t*)(ws + WS_OT); (void)OT; \
    float* PROJ = (float*)(ws + WS_PROJ); float* KVT = (float*)(ws + WS_KVT); \
    (void)x; (void)mem; (void)positions; (void)g_mix; (void)w_in; (void)g_dq; (void)g_dk; (void)lq1; (void)lk1; (void)lq2; (void)lk2; (void)g_sub; (void)g_sgu; (void)w_sp; (void)b_sp; \
    (void)g_memn; (void)w_kv; (void)g_cq; (void)g_ck; (void)w_out; (void)g_ffn; (void)w_router; (void)b_router; (void)w_mlp1; (void)b_mlp1; (void)w_mlp2; (void)b_mlp2; (void)out; (void)ctl; \
    (void)WIN_T; (void)WO_T; (void)WKV_T; (void)CS; (void)LIST; (void)GLIST; (void)MEMN; (void)MEMK; (void)MEMV; (void)W1T; (void)W2T; (void)H2; (void)ACT; (void)XN; (void)QB; (void)KB; (void)VB; \
    (void)UB; (void)VGB; (void)MQB; (void)CAT; (void)YB; (void)PROJ; (void)KVT;

    const int lo = args.ph_lo, hi = args.ph_hi;
#ifndef PHMASK
#define PHMASK 0x1ff
#endif
#define IN(k) (((PHMASK >> (k)) & 1) && lo <= (k) && (k) < hi)
#define BOTH(k) (IN(k) && IN((k) + 1))
#define GRID_BAR() do { __threadfence(); cg::this_grid().sync(); } while (0)

    if (IN(0)) {
        DECL_ALL
        LAS float* scr = (LAS float*)(lds + wave * 16384);
        constexpr int I_IN = 16 * (NPROJ / 32), I_O = 16 * 32, I_KV = 16 * 16, I_1 = 16 * 64, I_2 = 16 * 32;
        constexpr int NITEMS = I_IN + I_O + I_KV + NE * I_1 + NE * I_2;
        for (int it = gw; it < NITEMS; it += NGW) {
            int r = it;
            if (r < I_IN) { transpose_item_p(w_in, DM, NPROJ, WIN_T, scr, r, lane, [](int n) {
                    if (n < 1024 || n >= 2048) { const int w = n & 255, d = w & 63; return (n & ~255) + 128 * ((d >> 3) & 1) + 32 * (w >> 6) + 8 * (d >> 4) + (d & 7); } return n; }); continue; } r -= I_IN;
            if (r < I_O) { transpose_item(w_out, DM, DM, WO_T, scr, r, lane); continue; } r -= I_O;
            if (r < I_KV) { transpose_item_p(w_kv, DM, 512, WKV_T, scr, r, lane, [](int n) {
                    if (n < 256) { const int d = n & 63; return 128 * ((d >> 3) & 1) + 32 * (n >> 6) + 8 * (d >> 4) + (d & 7); } return n; }); continue; } r -= I_KV;
            if (r < NE * I_1) { const int e = r / I_1; transpose_item_p(w_mlp1 + (size_t)e * DM * 2048, DM, 2048, W1T + (size_t)e * 2048 * DM, scr, r % I_1, lane,
                                                                   [](int n) { const int half = n >> 10, q = n & 1023; return 256 * (q >> 7) + 128 * half + (q & 127); }); continue; } r -= NE * I_1;
            { const int e = r / I_2; transpose_item(w_mlp2 + (size_t)e * DFF * DM, DFF, DM, W2T + (size_t)e * DM * DFF, scr, r % I_2, lane); }
        }
        for (int m = gw; m < M; m += NGW) rms_row_to_bf16(x + (size_t)m * DM, g_mix, XN + (size_t)m * DM, lane);
        for (int m = gw; m < MM; m += NGW) rms_row_to_bf16(mem + (size_t)m * DM, g_memn, MEMN + (size_t)m * DM, lane);
        for (int i = bid * NTHREADS + tid; i < M * 8; i += G * NTHREADS) {
            const int tok = i >> 3, f = i & 7;
            const float inv = (float)exp2(-(double)f * 0.125 * 18.931568569324174);
            const float ang = (float)positions[tok] * inv;
            CS[(size_t)tok * 16 + f] = (float)cos((double)ang); CS[(size_t)tok * 16 + 8 + f] = (float)sin((double)ang);
        }
        if (bid == 0 && tid < 64) { ctl[tid] = 0u; float* GT = (float*)(ws + WS_CTL + 4096); GT[tid] = g_dq[tid]; GT[64 + tid] = g_dk[tid]; GT[128 + tid] = g_cq[tid]; GT[192 + tid] = g_ck[tid]; }
        if (BOTH(0)) GRID_BAR();
    }

    if (IN(1)) {
        DECL_ALL
        pg8::InProjSched S{(const char*)XN, (const char*)MEMN, (const char*)WIN_T, G, bid};
        pg8::EpiInProj E{ws};
        pg8::gemm_phase<pg8::EpiInProj, pg8::InProjSched, false>(lds, S, E, nullptr);
        if (BOTH(1)) GRID_BAR();
    }

    if (IN(2)) {
        DECL_ALL
    }

    if (IN(3)) {
        DECL_ALL
        const int vcu = (G % 8 == 0) ? (bid % 8) * (G / 8) + bid / 8 : bid;
        for (int pair = vcu; pair < BATCH * 4 * 4; pair += G) {
            const int bh = pair >> 2, s4 = pair & 3, b = bh >> 2, h = bh & 3; const size_t rb = (size_t)b * SEQ;
            for (int u = 0; u < 8; ++u) {
                const int qb = (u & 4) ? 7 - s4 : s4, c = (u >> 1) & 1, half = u & 1;
                attn_body::attn_unit<8, 512, 512, 512, 1024, true>(QB + (rb + qb * 256) * 512 + (h * 2 + c) * 64, KB + rb * 512 + (h * 2 + c) * 64, VB + rb * 512 + h * 128 + half * 64,
                                                                   OT + (rb + qb * 256) * 1024 + h * 256 + c * 128 + half * 64, 4 * qb + 4, (char*)lds_raw);
            }
            asm volatile("s_waitcnt vmcnt(0)" ::: "memory");
            __builtin_amdgcn_fence(__ATOMIC_RELEASE, "agent"); __builtin_amdgcn_fence(__ATOMIC_ACQUIRE, "agent");
            asm volatile("s_waitcnt vmcnt(0)" ::: "memory");
            __syncthreads();
            int ln = lane; asm volatile("" : "+v"(ln));
            const float lam = __expf(wave_sum(lq1[ln] * lk1[ln])) - __expf(wave_sum(lq2[ln] * lk2[ln])) + 0.2f;
            const float gs0 = g_sub[2 * ln], gs1 = g_sub[2 * ln + 1];
            for (int rr = wave; rr < 512; rr += NWAVES) {
                const int qb = (rr & 256) ? 7 - s4 : s4; const size_t row = rb + qb * 256 + (rr & 255);
                const unsigned w1 = *(const unsigned*)(OT + row * 1024 + h * 256 + 2 * ln), w2 = *(const unsigned*)(OT + row * 1024 + h * 256 + 128 + 2 * ln);
                const float a0 = bf2f(w1 & 0xffffu) - lam * bf2f(w2 & 0xffffu), a1 = bf2f(w1 >> 16) - lam * bf2f(w2 >> 16);
                const float rstd = 0.8f / sqrtf(wave_sum(a0 * a0 + a1 * a1) * (1.f / 128) + EPS);
                *(unsigned*)(CAT + row * 1024 + h * 128 + 2 * ln) = pk2(a0 * rstd * gs0, a1 * rstd * gs1);
            }
        }
        for (int j = vcu; j < BATCH * 4 * 8; j += G) {
            const int bh = j >> 3, qb = j & 7, b = bh >> 2, h = bh & 3; const size_t rb = (size_t)b * SEQ;
            attn_body::attn_unit<8, 256, 256, 256, 1024, false>(MQB + (rb + qb * 256) * 256 + h * 64, MEMK + (size_t)b * MEML * 256 + h * 64, MEMV + (size_t)b * MEML * 256 + h * 64,
                                                                CAT + (rb + qb * 256) * 1024 + 768 + h * 64, MEML / 64, (char*)lds_raw);
        }
        __syncthreads();
        LAS float* vt = (LAS float*)lds;
        for (int it = bid; it < BATCH * 16; it += G) {
            const size_t r0 = (size_t)it * 128;
            for (int rr = wave; rr < 128; rr += NWAVES) {
                const u32x2 w = *(const u32x2*)(VGB + (r0 + rr) * 256 + 4 * lane);
                const float v0 = bf2f(w.x & 0xffffu), v1 = bf2f(w.x >> 16), v2 = bf2f(w.y & 0xffffu), v3 = bf2f(w.y >> 16);
                const float mean = wave_sum((v0 + v1) + (v2 + v3)) * (1.f / 256);
                const float d0 = v0 - mean, d1 = v1 - mean, d2 = v2 - mean, d3 = v3 - mean;
                const float rstd = 1.0f / sqrtf(wave_sum((d0 * d0 + d1 * d1) + (d2 * d2 + d3 * d3)) * (1.f / 256) + EPS);
                const f32x4 gg = *(const f32x4*)(g_sgu + 4 * lane);
                *(LAS f32x4*)(vt + rr * 256 + 4 * lane) = (f32x4){d0 * rstd * gg.x, d1 * rstd * gg.y, d2 * rstd * gg.z, d3 * rstd * gg.w};
            }
            __syncthreads();
            const int ch = tid & 255, g = ch >> 6;
            for (int i = 0; i < 64; ++i) {
                const int t = 2 * i + (tid >> 8);
                const float* wr = w_sp + ((size_t)g * 128 + t) * 128;
                float acc = 0.f;
                for (int s = 0; s <= t; ++s) acc += wr[s] * vt[s * 256 + ch];
                const float u = bf2f(UB[(r0 + t) * 256 + ch]);
                CAT[(r0 + t) * 1024 + 512 + ch] = (bf16_t)f2bf(u * (acc + b_sp[g * 128 + t]));
            }
            __syncthreads();
        }
        if (BOTH(3)) GRID_BAR();
    }

    if (IN(4)) {
        DECL_ALL
        pg8::DenseSched S{(const char*)CAT, (const char*)WO_T, DM / 256, (M / 256) * (DM / 256), G, bid};
        pg8::EpiResidual E{x, out};
        pg8::gemm_phase<pg8::EpiResidual, pg8::DenseSched, false>(lds, S, E, nullptr);
        if (BOTH(4)) GRID_BAR();
    }

    if (IN(5)) {
        DECL_ALL
        for (int m = gw; m < M; m += NGW) {
            const f32x4* xr = (const f32x4*)(out + (size_t)m * DM) + 4 * lane; const f32x4* gr = (const f32x4*)g_ffn + 4 * lane;
            f32x4 v[4]; float s = 0.f;
#pragma unroll
            for (int j = 0; j < 4; ++j) { v[j] = xr[j]; s += (v[j].x * v[j].x + v[j].y * v[j].y) + (v[j].z * v[j].z + v[j].w * v[j].w); }
            const float rstd = 1.0f / sqrtf(wave_sum(s) * (1.f / DM) + EPS);
            u32x2* o8 = (u32x2*)(H2 + (size_t)m * DM) + 4 * lane;
#pragma unroll
            for (int j = 0; j < 4; ++j) { const f32x4 gg = gr[j]; v[j].x *= rstd * gg.x; v[j].y *= rstd * gg.y; v[j].z *= rstd * gg.z; v[j].w *= rstd * gg.w;
                u32x2 w; w.x = pk2(v[j].x, v[j].y); w.y = pk2(v[j].z, v[j].w); o8[j] = w; }
            const f32x4* wr = (const f32x4*)(w_router + (size_t)lane * 16 * 32);
            LAS float* scr = (LAS float*)(lds + wave * 12800);
            LAS float* hs = scr + 2112 + lane * 17;
#pragma unroll
            for (int j = 0; j < 4; ++j)
#pragma unroll
                for (int i = 0; i < 4; ++i) hs[4 * j + i] = v[j][i];
            asm volatile("s_waitcnt lgkmcnt(0)" ::: "memory");
            float lg[32];
#pragma unroll
            for (int e = 0; e < 32; ++e) lg[e] = 0.f;
#pragma unroll 1
            for (int c = 0; c < 16; ++c) {
                const float hv = hs[c];
#pragma unroll
                for (int e4 = 0; e4 < 8; ++e4) { const f32x4 w = wr[c * 8 + e4]; lg[4 * e4] += hv * w.x; lg[4 * e4 + 1] += hv * w.y; lg[4 * e4 + 2] += hv * w.z; lg[4 * e4 + 3] += hv * w.w; }
            }
#pragma unroll
            for (int e = 0; e < 32; ++e) scr[e * 65 + lane] = lg[e];
            asm volatile("s_waitcnt lgkmcnt(0)" ::: "memory");
            const int e_me = lane & 31, half = lane >> 5;
            float tot = 0.f;
#pragma unroll
            for (int i = 0; i < 32; ++i) tot += scr[e_me * 65 + half * 32 + i];
            asm volatile("s_waitcnt lgkmcnt(0)" ::: "memory");
            tot += __shfl_xor(tot, 32);
            float myv = tot + b_router[e_me];
            float tv[4]; int ti[4];
#pragma unroll
            for (int k = 0; k < 4; ++k) {
                float bv = myv; int bi = e_me;
#pragma unroll
                for (int o = 1; o < 32; o <<= 1) { const float ov = __shfl_xor(bv, o); const int oi = __shfl_xor(bi, o); const bool take = (ov > bv) || (ov == bv && oi < bi); bv = take ? ov : bv; bi = take ? oi : bi; }
                tv[k] = bv; ti[k] = bi;
                if (e_me == bi) myv = -3.0e38f;
            }
            float ex[4], sum = 0.f;
#pragma unroll
            for (int k = 0; k < 4; ++k) { ex[k] = __expf(tv[k] - tv[0]); sum += ex[k]; }
            if (lane == 0) {
#pragma unroll
                for (int k = 0; k < 4; ++k) {
                    const unsigned r = atomicAdd(&ctl[ti[k]], 1u);
                    LIST[(size_t)ti[k] * M + r] = m * 4 + k; GLIST[(size_t)ti[k] * M + r] = ex[k] / sum;
                }
            }
        }
        if (BOTH(5)) GRID_BAR();
    }

    LAS int* tstart = (LAS int*)(lds + 140 * 1024); LAS int* ecnt = tstart + 40;
    if (IN(6) || IN(7)) {
        DECL_ALL
        __syncthreads();
        if (tid == 0) { int acc = 0; for (int e = 0; e < NE; ++e) { const int c = (int)__hip_atomic_load(&ctl[e], __ATOMIC_RELAXED, __HIP_MEMORY_SCOPE_AGENT); tstart[e] = acc; ecnt[e] = c; acc += (c + 255) / 256; } tstart[NE] = acc; }
        __syncthreads();
    }
    if (IN(6)) {
        DECL_ALL
        const int ntiles = tstart[NE];
        pg8::MoeSched S{(const char*)H2, (const char*)W1T, (size_t)2048 * DM * 2, LIST, tstart, ecnt, 8, ntiles * 8, G, bid, false};
        pg8::EpiSwiglu E{ACT, b_mlp1};
        pg8::gemm_phase<pg8::EpiSwiglu, pg8::MoeSched, true>(lds, S, E, (LAS unsigned*)(lds + 131072));
        if (BOTH(6)) GRID_BAR();
    }
    if (IN(7)) {
        DECL_ALL
        const int ntiles = tstart[NE];
        pg8::MoeSched S{(const char*)ACT, (const char*)W2T, (size_t)DM * DFF * 2, LIST, tstart, ecnt, 4, ntiles * 4, G, bid, true};
        pg8::EpiGateScatter E{YB, b_mlp2, LIST, GLIST, ecnt};
        pg8::gemm_phase<pg8::EpiGateScatter, pg8::MoeSched, false>(lds, S, E, nullptr);
        if (BOTH(7)) GRID_BAR();
    }
    if (IN(8)) {
        DECL_ALL
        for (size_t i = (size_t)bid * NTHREADS + tid; i < (size_t)M * DM / 4; i += (size_t)G * NTHREADS) {
            const size_t tok = i / (DM / 4); const int c = (int)(i % (DM / 4)) * 4;
            f32x4 a = *(const f32x4*)(out + tok * DM + c);
#pragma unroll
            for (int k = 0; k < 4; ++k) {
                const u32x2 w = *(const u32x2*)(YB + (tok * 4 + k) * DM + c);
                a.x += bf2f(w.x & 0xffffu); a.y += bf2f(w.x >> 16); a.z += bf2f(w.y & 0xffffu); a.w += bf2f(w.y >> 16);
            }
            *(f32x4*)(out + tok * DM + c) = a;
        }
    }
#undef IN
#undef BOTH
}

extern "C" void kernel_launch(void* const* d_in, const int* in_sizes, int n_in, void* d_out, int out_size, void* d_ws, size_t ws_size, hipStream_t stream) {
    static int grid = 0;
    if (grid == 0) {
        if (n_in != 27 || out_size != M * DM || ws_size < WS_END) { fprintf(stderr, "kernel_launch: unexpected problem (n_in %d out %d ws %zu)\n", n_in, out_size, ws_size); grid = -1; return; }
        int dev = 0, cus = 0, per_cu = 0;
        hipGetDevice(&dev); hipDeviceGetAttribute(&cus, hipDeviceAttributeMultiprocessorCount, dev);
        if (hipFuncSetAttribute((const void*)mk_fwd, hipFuncAttributeMaxDynamicSharedMemorySize, LDS_BYTES) != hipSuccess) { fprintf(stderr, "kernel_launch: hipFuncSetAttribute failed\n"); grid = -1; return; }
        hipOccupancyMaxActiveBlocksPerMultiprocessor(&per_cu, (const void*)mk_fwd, NTHREADS, LDS_BYTES);
        (void)hipGetLastError();
        if (per_cu < 1) { fprintf(stderr, "kernel_launch: occupancy query says %d blocks per CU\n", per_cu); per_cu = 1; }
        grid = cus;
    }
    if (grid < 0) return;
    Args a{};
    for (int i = 0; i < 27; ++i) a.in[i] = d_in[i];
    a.out = (float*)d_out; a.ws = (unsigned char*)d_ws;
    constexpr int NPH = 9;
    if (MK_N_LAUNCHES == 1) {
        a.ph_lo = 0; a.ph_hi = NPH;
        void* kargs[] = {&a};
        hipError_t e = hipLaunchCooperativeKernel((const void*)mk_fwd, dim3(grid), dim3(NTHREADS), kargs, LDS_BYTES, stream);
        if (e != hipSuccess) fprintf(stderr, "cooperative launch failed: %s (grid %d)\n", hipGetErrorString(e), grid);
    } else {
        for (int p = 0; p < NPH; ++p) { a.ph_lo = p; a.ph_hi = p + 1; hipLaunchKernelGGL(mk_fwd, dim3(grid), dim3(NTHREADS), LDS_BYTES, stream, a); }
    }
}
```

```cpp
#include <hip/hip_runtime.h>
#include <hip/hip_cooperative_groups.h>
#include <cstdio>
#include <cstdint>
namespace cg = cooperative_groups;

#ifndef MK_N_LAUNCHES
#define MK_N_LAUNCHES 1
#endif

constexpr int BATCH = 16, SEQ = 2048, DM = 1024, M = BATCH * SEQ;
constexpr int NPROJ = 2304;
constexpr int MEML = 256, MM = BATCH * MEML;
constexpr int NE = 32, TOPK = 4, DFF = 1024;
constexpr int MAXTILES = (M * TOPK) / 256 + NE;
constexpr int NSLOT = MAXTILES * 256;
constexpr float EPS = 1e-6f;
constexpr float C2 = 0.125f * 1.4426950408889634f;
constexpr int NWAVES = 8, NTHREADS = 512;
constexpr int LDS_BYTES = 147456;

constexpr size_t MiB = 1u << 20;
constexpr size_t WS_CTL = 0;
constexpr size_t WS_WIN = 2 * MiB, WS_WKV = WS_WIN + (size_t)NPROJ * DM * 2  , WS_WO = 8 * MiB, WS_CS = 10 * MiB, WS_LIST = 12 * MiB, WS_GLIST = 16 * MiB;
constexpr size_t WS_MEMN = 20 * MiB, WS_MEMK = 28 * MiB, WS_MEMV = 30 * MiB;
constexpr size_t WS_W1 = 32 * MiB, WS_W2 = 160 * MiB, WS_H2 = 224 * MiB, WS_ACT = 288 * MiB;
constexpr size_t WS_XN = 560 * MiB, WS_QB = 624 * MiB, WS_KB = 656 * MiB, WS_VB = 688 * MiB, WS_UB = 720 * MiB, WS_VGB = 736 * MiB, WS_MQB = 752 * MiB;
constexpr size_t WS_OT = 768 * MiB, WS_CAT = 832 * MiB, WS_RS = 896 * MiB  , WS_END = 900 * MiB;
constexpr size_t WS_YB = 560 * MiB;
constexpr size_t WS_PROJ = 224 * MiB;
constexpr size_t WS_KVT = 512 * MiB;
static_assert(WS_ACT + (size_t)NSLOT * DFF * 2 <= WS_XN, "act");
static_assert(WS_PROJ + (size_t)M * NPROJ * 4 <= WS_KVT && WS_KVT + (size_t)MM * 512 * 4 <= WS_XN, "proj temp");

#define LAS __attribute__((address_space(3)))
typedef unsigned short bf16_t;
typedef short bf16x8 __attribute__((ext_vector_type(8)));
typedef float f32x4 __attribute__((ext_vector_type(4)));
typedef unsigned u32x4 __attribute__((ext_vector_type(4)));
typedef unsigned u32x2 __attribute__((ext_vector_type(2)));

__device__ __forceinline__ unsigned f2bf(float f) { unsigned u = __float_as_uint(f); return (u + 0x7fffu + ((u >> 16) & 1u)) >> 16; }
__device__ __forceinline__ float bf2f(unsigned h) { return __uint_as_float(h << 16); }
__device__ __forceinline__ unsigned pk2(float lo, float hi) { return f2bf(lo) | (f2bf(hi) << 16); }
__device__ __forceinline__ float wave_sum(float v) {
#pragma unroll
    for (int o = 1; o < 64; o <<= 1) v += __shfl_xor(v, o);
    return v;
}
__device__ __forceinline__ float gelu_tanh(float x) {
    const float y = 0.7978845608028654f * (x + 0.044715f * x * x * x);
    const float t = 1.f - 2.f / (1.f + __expf(2.f * y));
    return 0.5f * x * (1.f + t);
}

struct Args {
    const void* in[27]; float* out; unsigned char* ws; int ph_lo, ph_hi;
};

template <class RowMap>
__device__ __forceinline__ void transpose_item_p(const float* W, int K, int N, bf16_t* WT, LAS float* scr, int item, int lane, RowMap rm) {
    const int nblk = N / 32, kb = item / nblk, nb = item % nblk, k0 = 64 * kb, n0 = 32 * nb;
#pragma unroll 8
    for (int i = 0; i < 32; ++i) { const int kk = 2 * i + (lane >> 5); scr[kk * 33 + (lane & 31)] = W[(size_t)(k0 + kk) * N + n0 + (lane & 31)]; }
    asm volatile("s_waitcnt lgkmcnt(0)" ::: "memory");
    const int c = lane & 7;
#pragma unroll
    for (int j = 0; j < 4; ++j) { const int n = (lane >> 3) + 8 * j; const LAS float* s = scr + (8 * c) * 33 + n;
        u32x4 o; o.x = pk2(s[0 * 33], s[1 * 33]); o.y = pk2(s[2 * 33], s[3 * 33]); o.z = pk2(s[4 * 33], s[5 * 33]); o.w = pk2(s[6 * 33], s[7 * 33]);
        *(u32x4*)(WT + (size_t)rm(n0 + n) * K + k0 + 8 * c) = o; }
    asm volatile("s_waitcnt lgkmcnt(0)" ::: "memory");
}
__device__ __forceinline__ void transpose_item(const float* W, int K, int N, bf16_t* WT, LAS float* scr, int item, int lane) {
    const int nblk = N / 32, kb = item / nblk, nb = item % nblk, k0 = 64 * kb, n0 = 32 * nb;
#pragma unroll 8
    for (int i = 0; i < 32; ++i) { const int kk = 2 * i + (lane >> 5); scr[kk * 33 + (lane & 31)] = W[(size_t)(k0 + kk) * N + n0 + (lane & 31)]; }
    asm volatile("s_waitcnt lgkmcnt(0)" ::: "memory");
    const int c = lane & 7;
#pragma unroll
    for (int j = 0; j < 4; ++j) { const int n = (lane >> 3) + 8 * j; const LAS float* s = scr + (8 * c) * 33 + n;
        u32x4 o; o.x = pk2(s[0 * 33], s[1 * 33]); o.y = pk2(s[2 * 33], s[3 * 33]); o.z = pk2(s[4 * 33], s[5 * 33]); o.w = pk2(s[6 * 33], s[7 * 33]);
        *(u32x4*)(WT + (size_t)(n0 + n) * K + k0 + 8 * c) = o; }
    asm volatile("s_waitcnt lgkmcnt(0)" ::: "memory");
}
__device__ __forceinline__ void rms_row_to_bf16(const float* xrow, const float* g, bf16_t* orow, int lane) {
    const f32x4* xr = (const f32x4*)xrow + lane; const f32x4* gr = (const f32x4*)g + lane;
    f32x4 v[4]; float s = 0.f;
#pragma unroll
    for (int j = 0; j < 4; ++j) { v[j] = xr[64 * j]; s += (v[j].x * v[j].x + v[j].y * v[j].y) + (v[j].z * v[j].z + v[j].w * v[j].w); }
    const float rstd = 1.0f / sqrtf(wave_sum(s) * (1.f / DM) + EPS);
    u32x2* o8 = (u32x2*)orow + lane;
#pragma unroll
    for (int j = 0; j < 4; ++j) { const f32x4 gg = gr[64 * j]; u32x2 w; w.x = pk2(v[j].x * rstd * gg.x, v[j].y * rstd * gg.y); w.y = pk2(v[j].z * rstd * gg.z, v[j].w * rstd * gg.w); o8[64 * j] = w; }
}

template <int NB, class RowFn, class Epi>
__device__ __forceinline__ void sgemm_item(const bf16_t* A, int lda, RowFn rowfn, const bf16_t* Bt0, const bf16_t* Bt1, int ldb, int K, int m0, int n0, Epi epi, int wave, int lane) {
    const int fr = lane & 15, fq = lane >> 4;
    unsigned aoff[2], boff[4];
#pragma unroll
    for (int mi = 0; mi < 2; ++mi) aoff[mi] = (unsigned)rowfn(m0 + 32 * wave + 16 * mi + fr) * (unsigned)lda + 8u * fq;
#pragma unroll
    for (int ni = 0; ni < 4; ++ni) boff[ni] = (unsigned)(n0 + 16 * ni + fr) * (unsigned)ldb + 8u * fq;
    f32x4 acc[NB][2][4];
#pragma unroll
    for (int b = 0; b < NB; ++b)
#pragma unroll
        for (int mi = 0; mi < 2; ++mi)
#pragma unroll
            for (int ni = 0; ni < 4; ++ni) acc[b][mi][ni] = (f32x4){0.f, 0.f, 0.f, 0.f};
#pragma unroll 2
    for (int k0 = 0; k0 < K; k0 += 32) {
        bf16x8 a[2], bb[NB][4];
#pragma unroll
        for (int mi = 0; mi < 2; ++mi) a[mi] = *(const bf16x8*)(A + k0 + aoff[mi]);
#pragma unroll
        for (int ni = 0; ni < 4; ++ni) { bb[0][ni] = *(const bf16x8*)(Bt0 + k0 + boff[ni]); if (NB == 2) bb[NB - 1][ni] = *(const bf16x8*)(Bt1 + k0 + boff[ni]); }
#pragma unroll
        for (int b = 0; b < NB; ++b)
#pragma unroll
            for (int mi = 0; mi < 2; ++mi)
#pragma unroll
                for (int ni = 0; ni < 4; ++ni) acc[b][mi][ni] = __builtin_amdgcn_mfma_f32_16x16x32_bf16(a[mi], bb[b][ni], acc[b][mi][ni], 0, 0, 0);
    }
#pragma unroll
    for (int mi = 0; mi < 2; ++mi)
#pragma unroll
        for (int ni = 0; ni < 4; ++ni)
#pragma unroll
            for (int j = 0; j < 4; ++j) epi(m0 + 32 * wave + 16 * mi + 4 * fq + j, n0 + 16 * ni + fr, acc[0][mi][ni][j], acc[NB - 1][mi][ni][j]);
}

template <int DV, bool CAUSAL>
__device__ __forceinline__ void sattn_wave(const bf16_t* Qw, int ldq, const bf16_t* Kp, int ldk, const bf16_t* Vp, int ldv, int nblk, int q0, LAS bf16_t* pl, f32x4 (&o)[DV / 16], int lane) {
    const int fr = lane & 15, fq = lane >> 4;
    bf16x8 qa[2];
#pragma unroll
    for (int ks = 0; ks < 2; ++ks) qa[ks] = *(const bf16x8*)(Qw + (size_t)fr * ldq + 32 * ks + 8 * fq);
    float mrow[4], lpart[4];
#pragma unroll
    for (int j = 0; j < 4; ++j) { mrow[j] = -1e30f; lpart[j] = 0.f; }
#pragma unroll
    for (int nt = 0; nt < DV / 16; ++nt) o[nt] = (f32x4){0.f, 0.f, 0.f, 0.f};
    for (int kb = 0; kb < nblk; ++kb) {
        f32x4 s[2];
#pragma unroll
        for (int nt = 0; nt < 2; ++nt) {
            s[nt] = (f32x4){0.f, 0.f, 0.f, 0.f};
            const bf16_t* kr = Kp + (size_t)(kb * 32 + 16 * nt + fr) * ldk + 8 * fq;
#pragma unroll
            for (int ks = 0; ks < 2; ++ks) { const bf16x8 kf = *(const bf16x8*)(kr + 32 * ks); s[nt] = __builtin_amdgcn_mfma_f32_16x16x32_bf16(qa[ks], kf, s[nt], 0, 0, 0); }
        }
        if (CAUSAL) {
#pragma unroll
            for (int nt = 0; nt < 2; ++nt)
#pragma unroll
                for (int j = 0; j < 4; ++j) if (kb * 32 + 16 * nt + fr > q0 + 4 * fq + j) s[nt][j] = -1e30f;
        }
        float alpha[4];
#pragma unroll
        for (int j = 0; j < 4; ++j) {
            float mx = fmaxf(s[0][j], s[1][j]);
            mx = fmaxf(mx, __shfl_xor(mx, 1)); mx = fmaxf(mx, __shfl_xor(mx, 2)); mx = fmaxf(mx, __shfl_xor(mx, 4)); mx = fmaxf(mx, __shfl_xor(mx, 8));
            const float mn = fmaxf(mrow[j], mx);
            alpha[j] = exp2f(mrow[j] - mn); mrow[j] = mn;
            const float p0 = exp2f(s[0][j] - mn), p1 = exp2f(s[1][j] - mn);
            lpart[j] = lpart[j] * alpha[j] + p0 + p1;
            pl[(4 * fq + j) * 40 + fr] = (bf16_t)f2bf(p0); pl[(4 * fq + j) * 40 + 16 + fr] = (bf16_t)f2bf(p1);
        }
#pragma unroll
        for (int nt = 0; nt < DV / 16; ++nt)
#pragma unroll
            for (int j = 0; j < 4; ++j) o[nt][j] *= alpha[j];
        asm volatile("s_waitcnt lgkmcnt(0)" ::: "memory");
        const bf16x8 pa = *(const LAS bf16x8*)(pl + fr * 40 + 8 * fq);
        asm volatile("s_waitcnt lgkmcnt(0)" ::: "memory");
#pragma unroll
        for (int nt = 0; nt < DV / 16; ++nt) {
            bf16x8 vf;
#pragma unroll
            for (int jj = 0; jj < 8; ++jj) vf[jj] = (short)Vp[(size_t)(kb * 32 + 8 * fq + jj) * ldv + 16 * nt + fr];
            o[nt] = __builtin_amdgcn_mfma_f32_16x16x32_bf16(pa, vf, o[nt], 0, 0, 0);
        }
    }
#pragma unroll
    for (int j = 0; j < 4; ++j) {
        float l = lpart[j];
        l += __shfl_xor(l, 1); l += __shfl_xor(l, 2); l += __shfl_xor(l, 4); l += __shfl_xor(l, 8);
        const float rl = 1.0f / l;
#pragma unroll
        for (int nt = 0; nt < DV / 16; ++nt) o[nt][j] *= rl;
    }
}


namespace pg8 {
constexpr int BM = 256, BK = 64, HALF = 128, HTB = HALF * BK * 2, STAGE_BYTES = 8 * HTB, KD = 1024;
__device__ __forceinline__ int lds_byte(int r, int c) { const int st = (r >> 4) * 2 + (c >> 5), rr = r & 15, cc = c & 31, ob = rr * 64 + cc * 2; return st * 1024 + (ob ^ (((ob >> 9) & 1) << 5)); }
__device__ __forceinline__ void stage_rc(int b, int& R, int& C) { const int st = b / 1024, sb = b % 1024, swz = sb ^ (((sb >> 9) & 1) << 5); R = (st >> 1) * 16 + swz / 64; C = (st & 1) * 32 + (swz % 64) / 2; }
__device__ __forceinline__ int perm32(int rho) { const int n = rho >> 4, i = rho & 15; return 8 * (i >> 2) + 4 * n + (i & 3); }
__device__ __forceinline__ unsigned cvt_pk_bf16(float lo, float hi) { unsigned r; asm volatile("v_cvt_pk_bf16_f32 %0, %1, %2" : "=v"(r) : "v"(lo), "v"(hi)); return r; }

struct Unit { const char* a; const char* b; int t, pn, e, mt; };

template <class Epi, class Sched, bool GATHER>
__device__ __forceinline__ void gemm_phase(LAS unsigned char* lds, const Sched& S, const Epi& E, LAS unsigned* xoff) {
    const int tid = threadIdx.x, wid = __builtin_amdgcn_readfirstlane(tid >> 6), lane = tid & 63, wr = wid >> 2, wc = wid & 3, fr = lane & 15, fq = lane >> 4;
    constexpr int K = KD, nt = K / BK;
    unsigned voffA0[2], voffA1[2], voffB[2];
    Unit cur, nxt; int ui = 0;
    if (!S.next(0, cur)) return;
#pragma unroll
    for (int i = 0; i < 2; ++i) { int R, C; stage_rc(tid * 16 + i * 8192, R, C); const int Rb = Epi::PERM ? ((R & ~31) + perm32(R & 31)) : R;
        voffB[i] = (unsigned)(Rb * K + C) * 2u;
        if (GATHER) { voffA0[i] = S.arow(cur, R) + (unsigned)C * 2u; voffA1[i] = S.arow(cur, R + HALF) + (unsigned)C * 2u; }
        else { voffA0[i] = (unsigned)(R * K + C) * 2u; voffA1[i] = voffA0[i] + (unsigned)(HALF * K * 2); } }
    if (GATHER) {
        Unit u1; const bool h1 = S.next(1, u1);
#pragma unroll
        for (int i = 0; i < 2; ++i) { int R, C; stage_rc(tid * 16 + i * 8192, R, C);
            xoff[tid * 4 + i] = h1 ? S.arow(u1, R) + (unsigned)C * 2u : voffA0[i]; xoff[tid * 4 + 2 + i] = h1 ? S.arow(u1, R + HALF) + (unsigned)C * 2u : voffA1[i]; }
    }
    const size_t kstep = (size_t)(BK * 2);
    const size_t hstep = (size_t)HALF * K * 2;
    const unsigned ldsw = (unsigned)wid * 1024u;
    const int aoff = lds_byte(wr * 64 + fr, fq * 8), boff = lds_byte(wc * 32 + fr, fq * 8);
#define PG8_SA(b, h) (((b) * 2 + (h)) * HTB)
#define PG8_SB(b, h) ((4 + (b) * 2 + (h)) * HTB)
#define PG8_STAGE(bufoff, gbase, voff) do { _Pragma("unroll") for (int _i = 0; _i < 2; ++_i) \
        __builtin_amdgcn_global_load_lds((const unsigned*)((const char*)(gbase) + (voff)[_i]), (LAS unsigned*)(lds + (bufoff) + ldsw + _i * 8192), 16, 0, 0); } while (0)
#define PG8_LDA(dst, b, h) do { _Pragma("unroll") for (int m = 0; m < 4; ++m) _Pragma("unroll") for (int k = 0; k < 2; ++k) dst[m][k] = *(const LAS bf16x8*)(lds + PG8_SA(b, h) + aoff + m * 2048 + k * 1024); } while (0)
#define PG8_LDB(dst, b, h) do { _Pragma("unroll") for (int n = 0; n < 2; ++n) _Pragma("unroll") for (int k = 0; k < 2; ++k) dst[n][k] = *(const LAS bf16x8*)(lds + PG8_SB(b, h) + boff + n * 2048 + k * 1024); } while (0)
#define PG8_MMA(ai, bj, At, Bt) do { __builtin_amdgcn_s_setprio(1); _Pragma("unroll") for (int m = 0; m < 4; ++m) _Pragma("unroll") for (int n = 0; n < 2; ++n) _Pragma("unroll") for (int k = 0; k < 2; ++k) \
        acc[ai][bj][m][n] = __builtin_amdgcn_mfma_f32_16x16x32_bf16(Bt[n][k], At[m][k], acc[ai][bj][m][n], 0, 0, 0); __builtin_amdgcn_s_setprio(0); } while (0)
#define PG8_WAIT_V(n) asm volatile("s_waitcnt vmcnt(" #n ")" ::: "memory")
#define PG8_WAIT_L(n) asm volatile("s_waitcnt lgkmcnt(" #n ")" ::: "memory")
#define PG8_BAR __builtin_amdgcn_s_barrier()
#define PG8_SCHED __builtin_amdgcn_sched_barrier(0)
    f32x4 acc[2][2][4][2];
#pragma unroll
    for (int a = 0; a < 2; ++a)
#pragma unroll
        for (int b = 0; b < 2; ++b)
#pragma unroll
            for (int m = 0; m < 4; ++m)
#pragma unroll
                for (int n = 0; n < 2; ++n) acc[a][b][m][n] = (f32x4){0.f, 0.f, 0.f, 0.f};
    bf16x8 At[4][2], B0[2][2], B1[2][2];
    const char* cA = cur.a; const char* cB = cur.b;
    PG8_WAIT_V(0);
    PG8_STAGE(PG8_SB(0, 0), cB, voffB); PG8_STAGE(PG8_SB(0, 1), cB + hstep, voffB); PG8_STAGE(PG8_SA(0, 0), cA, voffA0); PG8_STAGE(PG8_SA(0, 1), cA, voffA1);
    if (wr == 1) PG8_BAR;
    PG8_WAIT_V(2); PG8_BAR;
    PG8_STAGE(PG8_SB(1, 0), cB + kstep, voffB); PG8_STAGE(PG8_SA(1, 0), cA + kstep, voffA0); PG8_STAGE(PG8_SB(1, 1), cB + hstep + kstep, voffB);
    PG8_WAIT_V(6); PG8_BAR;
    for (;;) {
        const bool has_next = S.next(ui + 1, nxt);
        const char* nA = has_next ? nxt.a : cA; const char* nB = has_next ? nxt.b : cB;
        for (int t = 0; t < nt; t += 2) {
            const bool last = (t == nt - 2);
            const char* a1 = cA + (size_t)(t + 1) * kstep;
            const char* a2 = last ? nA : cA + (size_t)(t + 2) * kstep; const char* b2 = last ? nB : cB + (size_t)(t + 2) * kstep;
            const char* a3 = a2 + kstep; const char* b3 = b2 + kstep;
            PG8_LDB(B0, 0, 0); PG8_LDB(B1, 0, 1); PG8_SCHED; PG8_LDA(At, 0, 0); PG8_STAGE(PG8_SA(1, 1), a1, voffA1);
            if (GATHER) { if (last && has_next) {
#pragma unroll
                for (int i = 0; i < 2; ++i) { voffA0[i] = xoff[tid * 4 + i]; voffA1[i] = xoff[tid * 4 + 2 + i]; } } }
            PG8_WAIT_V(8); PG8_WAIT_L(0); PG8_BAR; PG8_MMA(0, 0, At, B0); PG8_MMA(0, 1, At, B1); PG8_BAR; PG8_SCHED;
            PG8_LDA(At, 0, 1); PG8_STAGE(PG8_SB(0, 0), b2, voffB); PG8_STAGE(PG8_SB(0, 1), b2 + hstep, voffB); PG8_STAGE(PG8_SA(0, 0), a2, voffA0);
            PG8_WAIT_V(8); PG8_WAIT_L(0); PG8_BAR; PG8_MMA(1, 0, At, B0); PG8_MMA(1, 1, At, B1); PG8_BAR; PG8_SCHED;
            PG8_LDB(B0, 1, 0); PG8_LDB(B1, 1, 1); PG8_SCHED; PG8_LDA(At, 1, 0); PG8_STAGE(PG8_SA(0, 1), a2, voffA1);
            PG8_WAIT_V(8); PG8_WAIT_L(0); PG8_BAR; PG8_MMA(0, 0, At, B0); PG8_MMA(0, 1, At, B1); PG8_BAR; PG8_SCHED;
            PG8_LDA(At, 1, 1); PG8_STAGE(PG8_SB(1, 0), b3, voffB); PG8_STAGE(PG8_SB(1, 1), b3 + hstep, voffB); PG8_STAGE(PG8_SA(1, 0), a3, voffA0);
            PG8_WAIT_V(8); PG8_WAIT_L(0); PG8_BAR; PG8_MMA(1, 0, At, B0); PG8_MMA(1, 1, At, B1); PG8_BAR; PG8_SCHED;
        }
        if (wr == 0) PG8_BAR;
        E(acc, cur, wr, wc, fr, fq);
        if (GATHER) {
            Unit u2; const bool h2 = S.next(ui + 2, u2);
            if (h2) {
#pragma unroll
                for (int i = 0; i < 2; ++i) { int R, C; stage_rc(tid * 16 + i * 8192, R, C);
                    xoff[tid * 4 + i] = S.arow(u2, R) + (unsigned)C * 2u; xoff[tid * 4 + 2 + i] = S.arow(u2, R + HALF) + (unsigned)C * 2u; }
            }
        }
        if (!has_next) break;
#pragma unroll
        for (int a = 0; a < 2; ++a)
#pragma unroll
            for (int b = 0; b < 2; ++b)
#pragma unroll
                for (int m = 0; m < 4; ++m)
#pragma unroll
                    for (int n = 0; n < 2; ++n) acc[a][b][m][n] = (f32x4){0.f, 0.f, 0.f, 0.f};
        cur = nxt; cA = nA; cB = nB; ++ui;
        if (wr == 1) PG8_BAR;
    }
    PG8_WAIT_V(0);
    PG8_BAR;
#undef PG8_SA
#undef PG8_SB
#undef PG8_STAGE
#undef PG8_LDA
#undef PG8_LDB
#undef PG8_MMA
#undef PG8_WAIT_V
#undef PG8_WAIT_L
#undef PG8_BAR
#undef PG8_SCHED
}

struct DenseSched {
    const char* A; const char* B; int nN, total, G, c;
    __device__ __forceinline__ bool next(int i, Unit& u) const {
        const int per = G >> 3; const int L = (i * 8 + (c & 7)) * per + (c >> 3); if (L >= total) return false;
        const int pm = L / nN, pn = L % nN; u.a = A + (size_t)pm * (BM * KD * 2); u.b = B + (size_t)pn * (BM * KD * 2); u.t = pm; u.pn = pn; u.e = 0; u.mt = pm; return true;
    }
    __device__ __forceinline__ unsigned arow(const Unit&, int) const { return 0u; }
};
struct MoeSched {
    const char* A; const char* B; size_t b_expert_stride; const int* list; LAS const int* tstart; LAS const int* ecnt; int nN, total, G, c; bool tile_major_a;
    __device__ __forceinline__ bool next(int i, Unit& u) const {
        const int per = G >> 3; const int L = (i * 8 + (c & 7)) * per + (c >> 3); if (L >= total) return false;
        const int t = L / nN, pn = L % nN; int e = 0;
        for (int q = 1; q < NE; ++q) if (tstart[q] <= t) e = q;
        u.t = t; u.pn = pn; u.e = e; u.mt = t - tstart[e];
        u.a = tile_major_a ? A + (size_t)t * (BM * KD * 2) : A; u.b = B + (size_t)e * b_expert_stride + (size_t)pn * (BM * KD * 2); return true;
    }
    __device__ __forceinline__ unsigned arow(const Unit& u, int R) const {
        const int rank = u.mt * 256 + R; const int tok = rank < ecnt[u.e] ? (list[(size_t)u.e * M + rank] >> 2) : 0; return (unsigned)tok * (unsigned)(KD * 2);
    }
};

struct EpiResidual {
    static constexpr bool PERM = false;
    const float* res; float* o; bf16_t* h2; const float* gain;
    __device__ __forceinline__ void operator()(const f32x4 (&acc)[2][2][4][2], const Unit& u, int wr, int wc, int fr, int fq) const {
        const int col0 = u.pn * BM + wc * 32 + 4 * fq;
        f32x4 gv[2][2];
#pragma unroll
        for (int bj = 0; bj < 2; ++bj)
#pragma unroll
            for (int n = 0; n < 2; ++n) gv[bj][n] = *(const f32x4*)(gain + col0 + bj * HALF + n * 16);
#pragma unroll
        for (int ai = 0; ai < 2; ++ai)
#pragma unroll
            for (int m = 0; m < 4; ++m) { const size_t off = (size_t)(u.t * BM + ai * HALF + wr * 64 + m * 16 + fr) * DM + col0;
#pragma unroll
                for (int bj = 0; bj < 2; ++bj)
#pragma unroll
                    for (int n = 0; n < 2; ++n) { const f32x4 r = *(const f32x4*)(res + off + bj * HALF + n * 16); const f32x4 x1 = r + acc[ai][bj][m][n]; *(f32x4*)(o + off + bj * HALF + n * 16) = x1;
                        const f32x4 hh = x1 * gv[bj][n]; u32x2 w; w.x = cvt_pk_bf16(hh[0], hh[1]); w.y = cvt_pk_bf16(hh[2], hh[3]); *(u32x2*)(h2 + off + bj * HALF + n * 16) = w; }
                if (m & 1) asm volatile("" ::: "memory"); }
    }
};
struct EpiSwiglu {
    static constexpr bool PERM = true;
    bf16_t* act; const float* b1; const float* rs; LAS const int* ecnt;
    __device__ __forceinline__ void operator()(const f32x4 (&acc)[2][2][4][2], const Unit& u, int wr, int wc, int fr, int fq) const {
        asm volatile("" : "+v"(fr), "+v"(fq));
        const int c0 = u.pn * HALF + wc * 32 + 8 * fq; const float* bg = b1 + (size_t)u.e * 2048 + c0; const int cnt = ecnt[u.e];
        f32x4 bv[2][2];
#pragma unroll
        for (int bj = 0; bj < 2; ++bj)
#pragma unroll
            for (int n = 0; n < 2; ++n) bv[bj][n] = *(const f32x4*)(bg + bj * 1024 + 4 * n);
#pragma unroll
        for (int ai = 0; ai < 2; ++ai)
#pragma unroll
            for (int m = 0; m < 4; ++m) {
                const int rl = ai * HALF + wr * 64 + m * 16 + fr, rank = u.mt * 256 + rl;
                const float r = rank < cnt ? rs[(size_t)u.e * M + rank] : 0.f;
                float a8[8];
#pragma unroll
                for (int n = 0; n < 2; ++n)
#pragma unroll
                    for (int i = 0; i < 4; ++i) {
                        const float glu = fminf(acc[ai][0][m][n][i] * r + bv[0][n][i], 7.0f), lin = fminf(fmaxf(acc[ai][1][m][n][i] * r + bv[1][n][i], -7.0f), 7.0f);
                        a8[4 * n + i] = glu * __builtin_amdgcn_rcpf(1.0f + __expf(-1.702f * glu)) * (lin + 1.0f);
                    }
                u32x4 w; w.x = cvt_pk_bf16(a8[0], a8[1]); w.y = cvt_pk_bf16(a8[2], a8[3]); w.z = cvt_pk_bf16(a8[4], a8[5]); w.w = cvt_pk_bf16(a8[6], a8[7]);
                *(u32x4*)(act + ((size_t)u.t * BM + rl) * DFF + c0) = w;
            }
    }
};
struct EpiGateScatter {
    static constexpr bool PERM = true;
    bf16_t* yb; const float* b2; const int* list; const float* glist; LAS const int* ecnt;
    __device__ __forceinline__ void operator()(const f32x4 (&acc)[2][2][4][2], const Unit& u, int wr, int wc, int fr, int fq) const {
        asm volatile("" : "+v"(fr), "+v"(fq));
        const int c0 = u.pn * BM + wc * 32 + 8 * fq; const float* bb = b2 + (size_t)u.e * DM + c0; const int cnt = ecnt[u.e];
        f32x4 bv[2][2];
#pragma unroll
        for (int bj = 0; bj < 2; ++bj)
#pragma unroll
            for (int n = 0; n < 2; ++n) bv[bj][n] = *(const f32x4*)(bb + bj * HALF + 4 * n);
#pragma unroll
        for (int ai = 0; ai < 2; ++ai)
#pragma unroll
            for (int m = 0; m < 4; ++m) {
                const int rank = u.mt * 256 + ai * HALF + wr * 64 + m * 16 + fr;
                if (rank < cnt) {
                    const int dest = list[(size_t)u.e * M + rank]; const float g = glist[(size_t)u.e * M + rank];
#pragma unroll
                    for (int bj = 0; bj < 2; ++bj) { const f32x4 v0 = (acc[ai][bj][m][0] + bv[bj][0]) * g, v1 = (acc[ai][bj][m][1] + bv[bj][1]) * g;
                        u32x4 w; w.x = cvt_pk_bf16(v0[0], v0[1]); w.y = cvt_pk_bf16(v0[2], v0[3]); w.z = cvt_pk_bf16(v1[0], v1[1]); w.w = cvt_pk_bf16(v1[2], v1[3]);
                        *(u32x4*)(yb + (size_t)dest * DM + c0 + bj * HALF) = w; }
                }
            }
    }
};

struct EpiInProj {
    static constexpr bool PERM = true;
    unsigned char* wsb;
    __device__ __forceinline__ void operator()(const f32x4 (&acc)[2][2][4][2], const Unit& u, int wr, int wc, int fr, int fq) const {
        const int pn = u.pn; const int row0 = u.t * BM + wr * 64 + fr;
        if (pn < 4 || pn == 8 || pn == 9) {
            const float* gp = (const float*)(wsb + WS_CTL + 4096) + 64 * (pn < 2 ? 0 : pn < 4 ? 1 : pn == 8 ? 2 : 3);
            const bool rope = pn < 4; const float sc = (pn < 2 || pn == 8) ? C2 : 1.0f;
            const size_t doff = pn < 2 ? WS_QB + (size_t)pn * 512 : pn < 4 ? WS_KB + (size_t)(pn - 2) * 512 : pn == 8 ? WS_MQB : WS_MEMK;
            bf16_t* dst = (bf16_t*)(wsb + doff); const int pitch = pn < 4 ? 512 : 256;
            const float* cs = (const float*)(wsb + WS_CS);
            f32x4 gv[2][2];
#pragma unroll
            for (int bj = 0; bj < 2; ++bj)
#pragma unroll
                for (int n = 0; n < 2; ++n) gv[bj][n] = *(const f32x4*)(gp + 16 * fq + 8 * bj + 4 * n) * sc;
#pragma unroll
            for (int ai = 0; ai < 2; ++ai)
#pragma unroll
                for (int m = 0; m < 4; ++m) {
                    const int row = row0 + ai * HALF + m * 16;
                    float ss = 0.f;
#pragma unroll
                    for (int bj = 0; bj < 2; ++bj)
#pragma unroll
                        for (int n = 0; n < 2; ++n) { const f32x4 v = acc[ai][bj][m][n]; ss += (v[0] * v[0] + v[1] * v[1]) + (v[2] * v[2] + v[3] * v[3]); }
                    ss += __shfl_xor(ss, 16); ss += __shfl_xor(ss, 32);
                    const float rstd = 1.0f / sqrtf(ss * (1.f / 64) + EPS);
                    f32x4 y[2][2];
#pragma unroll
                    for (int bj = 0; bj < 2; ++bj)
#pragma unroll
                        for (int n = 0; n < 2; ++n) y[bj][n] = acc[ai][bj][m][n] * rstd * gv[bj][n];
                    if (rope && fq == 0) {
#pragma unroll
                        for (int n = 0; n < 2; ++n) { const f32x4 c = *(const f32x4*)(cs + (size_t)row * 16 + 4 * n), sn = *(const f32x4*)(cs + (size_t)row * 16 + 8 + 4 * n);
                            const f32x4 x1 = y[0][n], x2 = y[1][n]; y[0][n] = x1 * c - x2 * sn; y[1][n] = x2 * c + x1 * sn; }
                    }
                    bf16_t* o = dst + (size_t)row * pitch + wc * 64 + 16 * fq;
#pragma unroll
                    for (int bj = 0; bj < 2; ++bj) { u32x4 w; w.x = cvt_pk_bf16(y[bj][0][0], y[bj][0][1]); w.y = cvt_pk_bf16(y[bj][0][2], y[bj][0][3]); w.z = cvt_pk_bf16(y[bj][1][0], y[bj][1][1]); w.w = cvt_pk_bf16(y[bj][1][2], y[bj][1][3]);
                        *(u32x4*)(o + 8 * bj) = w; }
                }
        } else {
            const bool act = (pn == 6 || pn == 7);
            const size_t doff = pn < 6 ? WS_VB + (size_t)(pn - 4) * 512 : pn == 6 ? WS_UB : pn == 7 ? WS_VGB : WS_MEMV;
            bf16_t* dst = (bf16_t*)(wsb + doff); const int pitch = pn < 6 ? 512 : 256;
#pragma unroll
            for (int ai = 0; ai < 2; ++ai)
#pragma unroll
                for (int m = 0; m < 4; ++m) {
                    bf16_t* o = dst + (size_t)(row0 + ai * HALF + m * 16) * pitch + wc * 32 + 8 * fq;
#pragma unroll
                    for (int bj = 0; bj < 2; ++bj) { f32x4 v0 = acc[ai][bj][m][0], v1 = acc[ai][bj][m][1];
                        if (act) {
#pragma unroll
                            for (int i = 0; i < 4; ++i) { v0[i] = gelu_tanh(v0[i]); v1[i] = gelu_tanh(v1[i]); } }
                        u32x4 w; w.x = cvt_pk_bf16(v0[0], v0[1]); w.y = cvt_pk_bf16(v0[2], v0[3]); w.z = cvt_pk_bf16(v1[0], v1[1]); w.w = cvt_pk_bf16(v1[2], v1[3]);
                        *(u32x4*)(o + bj * HALF) = w; }
                }
        }
    }
};
struct InProjSched {
    const char* XNb; const char* MEMNb; const char* B; int G, c;
    __device__ __forceinline__ bool next(int i, Unit& u) const {
        constexpr int N1 = (M / 256) * 9, N2 = (MM / 256) * 2;
        const int per = G >> 3; const int L = (i * 8 + (c & 7)) * per + (c >> 3); if (L >= N1 + N2) return false;
        int pm, pn; const char* a;
        if (L < N1) { pm = L / 9; pn = L % 9; a = XNb; } else { const int j = L - N1; pm = j >> 1; pn = 9 + (j & 1); a = MEMNb; }
        u.a = a + (size_t)pm * (BM * KD * 2); u.b = B + (size_t)pn * (BM * KD * 2); u.t = pm; u.pn = pn; u.e = 0; u.mt = pm; return true;
    }
    __device__ __forceinline__ unsigned arow(const Unit&, int) const { return 0u; }
};
}

namespace attn_body {
typedef unsigned short bf16;
using bf16x8=__attribute__((ext_vector_type(8)))short;
using s16x4=__attribute__((ext_vector_type(4)))short;
using f32x16=__attribute__((ext_vector_type(16)))float;
using u32x4=__attribute__((ext_vector_type(4)))unsigned;
constexpr int D=64;
constexpr int NW=8,QBLK=32,QB=QBLK*NW,KVBLK=64;
__device__ __forceinline__ int crow(int r,int hi){return (r&3)+8*(r>>2)+4*hi;}
#define SBAR() __builtin_amdgcn_sched_barrier(0)
__device__ __forceinline__ void cmask(f32x16&p0,f32x16&p1,int jb,int qrel,int hi){
  const float NEG=-INFINITY; const int lim=qrel-(64*jb+4*hi);
  #pragma unroll
  for(int r=0;r<16;++r){const int kc=(r&3)+8*(r>>2); if(kc>lim)p0[r]=NEG; if(kc+32>lim)p1[r]=NEG;}
}

constexpr int NSLOT=3, SLOTB=8192;
constexpr int LDS_K=0, LDS_V=NSLOT*SLOTB, LDS_WS=2*NSLOT*SLOTB, LDS_OST=LDS_WS+NW*64*4, LDS_BYTES=LDS_OST+NW*4096;
constexpr float C2=0.125f*1.4426950408889634f;
__device__ __forceinline__ void glds16(const void*gsrc,unsigned lds_dst){unsigned keep;
  asm volatile("s_mov_b32 %0, m0\n\ts_mov_b32 m0, %2\n\ts_nop 0\n\tglobal_load_lds_dwordx4 %1, off\n\ts_mov_b32 m0, %0":"=&s"(keep):"v"(gsrc),"s"(lds_dst):"memory");}
__device__ __forceinline__ float max3f(float a,float b,float c){float r;asm("v_max3_f32 %0, %1, %2, %3":"=v"(r):"v"(a),"v"(b),"v"(c));return r;}
__device__ __forceinline__ float max2f(float a,float b){float r;asm("v_max_f32_e32 %0, %1, %2":"=v"(r):"v"(a),"v"(b));return r;}
__device__ __forceinline__ float fadd_s(float a,float b){float r;asm("v_add_f32_e32 %0, %1, %2":"=v"(r):"v"(a),"v"(b));return r;}
__device__ __forceinline__ float fsub_s(float a,float b){float r;asm("v_sub_f32_e32 %0, %1, %2":"=v"(r):"v"(a),"v"(b));return r;}
typedef float f32x2_t __attribute__((ext_vector_type(2))); typedef __bf16 bf16x2_t __attribute__((ext_vector_type(2)));
__device__ __forceinline__ unsigned cvtpk_s(float lo,float hi){f32x2_t v={lo,hi};bf16x2_t b=__builtin_convertvector(v,bf16x2_t);return __builtin_bit_cast(unsigned,b);}
#define WAIT_BAR(N) asm volatile("s_waitcnt vmcnt(" #N ") lgkmcnt(0)\n\ts_barrier":::"memory")

__device__ __forceinline__ void qkt(f32x16&p0,f32x16&p1,const char*Kslot,const bf16x8*qr,const f32x16&negm,int r32,int hi){
  const char*kb=Kslot+hi*1024+r32*16;
  #pragma unroll
  for(int d0=0;d0<4;++d0){
    const bf16x8 b0=*reinterpret_cast<const bf16x8*>(kb+d0*2048);
    const bf16x8 b1=*reinterpret_cast<const bf16x8*>(kb+d0*2048+512);
    if(d0==0){p0=__builtin_amdgcn_mfma_f32_32x32x16_bf16(b0,qr[0],negm,0,0,0);p1=__builtin_amdgcn_mfma_f32_32x32x16_bf16(b1,qr[0],negm,0,0,0);}
    else{p0=__builtin_amdgcn_mfma_f32_32x32x16_bf16(b0,qr[d0],p0,0,0,0);p1=__builtin_amdgcn_mfma_f32_32x32x16_bf16(b1,qr[d0],p1,0,0,0);}}
}
typedef __attribute__((address_space(3))) const char* lds_cptr;
typedef short v4i16_t __attribute__((ext_vector_type(4)));
__device__ __forceinline__ void kload8(bf16x8*kf,lds_cptr kp){
  kf[0]=*(const __attribute__((address_space(3))) bf16x8*)(kp);      kf[1]=*(const __attribute__((address_space(3))) bf16x8*)(kp+512);
  kf[2]=*(const __attribute__((address_space(3))) bf16x8*)(kp+2048); kf[3]=*(const __attribute__((address_space(3))) bf16x8*)(kp+2560);
  kf[4]=*(const __attribute__((address_space(3))) bf16x8*)(kp+4096); kf[5]=*(const __attribute__((address_space(3))) bf16x8*)(kp+4608);
  kf[6]=*(const __attribute__((address_space(3))) bf16x8*)(kp+6144); kf[7]=*(const __attribute__((address_space(3))) bf16x8*)(kp+6656);
}
__device__ __forceinline__ void kload2(bf16x8*kf,lds_cptr kp,int j){ kf[2*j]=*(const __attribute__((address_space(3))) bf16x8*)(kp+j*2048); kf[2*j+1]=*(const __attribute__((address_space(3))) bf16x8*)(kp+j*2048+512); }
__device__ __forceinline__ s16x4 vtr(lds_cptr p){ return __builtin_bit_cast(s16x4,__builtin_amdgcn_ds_read_tr16_b64_v4i16((__attribute__((address_space(3))) v4i16_t*)p)); }
__device__ __forceinline__ float rowmax(const f32x16&p0,const f32x16&p1){
  float a=max3f(p0[0],p0[1],p1[0]),b=max3f(p0[2],p0[3],p1[1]);a=max3f(a,p1[2],p1[3]);
  #pragma unroll
  for(int r=4;r<16;r+=4){a=max3f(a,p0[r],p0[r+1]);b=max3f(b,p0[r+2],p0[r+3]);a=max3f(a,p1[r],p1[r+1]);b=max3f(b,p1[r+2],p1[r+3]);}
  const float m=max2f(a,b);
  auto rr=__builtin_amdgcn_permlane32_swap(__float_as_uint(m),__float_as_uint(m),false,false);
  return max2f(__uint_as_float(rr[0]),__uint_as_float(rr[1]));
}
__device__ __forceinline__ void pv(f32x16*o,int vb,bf16x8 pa0,bf16x8 pa1,bf16x8 pa2,bf16x8 pa3){
  #pragma unroll
  for(int d0=0;d0<2;++d0){s16x4 lo[4],hi[4];
    #pragma unroll
    for(int ks=0;ks<4;++ks){
      asm volatile("ds_read_b64_tr_b16 %0,%1 offset:%c2":"=&v"(lo[ks]):"v"(vb),"i"(d0*4096+ks*1024):"memory");
      asm volatile("ds_read_b64_tr_b16 %0,%1 offset:%c2":"=&v"(hi[ks]):"v"(vb),"i"(d0*4096+ks*1024+512):"memory");}
    asm volatile("s_waitcnt lgkmcnt(0)":::"memory");SBAR();
    #define PK(k) (bf16x8){lo[k][0],lo[k][1],lo[k][2],lo[k][3],hi[k][0],hi[k][1],hi[k][2],hi[k][3]}
    o[d0]=__builtin_amdgcn_mfma_f32_32x32x16_bf16(pa0,PK(0),o[d0],0,0,0);
    o[d0]=__builtin_amdgcn_mfma_f32_32x32x16_bf16(pa1,PK(1),o[d0],0,0,0);
    o[d0]=__builtin_amdgcn_mfma_f32_32x32x16_bf16(pa2,PK(2),o[d0],0,0,0);
    o[d0]=__builtin_amdgcn_mfma_f32_32x32x16_bf16(pa3,PK(3),o[d0],0,0,0);
    #undef PK
  }
}

#ifndef ATTN_STORE16
#define ATTN_STORE16(p,v) (*(u32x4*)(p)=(v))
#endif
template<int THRL,int LDQ,int LDK,int LDV,int LDO,bool CAUSAL> __device__ __forceinline__ void attn_unit(const bf16*Qu,const bf16*__restrict__ Kh,const bf16*__restrict__ Vh,bf16*Ou,const int NT,char*shm){
  const int tid=threadIdx.x,lane=tid&63,r32=lane&31,hi=lane>>5; const int wid=__builtin_amdgcn_readfirstlane(tid>>6);
  const bf16*Qw=Qu+(long)(wid*QBLK)*LDQ;
  const unsigned lds0=(unsigned)(uintptr_t)shm;
  float*wsf=(float*)(shm+LDS_WS)+wid*64;
  const bf16*ksrc=Kh+(long)lane*LDK+wid*8;
  const bf16*vsrc=Vh+(long)(16*(wid&3)+(lane>>2))*LDV+(wid>>2)*32+(lane&3)*8;
  const unsigned kdst=lds0+LDS_K+wid*1024, vdst=lds0+LDS_V+wid*1024;
  #define DMA_K(t,slot) glds16(ksrc+(long)(t)*KVBLK*LDK,(unsigned)__builtin_amdgcn_readfirstlane(kdst+(slot)))
  #define DMA_V(t,slot) glds16(vsrc+(long)(t)*KVBLK*LDV,(unsigned)__builtin_amdgcn_readfirstlane(vdst+(slot)))
  const int vb0=(int)(lds0+LDS_V)+((lane>>4)&1)*32+(lane&3)*8+(4*hi+((lane&15)>>2))*64;
  const char*Kbase=shm+LDS_K; bf16x8 kf[8];
  const lds_cptr shm3=(lds_cptr)shm; const lds_cptr kp0=shm3+LDS_K+hi*1024+r32*16; const lds_cptr vp0=shm3+LDS_V+((lane>>4)&1)*32+(lane&3)*8+(4*hi+((lane&15)>>2))*64;
  DMA_K(0,0);DMA_V(0,0);DMA_K(1,SLOTB);
  bf16x8 qr[4];
  #pragma unroll
  for(int d0=0;d0<4;++d0)qr[d0]=*reinterpret_cast<const bf16x8*>(&Qw[(long)r32*LDQ+d0*16+hi*8]);
  float mhat=0.f,l_reg=0.f;f32x16 o[2];o[0]=f32x16{};o[1]=f32x16{};float nms=0.f; const f32x16 zero16=f32x16{};
  const int qrel=wid*QBLK+r32;
  #define CMASK(P0,P1,t) do{ if(CAUSAL){int jb_=(t)-(NT-4); if(jb_>=0)cmask(P0,P1,jb_,qrel,hi);} }while(0)
  bool resc=false;
  #define START(P0,P1) do{ const float rm=rowmax(P0,P1); resc=false; \
    { const float dl=rm; mhat=fadd_s(mhat,dl); \
      _Pragma("unroll") for(int r=0;r<16;++r){P0[r]=fsub_s(P0[r],dl);P1[r]=fsub_s(P1[r],dl);} \
      nms=-mhat; } \
    _Pragma("unroll") for(int r=0;r<16;++r)P0[r]=__builtin_amdgcn_exp2f(P0[r]); }while(0)
  #define RESC() do{ if(resc){ asm volatile("s_waitcnt lgkmcnt(0)":::"memory"); \
      _Pragma("unroll") for(int d_=0;d_<2;++d_) _Pragma("unroll") for(int r=0;r<16;++r)o[d_][r]*=wsf[crow(r,hi)]; } }while(0)
  f32x16 pA0,pA1,pB0,pB1;
  int sl_prev=0,sl_cur=0,sl_next=SLOTB;
  #define ROT() do{sl_prev=sl_cur;sl_cur=sl_next;sl_next=(sl_next==(NSLOT-1)*SLOTB)?0:sl_next+SLOTB;}while(0)
  DMA_K(2,2*SLOTB);
  WAIT_BAR(3);
  qkt(pA0,pA1,Kbase,qr,zero16,r32,hi);asm volatile("s_nop 15\n\ts_nop 7":"+v"(pA0),"+v"(pA1));CMASK(pA0,pA1,0);
  START(pA0,pA1);
  _Pragma("unroll") for(int r=0;r<16;++r)pA1[r]=__builtin_amdgcn_exp2f(pA1[r]);
  WAIT_BAR(0);
  DMA_K(3,0);DMA_V(1,SLOTB);
  ROT();
  kload8(kf,kp0+sl_cur);
  WAIT_BAR(2);
  s16x4 vlo[8],vhi[8]; u32x4 pw0,pw1,pw2,pw3;
  #define PKW(P,B) cvtpk_s(P[B],P[B+1])
  #define PAF(k) __builtin_bit_cast(bf16x8,pw##k)
  #define VFR(i) (bf16x8){vlo[i][0],vlo[i][1],vlo[i][2],vlo[i][3],vhi[i][0],vhi[i][1],vhi[i][2],vhi[i][3]}
  #define PIN(x) asm volatile("":"+v"(x))
  #define MX3(a,b,c) __builtin_fmaxf(__builtin_fmaxf((a),(b)),(c))
  #define GAPA(MF,A0,A1,A2,A3,W0,W1,PW) do{ MF; sacc+=A0; sacc+=A1; sacc+=A2; sacc+=A3; PIN(sacc); W0; W1; PIN(PW); SBAR(); }while(0)
  #define EX(v) __builtin_amdgcn_exp2f(v)
  #define GAPB(MF,X,B) do{ MF; X[B]=EX(X[B]); X[B+1]=EX(X[B+1]); X[B+2]=EX(X[B+2]); X[B+3]=EX(X[B+3]); PIN(X); SBAR(); }while(0)
  #define VRD(i) do{ vlo[i]=vtr(vp_+(((i)>>2)*4096+((i)&3)*1024)); vhi[i]=vtr(vp_+(((i)>>2)*4096+((i)&3)*1024+512)); }while(0)
  #define KRD(G,j) do{ if(G){ kload2(kf,kp0+sl_next,j); SBAR(); } }while(0)
  #define STEP(C0,C1,P0,P1,t,GK,GV,GL) do{ SBAR(); \
    const lds_cptr vp_=vp0+sl_prev; \
    VRD(0); SBAR(); float sacc=(P0[0]+P0[1]); \
    GAPA(C0=__builtin_amdgcn_mfma_f32_32x32x16_bf16(kf[0],qr[0],zero16,0,0,0), P0[2],P0[3],P0[4],P0[5],     pw0[0]=PKW(P0,0), pw0[1]=PKW(P0,2), pw0); \
    VRD(4); SBAR(); GAPA(C1=__builtin_amdgcn_mfma_f32_32x32x16_bf16(kf[1],qr[0],zero16,0,0,0), P0[6],P0[7],P0[8],P0[9],     pw0[2]=PKW(P0,4), pw0[3]=PKW(P0,6), pw0); \
    VRD(1); SBAR(); GAPA(C0=__builtin_amdgcn_mfma_f32_32x32x16_bf16(kf[2],qr[1],C0,0,0,0),   P0[10],P0[11],P0[12],P0[13], pw1[0]=PKW(P0,8), pw1[1]=PKW(P0,10), pw1); \
    VRD(5); SBAR(); GAPA(C1=__builtin_amdgcn_mfma_f32_32x32x16_bf16(kf[3],qr[1],C1,0,0,0),   P0[14],P0[15],P1[0],P1[1],   pw1[2]=PKW(P0,12),pw1[3]=PKW(P0,14), pw1); \
    VRD(2); SBAR(); GAPA(C0=__builtin_amdgcn_mfma_f32_32x32x16_bf16(kf[4],qr[2],C0,0,0,0),   P1[2],P1[3],P1[4],P1[5],     pw2[0]=PKW(P1,0), pw2[1]=PKW(P1,2), pw2); \
    VRD(6); SBAR(); GAPA(C1=__builtin_amdgcn_mfma_f32_32x32x16_bf16(kf[5],qr[2],C1,0,0,0),   P1[6],P1[7],P1[8],P1[9],     pw2[2]=PKW(P1,4), pw2[3]=PKW(P1,6), pw2); \
    VRD(3); SBAR(); GAPA(C0=__builtin_amdgcn_mfma_f32_32x32x16_bf16(kf[6],qr[3],C0,0,0,0),   P1[10],P1[11],P1[12],P1[13], pw3[0]=PKW(P1,8), pw3[1]=PKW(P1,10), pw3); \
    VRD(7); SBAR(); GAPA(C1=__builtin_amdgcn_mfma_f32_32x32x16_bf16(kf[7],qr[3],C1,0,0,0),   P1[14],P1[15],0.f,0.f,       pw3[2]=PKW(P1,12),pw3[3]=PKW(P1,14), pw3); \
    l_reg+=sacc; \
    _Pragma("unroll") for(int r=0;r<16;++r){C0[r]+=nms;C1[r]+=nms;} \
    if(GK){DMA_K((t)+3,sl_cur);} if(GV){DMA_V((t)+1,sl_next);} \
    CMASK(C0,C1,t); \
    { float a=MX3(C0[0],C0[1],C1[0]),b=MX3(C0[2],C0[3],C1[1]); a=MX3(a,C1[2],C1[3]); \
      _Pragma("unroll") for(int r=4;r<16;r+=4){a=MX3(a,C0[r],C0[r+1]);b=MX3(b,C0[r+2],C0[r+3]);a=MX3(a,C1[r],C1[r+1]);b=MX3(b,C1[r+2],C1[r+3]);} \
      float rm=__builtin_fmaxf(a,b); { auto rr=__builtin_amdgcn_permlane32_swap(__float_as_uint(rm),__float_as_uint(rm),false,false); rm=__builtin_fmaxf(__uint_as_float(rr[0]),__uint_as_float(rr[1])); } \
      resc=false; \
      if(__builtin_expect(__any(rm>(float)THRL),0)){ const float dl=__builtin_fmaxf(rm,0.f); mhat+=dl; \
        _Pragma("unroll") for(int r=0;r<16;++r){C0[r]-=dl;C1[r]-=dl;} \
        nms=-mhat; \
        const float f=__builtin_amdgcn_exp2f(-dl); l_reg*=f; if(hi==0)wsf[r32]=f; resc=true; } } \
    SBAR(); \
    GAPB(o[0]=__builtin_amdgcn_mfma_f32_32x32x16_bf16(PAF(0),VFR(0),o[0],0,0,0), C0,0); \
    GAPB(o[1]=__builtin_amdgcn_mfma_f32_32x32x16_bf16(PAF(0),VFR(4),o[1],0,0,0), C0,4); \
    KRD(GL,0); GAPB(o[0]=__builtin_amdgcn_mfma_f32_32x32x16_bf16(PAF(1),VFR(1),o[0],0,0,0), C0,8); \
    KRD(GL,1); GAPB(o[1]=__builtin_amdgcn_mfma_f32_32x32x16_bf16(PAF(1),VFR(5),o[1],0,0,0), C0,12); \
    KRD(GL,2); GAPB(o[0]=__builtin_amdgcn_mfma_f32_32x32x16_bf16(PAF(2),VFR(2),o[0],0,0,0), C1,0); \
    KRD(GL,3); GAPB(o[1]=__builtin_amdgcn_mfma_f32_32x32x16_bf16(PAF(2),VFR(6),o[1],0,0,0), C1,4); \
    GAPB(o[0]=__builtin_amdgcn_mfma_f32_32x32x16_bf16(PAF(3),VFR(3),o[0],0,0,0), C1,8); \
    GAPB(o[1]=__builtin_amdgcn_mfma_f32_32x32x16_bf16(PAF(3),VFR(7),o[1],0,0,0), C1,12); \
    }while(0)
  int t=1;
  #undef CMASK
  #define CMASK(P0,P1,t) do{}while(0)
  for(;t+5<NT;t+=2){
    STEP(pB0,pB1,pA0,pA1,t,true,true,true);     WAIT_BAR(2); RESC(); ROT();
    STEP(pA0,pA1,pB0,pB1,t+1,true,true,true);   WAIT_BAR(2); RESC(); ROT();
  }
  #undef CMASK
  #define CMASK(P0,P1,t) do{ if(CAUSAL){int jb_=(t)-(NT-4); if(jb_>=0)cmask(P0,P1,jb_,qrel,hi);} }while(0)
  #define ENDW(tt) do{ if((tt)+3<NT){WAIT_BAR(2);} else if((tt)+2<NT){WAIT_BAR(1);} else {WAIT_BAR(0);} }while(0)
  for(;t+1<NT;t+=2){
    STEP(pB0,pB1,pA0,pA1,t,(t+3<NT),(t+1<NT),(t+1<NT));       ENDW(t);   RESC(); ROT();
    STEP(pA0,pA1,pB0,pB1,t+1,(t+4<NT),(t+2<NT),(t+2<NT));     ENDW(t+1); RESC(); ROT();
  }
  STEP(pB0,pB1,pA0,pA1,NT-1,false,false,false); RESC();
  { float sacc=pB0[0]+pB0[1]; _Pragma("unroll") for(int r=2;r<16;++r)sacc+=pB0[r]; _Pragma("unroll") for(int r=0;r<16;++r)sacc+=pB1[r]; l_reg+=sacc;
    pw0=(u32x4){PKW(pB0,0),PKW(pB0,2),PKW(pB0,4),PKW(pB0,6)};pw1=(u32x4){PKW(pB0,8),PKW(pB0,10),PKW(pB0,12),PKW(pB0,14)};pw2=(u32x4){PKW(pB1,0),PKW(pB1,2),PKW(pB1,4),PKW(pB1,6)};pw3=(u32x4){PKW(pB1,8),PKW(pB1,10),PKW(pB1,12),PKW(pB1,14)};
    SBAR(); pv(o,vb0+sl_cur,PAF(0),PAF(1),PAF(2),PAF(3)); }
  #undef PKW
  #undef PAF
  #undef VFR
  #undef PIN
  #undef MX3
  #undef GAPA
  #undef GAPB
  #undef EX
  #undef VRD
  #undef KRD
  #undef STEP
  #undef ENDW
  {auto rr=__builtin_amdgcn_permlane32_swap(__float_as_uint(l_reg),__float_as_uint(l_reg),false,false);l_reg=__uint_as_float(rr[0])+__uint_as_float(rr[1]);}
  if(hi==0)wsf[32+r32]=l_reg;asm volatile("s_waitcnt lgkmcnt(0)":::"memory");
  float rli[16];
  #pragma unroll
  for(int r=0;r<16;++r)rli[r]=__builtin_amdgcn_rcpf(wsf[32+crow(r,hi)]);
  bf16*Ow=Ou+(long)(wid*QBLK)*LDO;
  { bf16*stg=(bf16*)(shm+LDS_OST)+wid*2048;
    unsigned sbase=lds0+LDS_OST+(unsigned)wid*4096u+(unsigned)hi*512u+(unsigned)r32*2u; asm volatile("":"+v"(sbase));
    typedef __attribute__((address_space(3))) bf16* lds_hptr;
    #pragma unroll
    for(int r=0;r<16;++r){
      #pragma unroll
      for(int d0=0;d0<2;++d0)*(lds_hptr)(sbase+(unsigned)(((r&3)+8*(r>>2))*128+d0*64))=(bf16)(cvtpk_s(o[d0][r]*rli[r],0.f)&0xffffu);}
    asm volatile("s_waitcnt lgkmcnt(0)":::"memory");
    #pragma unroll
    for(int i=0;i<4;++i){const int row=i*8+(lane>>3),ch=lane&7; const u32x4 v=*(const u32x4*)(stg+row*64+ch*8); ATTN_STORE16(Ow+(long)row*LDO+ch*8,v);} }
  asm volatile("s_waitcnt lgkmcnt(0)\n\ts_barrier":::"memory");
  #undef DMA_K
  #undef DMA_V
  #undef CMASK
  #undef START
  #undef RESC
  #undef ROT
}
constexpr int ATTN_LDS_BYTES=LDS_BYTES;
#undef SBAR
#undef WAIT_BAR
}

__global__ void __launch_bounds__(NTHREADS, 2) mk_fwd(Args args) {
    extern __shared__ __attribute__((aligned(16))) unsigned char lds_raw[];
    LAS unsigned char* lds = (LAS unsigned char*)lds_raw;
    const int tid = threadIdx.x, lane = tid & 63, wave = __builtin_amdgcn_readfirstlane(tid >> 6);
    const int G = gridDim.x, bid = blockIdx.x;
    const int gw = bid * NWAVES + wave, NGW = G * NWAVES;
#define DECL_ALL \
    unsigned char* ws = args.ws; \
    const float* x = (const float*)args.in[0]; const float* mem = (const float*)args.in[1]; const int* positions = (const int*)args.in[2]; \
    const float* g_mix = (const float*)args.in[3]; const float* w_in = (const float*)args.in[4]; \
    const float* g_dq = (const float*)args.in[5]; const float* g_dk = (const float*)args.in[6]; \
    const float* lq1 = (const float*)args.in[7]; const float* lk1 = (const float*)args.in[8]; const float* lq2 = (const float*)args.in[9]; const float* lk2 = (const float*)args.in[10]; \
    const float* g_sub = (const float*)args.in[11]; const float* g_sgu = (const float*)args.in[12]; \
    const float* w_sp = (const float*)args.in[13]; const float* b_sp = (const float*)args.in[14]; \
    const float* g_memn = (const float*)args.in[15]; const float* w_kv = (const float*)args.in[16]; \
    const float* g_cq = (const float*)args.in[17]; const float* g_ck = (const float*)args.in[18]; \
    const float* w_out = (const float*)args.in[19]; const float* g_ffn = (const float*)args.in[20]; \
    const float* w_router = (const float*)args.in[21]; const float* b_router = (const float*)args.in[22]; \
    const float* w_mlp1 = (const float*)args.in[23]; const float* b_mlp1 = (const float*)args.in[24]; \
    const float* w_mlp2 = (const float*)args.in[25]; const float* b_mlp2 = (const float*)args.in[26]; \
    float* out = args.out; \
    unsigned* ctl = (unsigned*)(ws + WS_CTL); \
    bf16_t* WIN_T = (bf16_t*)(ws + WS_WIN); bf16_t* WO_T = (bf16_t*)(ws + WS_WO); bf16_t* WKV_T = (bf16_t*)(ws + WS_WKV); \
    float* CS = (float*)(ws + WS_CS); int* LIST = (int*)(ws + WS_LIST); float* GLIST = (float*)(ws + WS_GLIST); float* RS = (float*)(ws + WS_RS); (void)RS; \
    bf16_t* MEMN = (bf16_t*)(ws + WS_MEMN); bf16_t* MEMK = (bf16_t*)(ws + WS_MEMK); bf16_t* MEMV = (bf16_t*)(ws + WS_MEMV); \
    bf16_t* W1T = (bf16_t*)(ws + WS_W1); bf16_t* W2T = (bf16_t*)(ws + WS_W2); bf16_t* H2 = (bf16_t*)(ws + WS_H2); bf16_t* ACT = (bf16_t*)(ws + WS_ACT); \
    bf16_t* XN = (bf16_t*)(ws + WS_XN); bf16_t* QB = (bf16_t*)(ws + WS_QB); bf16_t* KB = (bf16_t*)(ws + WS_KB); bf16_t* VB = (bf16_t*)(ws + WS_VB); \
    bf16_t* UB = (bf16_t*)(ws + WS_UB); bf16_t* VGB = (bf16_t*)(ws + WS_VGB); bf16_t* MQB = (bf16_t*)(ws + WS_MQB); \
    bf16_t* CAT = (bf16_t*)(ws + WS_CAT); bf16_t* YB = (bf16_t*)(ws + WS_YB); bf16_t* OT = (bf16_t*)(ws + WS_OT); (void)OT; \
    float* PROJ = (float*)(ws + WS_PROJ); float* KVT = (float*)(ws + WS_KVT); \
    (void)x; (void)mem; (void)positions; (void)g_mix; (void)w_in; (void)g_dq; (void)g_dk; (void)lq1; (void)lk1; (void)lq2; (void)lk2; (void)g_sub; (void)g_sgu; (void)w_sp; (void)b_sp; \
    (void)g_memn; (void)w_kv; (void)g_cq; (void)g_ck; (void)w_out; (void)g_ffn; (void)w_router; (void)b_router; (void)w_mlp1; (void)b_mlp1; (void)w_mlp2; (void)b_mlp2; (void)out; (void)ctl; \
    (void)WIN_T; (void)WO_T; (void)WKV_T; (void)CS; (void)LIST; (void)GLIST; (void)MEMN; (void)MEMK; (void)MEMV; (void)W1T; (void)W2T; (void)H2; (void)ACT; (void)XN; (void)QB; (void)KB; (void)VB; \
    (void)UB; (void)VGB; (void)MQB; (void)CAT; (void)YB; (void)PROJ; (void)KVT;

    const int lo = args.ph_lo, hi = args.ph_hi;
#ifndef PHMASK
#define PHMASK 0x1ff
#endif
#define IN(k) (((PHMASK >> (k)) & 1) && lo <= (k) && (k) < hi)
#define BOTH(k) (IN(k) && IN((k) + 1))
#define GRID_BAR() do { __threadfence(); cg::this_grid().sync(); } while (0)

    if (IN(0)) {
        DECL_ALL
        LAS float* scr = (LAS float*)(lds + wave * 16384);
        constexpr int I_IN = 16 * (NPROJ / 32), I_O = 16 * 32, I_KV = 16 * 16, I_1 = 16 * 64, I_2 = 16 * 32;
        constexpr int NITEMS = I_IN + I_O + I_KV + NE * I_1 + NE * I_2;
        for (int it = gw; it < NITEMS; it += NGW) {
            int r = it;
            if (r < I_IN) { transpose_item_p(w_in, DM, NPROJ, WIN_T, scr, r, lane, [](int n) {
                    if (n < 1024 || n >= 2048) { const int w = n & 255, d = w & 63; return (n & ~255) + 128 * ((d >> 3) & 1) + 32 * (w >> 6) + 8 * (d >> 4) + (d & 7); } return n; }); continue; } r -= I_IN;
            if (r < I_O) { transpose_item(w_out, DM, DM, WO_T, scr, r, lane); continue; } r -= I_O;
            if (r < I_KV) { transpose_item_p(w_kv, DM, 512, WKV_T, scr, r, lane, [](int n) {
                    if (n < 256) { const int d = n & 63; return 128 * ((d >> 3) & 1) + 32 * (n >> 6) + 8 * (d >> 4) + (d & 7); } return n; }); continue; } r -= I_KV;
            if (r < NE * I_1) { const int e = r / I_1; transpose_item_p(w_mlp1 + (size_t)e * DM * 2048, DM, 2048, W1T + (size_t)e * 2048 * DM, scr, r % I_1, lane,
                                                                   [](int n) { const int half = n >> 10, q = n & 1023; return 256 * (q >> 7) + 128 * half + (q & 127); }); continue; } r -= NE * I_1;
            { const int e = r / I_2; transpose_item(w_mlp2 + (size_t)e * DFF * DM, DFF, DM, W2T + (size_t)e * DM * DFF, scr, r % I_2, lane); }
        }
        for (int m = gw; m < M; m += NGW) rms_row_to_bf16(x + (size_t)m * DM, g_mix, XN + (size_t)m * DM, lane);
        for (int m = gw; m < MM; m += NGW) rms_row_to_bf16(mem + (size_t)m * DM, g_memn, MEMN + (size_t)m * DM, lane);
        for (int i = bid * NTHREADS + tid; i < M * 8; i += G * NTHREADS) {
            const int tok = i >> 3, f = i & 7;
            const float inv = (float)exp2(-(double)f * 0.125 * 18.931568569324174);
            const float ang = (float)positions[tok] * inv;
            CS[(size_t)tok * 16 + f] = (float)cos((double)ang); CS[(size_t)tok * 16 + 8 + f] = (float)sin((double)ang);
        }
        if (bid == 0 && tid < 64) { ctl[tid] = 0u; float* GT = (float*)(ws + WS_CTL + 4096); GT[tid] = g_dq[tid]; GT[64 + tid] = g_dk[tid]; GT[128 + tid] = g_cq[tid]; GT[192 + tid] = g_ck[tid]; }
        if (BOTH(0)) GRID_BAR();
    }

    if (IN(1)) {
        DECL_ALL
        pg8::InProjSched S{(const char*)XN, (const char*)MEMN, (const char*)WIN_T, G, bid};
        pg8::EpiInProj E{ws};
        pg8::gemm_phase<pg8::EpiInProj, pg8::InProjSched, false>(lds, S, E, nullptr);
        if (BOTH(1)) GRID_BAR();
    }

    if (IN(2)) {
        DECL_ALL
    }

    if (IN(3)) {
        DECL_ALL
        const int vcu = (G % 8 == 0) ? (bid % 8) * (G / 8) + bid / 8 : bid;
        for (int pair = vcu; pair < BATCH * 4 * 4; pair += G) {
            const int bh = pair >> 2, s4 = pair & 3, b = bh >> 2, h = bh & 3; const size_t rb = (size_t)b * SEQ;
            for (int u = 0; u < 8; ++u) {
                const int qb = (u & 4) ? 7 - s4 : s4, c = (u >> 1) & 1, half = u & 1;
                attn_body::attn_unit<8, 512, 512, 512, 1024, true>(QB + (rb + qb * 256) * 512 + (h * 2 + c) * 64, KB + rb * 512 + (h * 2 + c) * 64, VB + rb * 512 + h * 128 + half * 64,
                                                                   OT + (rb + qb * 256) * 1024 + h * 256 + c * 128 + half * 64, 4 * qb + 4, (char*)lds_raw);
            }
            asm volatile("s_waitcnt vmcnt(0)" ::: "memory");
            __builtin_amdgcn_fence(__ATOMIC_RELEASE, "agent"); __builtin_amdgcn_fence(__ATOMIC_ACQUIRE, "agent");
            asm volatile("s_waitcnt vmcnt(0)" ::: "memory");
            __syncthreads();
            int ln = lane; asm volatile("" : "+v"(ln));
            const float lam = __expf(wave_sum(lq1[ln] * lk1[ln])) - __expf(wave_sum(lq2[ln] * lk2[ln])) + 0.2f;
            const float gs0 = g_sub[2 * ln], gs1 = g_sub[2 * ln + 1];
            for (int rr = wave; rr < 512; rr += NWAVES) {
                const int qb = (rr & 256) ? 7 - s4 : s4; const size_t row = rb + qb * 256 + (rr & 255);
                const unsigned w1 = *(const unsigned*)(OT + row * 1024 + h * 256 + 2 * ln), w2 = *(const unsigned*)(OT + row * 1024 + h * 256 + 128 + 2 * ln);
                const float a0 = bf2f(w1 & 0xffffu) - lam * bf2f(w2 & 0xffffu), a1 = bf2f(w1 >> 16) - lam * bf2f(w2 >> 16);
                const float rstd = 0.8f / sqrtf(wave_sum(a0 * a0 + a1 * a1) * (1.f / 128) + EPS);
                *(unsigned*)(CAT + row * 1024 + h * 128 + 2 * ln) = pk2(a0 * rstd * gs0, a1 * rstd * gs1);
            }
        }
        for (int j = vcu; j < BATCH * 4 * 8; j += G) {
            const int bh = j >> 3, qb = j & 7, b = bh >> 2, h = bh & 3; const size_t rb = (size_t)b * SEQ;
            attn_body::attn_unit<8, 256, 256, 256, 1024, false>(MQB + (rb + qb * 256) * 256 + h * 64, MEMK + (size_t)b * MEML * 256 + h * 64, MEMV + (size_t)b * MEML * 256 + h * 64,
                                                                CAT + (rb + qb * 256) * 1024 + 768 + h * 64, MEML / 64, (char*)lds_raw);
        }
        __syncthreads();
        LAS float* vt = (LAS float*)lds;
        for (int it = bid; it < BATCH * 16; it += G) {
            const size_t r0 = (size_t)it * 128;
            for (int rr = wave; rr < 128; rr += NWAVES) {
                const u32x2 w = *(const u32x2*)(VGB + (r0 + rr) * 256 + 4 * lane);
                const float v0 = bf2f(w.x & 0xffffu), v1 = bf2f(w.x >> 16), v2 = bf2f(w.y & 0xffffu), v3 = bf2f(w.y >> 16);
                const float mean = wave_sum((v0 + v1) + (v2 + v3)) * (1.f / 256);
                const float d0 = v0 - mean, d1 = v1 - mean, d2 = v2 - mean, d3 = v3 - mean;
                const float rstd = 1.0f / sqrtf(wave_sum((d0 * d0 + d1 * d1) + (d2 * d2 + d3 * d3)) * (1.f / 256) + EPS);
                const f32x4 gg = *(const f32x4*)(g_sgu + 4 * lane);
                *(LAS f32x4*)(vt + rr * 256 + 4 * lane) = (f32x4){d0 * rstd * gg.x, d1 * rstd * gg.y, d2 * rstd * gg.z, d3 * rstd * gg.w};
            }
            __syncthreads();
            const int ch = tid & 255, g = ch >> 6;
            for (int i = 0; i < 64; ++i) {
                const int t = 2 * i + (tid >> 8);
                const float* wr = w_sp + ((size_t)g * 128 + t) * 128;
                float acc = 0.f;
                for (int s = 0; s <= t; ++s) acc += wr[s] * vt[s * 256 + ch];
                const float u = bf2f(UB[(r0 + t) * 256 + ch]);
                CAT[(r0 + t) * 1024 + 512 + ch] = (bf16_t)f2bf(u * (acc + b_sp[g * 128 + t]));
            }
            __syncthreads();
        }
        if (BOTH(3)) GRID_BAR();
    }

    if (IN(4)) {
        DECL_ALL
        pg8::DenseSched S{(const char*)CAT, (const char*)WO_T, DM / 256, (M / 256) * (DM / 256), G, bid};
        pg8::EpiResidual E{x, out, H2, g_ffn};
        pg8::gemm_phase<pg8::EpiResidual, pg8::DenseSched, false>(lds, S, E, nullptr);
        if (BOTH(4)) GRID_BAR();
    }

    if (IN(5)) {
        DECL_ALL
        LAS float* wg = (LAS float*)lds;
        for (int idx = tid; idx < DM * NE; idx += NTHREADS) { const int k = idx >> 5, e = idx & 31; wg[((k >> 2) * 32 + e) * 4 + (k & 3)] = w_router[idx] * g_ffn[k]; }
        LAS unsigned* lcnt = (LAS unsigned*)(lds + 141 * 1024); LAS unsigned* lbase = lcnt + 32;
        const int i16 = lane & 15, kq = lane >> 4;
        const float be0 = b_router[i16], be1 = b_router[16 + i16];
        for (int tile = bid; tile < M / 128; tile += G) {
            if (tid < 32) lcnt[tid] = 0u;
            __syncthreads();
            const int tok0 = tile * 128 + wave * 16;
            const float* xp = out + (size_t)(tok0 + i16) * DM + 4 * kq;
            const LAS float* wp = wg + (kq * 32 + i16) * 4;
            f32x4 acc0 = (f32x4){0.f, 0.f, 0.f, 0.f}, acc1 = (f32x4){0.f, 0.f, 0.f, 0.f}; float ss = 0.f;
#pragma unroll 4
            for (int j = 0; j < 64; ++j) {
                const f32x4 xv = *(const f32x4*)(xp + 16 * j);
                const f32x4 b0 = *(const LAS f32x4*)(wp + j * 512), b1 = *(const LAS f32x4*)(wp + j * 512 + 64);
                ss += (xv[0] * xv[0] + xv[1] * xv[1]) + (xv[2] * xv[2] + xv[3] * xv[3]);
#pragma unroll
                for (int q = 0; q < 4; ++q) { acc0 = __builtin_amdgcn_mfma_f32_16x16x4f32(xv[q], b0[q], acc0, 0, 0, 0); acc1 = __builtin_amdgcn_mfma_f32_16x16x4f32(xv[q], b1[q], acc1, 0, 0, 0); }
            }
            ss += __shfl_xor(ss, 16); ss += __shfl_xor(ss, 32);
            const float rstd = 1.0f / sqrtf(ss * (1.f / DM) + EPS);
            unsigned key0[4], key1[4]; float rsr[4];
#pragma unroll
            for (int reg = 0; reg < 4; ++reg) {
                rsr[reg] = __shfl(rstd, 4 * kq + reg);
                const float l0 = acc0[reg] * rsr[reg] + be0, l1 = acc1[reg] * rsr[reg] + be1;
                unsigned u0 = __float_as_uint(l0), u1 = __float_as_uint(l1);
                u0 ^= (u0 >> 31) ? 0xffffffffu : 0x80000000u; u1 ^= (u1 >> 31) ? 0xffffffffu : 0x80000000u;
                key0[reg] = (u0 & ~31u) | (unsigned)(31 - i16); key1[reg] = (u1 & ~31u) | (unsigned)(15 - i16);
            }
            unsigned win[4][4];
#pragma unroll
            for (int k = 0; k < 4; ++k)
#pragma unroll
                for (int reg = 0; reg < 4; ++reg) {
                    unsigned mk = key0[reg] > key1[reg] ? key0[reg] : key1[reg];
#pragma unroll
                    for (int o = 1; o < 16; o <<= 1) { const unsigned ok = (unsigned)__shfl_xor((int)mk, o); mk = ok > mk ? ok : mk; }
                    win[reg][k] = mk;
                    if (key0[reg] == mk) key0[reg] = 0u; if (key1[reg] == mk) key1[reg] = 0u;
                }
            unsigned mym = 0u; float myg = 0.f, myrs = 0.f;
#pragma unroll
            for (int reg = 0; reg < 4; ++reg) {
                float v[4], ex[4], sum = 0.f;
#pragma unroll
                for (int k = 0; k < 4; ++k) { unsigned uu = win[reg][k] & ~31u; uu ^= (uu >> 31) ? 0x80000000u : 0xffffffffu; v[k] = __uint_as_float(uu); }
#pragma unroll
                for (int k = 0; k < 4; ++k) { ex[k] = __expf(v[k] - v[0]); sum += ex[k]; }
                const float rsum = 1.0f / sum;
#pragma unroll
                for (int k = 0; k < 4; ++k) if (i16 == 4 * reg + k) { mym = win[reg][k]; myg = ex[k] * rsum; myrs = rsr[reg]; }
            }
            const int e_sel = 31 - (int)(mym & 31u);
            const unsigned lr = atomicAdd((unsigned*)&lcnt[e_sel], 1u);
            __syncthreads();
            if (tid < 32) { const unsigned c = lcnt[tid]; lbase[tid] = c ? atomicAdd(&ctl[tid], c) : 0u; }
            __syncthreads();
            const size_t slot = (size_t)e_sel * M + lbase[e_sel] + lr;
            LIST[slot] = (tok0 + 4 * kq + (i16 >> 2)) * 4 + (i16 & 3); GLIST[slot] = myg; RS[slot] = myrs;
        }
        if (BOTH(5)) GRID_BAR();
    }

    LAS int* tstart = (LAS int*)(lds + 140 * 1024); LAS int* ecnt = tstart + 40;
    if (IN(6) || IN(7)) {
        DECL_ALL
        __syncthreads();
        if (tid == 0) { int acc = 0; for (int e = 0; e < NE; ++e) { const int c = (int)__hip_atomic_load(&ctl[e], __ATOMIC_RELAXED, __HIP_MEMORY_SCOPE_AGENT); tstart[e] = acc; ecnt[e] = c; acc += (c + 255) / 256; } tstart[NE] = acc; }
        __syncthreads();
    }
    if (IN(6)) {
        DECL_ALL
        const int ntiles = tstart[NE];
        pg8::MoeSched S{(const char*)H2, (const char*)W1T, (size_t)2048 * DM * 2, LIST, tstart, ecnt, 8, ntiles * 8, G, bid, false};
        pg8::EpiSwiglu E{ACT, b_mlp1, RS, ecnt};
        pg8::gemm_phase<pg8::EpiSwiglu, pg8::MoeSched, true>(lds, S, E, (LAS unsigned*)(lds + 131072));
        if (BOTH(6)) GRID_BAR();
    }
    if (IN(7)) {
        DECL_ALL
        const int ntiles = tstart[NE];
        pg8::MoeSched S{(const char*)ACT, (const char*)W2T, (size_t)DM * DFF * 2, LIST, tstart, ecnt, 4, ntiles * 4, G, bid, true};
        pg8::EpiGateScatter E{YB, b_mlp2, LIST, GLIST, ecnt};
        pg8::gemm_phase<pg8::EpiGateScatter, pg8::MoeSched, false>(lds, S, E, nullptr);
        if (BOTH(7)) GRID_BAR();
    }
    if (IN(8)) {
        DECL_ALL
        for (size_t i = (size_t)bid * NTHREADS + tid; i < (size_t)M * DM / 4; i += (size_t)G * NTHREADS) {
            const size_t tok = i / (DM / 4); const int c = (int)(i % (DM / 4)) * 4;
            f32x4 a = *(const f32x4*)(out + tok * DM + c);
#pragma unroll
            for (int k = 0; k < 4; ++k) {
                const u32x2 w = *(const u32x2*)(YB + (tok * 4 + k) * DM + c);
                a.x += bf2f(w.x & 0xffffu); a.y += bf2f(w.x >> 16); a.z += bf2f(w.y & 0xffffu); a.w += bf2f(w.y >> 16);
            }
            *(f32x4*)(out + tok * DM + c) = a;
        }
    }
#undef IN
#undef BOTH
}

extern "C" void kernel_launch(void* const* d_in, const int* in_sizes, int n_in, void* d_out, int out_size, void* d_ws, size_t ws_size, hipStream_t stream) {
    static int grid = 0;
    if (grid == 0) {
        if (n_in != 27 || out_size != M * DM || ws_size < WS_END) { fprintf(stderr, "kernel_launch: unexpected problem (n_in %d out %d ws %zu)\n", n_in, out_size, ws_size); grid = -1; return; }
        int dev = 0, cus = 0, per_cu = 0;
        hipGetDevice(&dev); hipDeviceGetAttribute(&cus, hipDeviceAttributeMultiprocessorCount, dev);
        if (hipFuncSetAttribute((const void*)mk_fwd, hipFuncAttributeMaxDynamicSharedMemorySize, LDS_BYTES) != hipSuccess) { fprintf(stderr, "kernel_launch: hipFuncSetAttribute failed\n"); grid = -1; return; }
        hipOccupancyMaxActiveBlocksPerMultiprocessor(&per_cu, (const void*)mk_fwd, NTHREADS, LDS_BYTES);
        (void)hipGetLastError();
        if (per_cu < 1) { fprintf(stderr, "kernel_launch: occupancy query says %d blocks per CU\n", per_cu); per_cu = 1; }
        grid = cus;
    }
    if (grid < 0) return;
    Args a{};
    for (int i = 0; i < 27; ++i) a.in[i] = d_in[i];
    a.out = (float*)d_out; a.ws = (unsigned char*)d_ws;
    constexpr int NPH = 9;
    if (MK_N_LAUNCHES == 1) {
        a.ph_lo = 0; a.ph_hi = NPH;
        void* kargs[] = {&a};
        hipError_t e = hipLaunchCooperativeKernel((const void*)mk_fwd, dim3(grid), dim3(NTHREADS), kargs, LDS_BYTES, stream);
        if (e != hipSuccess) fprintf(stderr, "cooperative launch failed: %s (grid %d)\n", hipGetErrorString(e), grid);
    } else {
        for (int p = 0; p < NPH; ++p) { a.ph_lo = p; a.ph_hi = p + 1; hipLaunchKernelGGL(mk_fwd, dim3(grid), dim3(NTHREADS), LDS_BYTES, stream, a); }
    }
}
```

```cpp
#include <hip/hip_runtime.h>
#include <hip/hip_cooperative_groups.h>
#include <cstdio>
#include <cstdint>
namespace cg = cooperative_groups;

#ifndef MK_N_LAUNCHES
#define MK_N_LAUNCHES 1
#endif

constexpr int BATCH = 16, SEQ = 2048, DM = 1024, M = BATCH * SEQ;
constexpr int NPROJ = 2304;
constexpr int MEML = 256, MM = BATCH * MEML;
constexpr int NE = 32, TOPK = 4, DFF = 1024;
constexpr int MAXTILES = (M * TOPK) / 256 + NE;
constexpr int NSLOT = MAXTILES * 256;
constexpr float EPS = 1e-6f;
constexpr float C2 = 0.125f * 1.4426950408889634f;
constexpr int NWAVES = 8, NTHREADS = 512;
constexpr int LDS_BYTES = 163840;

constexpr size_t MiB = 1u << 20;
constexpr size_t WS_CTL = 0, CTL_ZERO_BYTES = 65536;
constexpr int CW_BAR = 4096;
constexpr size_t WS_WIN = 2 * MiB, WS_WKV = WS_WIN + (size_t)NPROJ * DM * 2  , WS_WO = 8 * MiB, WS_CS = 10 * MiB, WS_LIST = 12 * MiB, WS_GLIST = 16 * MiB;
constexpr size_t WS_MEMN = 20 * MiB, WS_MEMK = 28 * MiB, WS_MEMV = 30 * MiB;
constexpr size_t WS_W1 = 32 * MiB, WS_W2 = 160 * MiB, WS_H2 = 224 * MiB, WS_ACT = 288 * MiB;
constexpr size_t WS_XN = 560 * MiB, WS_QB = 624 * MiB, WS_KB = 656 * MiB, WS_VB = 688 * MiB, WS_UB = 720 * MiB, WS_VGB = 736 * MiB, WS_MQB = 752 * MiB;
constexpr size_t WS_OT = 768 * MiB, WS_CAT = 832 * MiB, WS_RS = 896 * MiB  , WS_END = 900 * MiB;
constexpr size_t WS_RSX = 1 * MiB;
constexpr size_t WS_M1B = 488 * MiB;
constexpr size_t WS_SLOTS = 17 * MiB;
constexpr size_t WS_X1B = 424 * MiB;
constexpr size_t WS_YB = 560 * MiB;
constexpr size_t WS_PROJ = 224 * MiB;
constexpr size_t WS_KVT = 512 * MiB;
static_assert(WS_ACT + (size_t)NSLOT * DFF * 2 <= WS_XN, "act");
static_assert(WS_ACT + (size_t)NSLOT * DFF <= WS_X1B && WS_X1B + (size_t)M * DM * 2 <= WS_M1B && WS_M1B + (size_t)M * DM * 2 <= WS_XN, "x1b, m1b");
static_assert(WS_PROJ + (size_t)M * NPROJ * 4 <= WS_KVT && WS_KVT + (size_t)MM * 512 * 4 <= WS_XN, "proj temp");

#define LAS __attribute__((address_space(3)))
typedef unsigned short bf16_t;
typedef short bf16x8 __attribute__((ext_vector_type(8)));
typedef float f32x4 __attribute__((ext_vector_type(4)));
typedef unsigned u32x4 __attribute__((ext_vector_type(4)));
typedef unsigned u32x2 __attribute__((ext_vector_type(2)));
typedef int i32x4 __attribute__((ext_vector_type(4)));
typedef int i32x8 __attribute__((ext_vector_type(8)));

__device__ __forceinline__ unsigned f2bf(float f) { unsigned u = __float_as_uint(f); return (u + 0x7fffu + ((u >> 16) & 1u)) >> 16; }
__device__ __forceinline__ float bf2f(unsigned h) { return __uint_as_float(h << 16); }
__device__ __forceinline__ unsigned pk2(float lo, float hi) { return f2bf(lo) | (f2bf(hi) << 16); }
__device__ __forceinline__ float wave_sum(float v) {
#pragma unroll
    for (int o = 1; o < 64; o <<= 1) v += __shfl_xor(v, o);
    return v;
}
__device__ __forceinline__ float gelu_tanh(float x) {
    constexpr float K1 = -2.f * 0.7978845608028654f * 1.4426950408889634f, K2 = K1 * 0.044715f;
    return x * __builtin_amdgcn_rcpf(1.f + __builtin_amdgcn_exp2f(x * (K1 + K2 * (x * x))));
}

struct Args {
    const void* in[27]; float* out; unsigned char* ws; int ph_lo, ph_hi;
};

template <bool KSCALE = false, class RowMap>
__device__ __forceinline__ void transpose_item_p(const float* W, int K, int N, bf16_t* WT, LAS float* scr, int item, int lane, RowMap rm, const float* ks = nullptr) {
    const int nblk = N / 32, kb = item / nblk, nb = item % nblk, k0 = 64 * kb, n0 = 32 * nb;
#pragma unroll 8
    for (int i = 0; i < 32; ++i) { const int kk = 2 * i + (lane >> 5); float wv = W[(size_t)(k0 + kk) * N + n0 + (lane & 31)]; if (KSCALE) wv *= ks[k0 + kk]; scr[kk * 33 + (lane & 31)] = wv; }
    asm volatile("s_waitcnt lgkmcnt(0)" ::: "memory");
    const int c = lane & 7;
#pragma unroll
    for (int j = 0; j < 4; ++j) { const int n = (lane >> 3) + 8 * j; const LAS float* s = scr + (8 * c) * 33 + n;
        u32x4 o; o.x = pk2(s[0 * 33], s[1 * 33]); o.y = pk2(s[2 * 33], s[3 * 33]); o.z = pk2(s[4 * 33], s[5 * 33]); o.w = pk2(s[6 * 33], s[7 * 33]);
        *(u32x4*)(WT + (size_t)rm(n0 + n) * K + k0 + 8 * c) = o; }
    asm volatile("s_waitcnt lgkmcnt(0)" ::: "memory");
}
template <class RowMap>
__device__ __forceinline__ void transpose_item_f8(const float* W, int K, int N, unsigned char* WT, LAS float* scr, int item, int lane, RowMap rm) {
    const int nblk = N / 32, kb = item / nblk, nb = item % nblk, k0 = 128 * kb, n0 = 32 * nb;
    const int lk = lane >> 3, lp = lane & 7;
    const float* src = W + (size_t)(k0 + lk) * N + n0 + 4 * lp;
#pragma unroll 4
    for (int i = 0; i < 16; ++i) { const int kk = 8 * i + lk; const f32x4 v = __builtin_nontemporal_load((const f32x4*)(src + (size_t)(8 * i) * N));
        LAS float* d = scr + kk * 33 + 16 * (kk >> 6) + 4 * lp; d[0] = v[0]; d[1] = v[1]; d[2] = v[2]; d[3] = v[3]; }
    asm volatile("s_waitcnt lgkmcnt(0)" ::: "memory");
    const int n = lane >> 1, kh = lane & 1; const LAS float* s = scr + (64 * kh) * 33 + 16 * kh + n;
    unsigned char* o = WT + (size_t)rm(n0 + n) * K + k0 + 64 * kh;
#pragma unroll
    for (int q = 0; q < 4; ++q) { u32x4 w;
#pragma unroll
        for (int j = 0; j < 4; ++j) { const LAS float* t = s + (16 * q + 4 * j) * 33;
            int p = __builtin_amdgcn_cvt_pk_fp8_f32(t[0] * 64.f, t[33] * 64.f, 0, false); p = __builtin_amdgcn_cvt_pk_fp8_f32(t[66] * 64.f, t[99] * 64.f, p, true); w[j] = (unsigned)p; }
        *(u32x4*)(o + 16 * q) = w; }
    asm volatile("s_waitcnt lgkmcnt(0)" ::: "memory");
}
__device__ __forceinline__ void transpose_item(const float* W, int K, int N, bf16_t* WT, LAS float* scr, int item, int lane) {
    const int nblk = N / 32, kb = item / nblk, nb = item % nblk, k0 = 64 * kb, n0 = 32 * nb;
#pragma unroll 8
    for (int i = 0; i < 32; ++i) { const int kk = 2 * i + (lane >> 5); scr[kk * 33 + (lane & 31)] = W[(size_t)(k0 + kk) * N + n0 + (lane & 31)]; }
    asm volatile("s_waitcnt lgkmcnt(0)" ::: "memory");
    const int c = lane & 7;
#pragma unroll
    for (int j = 0; j < 4; ++j) { const int n = (lane >> 3) + 8 * j; const LAS float* s = scr + (8 * c) * 33 + n;
        u32x4 o; o.x = pk2(s[0 * 33], s[1 * 33]); o.y = pk2(s[2 * 33], s[3 * 33]); o.z = pk2(s[4 * 33], s[5 * 33]); o.w = pk2(s[6 * 33], s[7 * 33]);
        *(u32x4*)(WT + (size_t)(n0 + n) * K + k0 + 8 * c) = o; }
    asm volatile("s_waitcnt lgkmcnt(0)" ::: "memory");
}
__device__ __forceinline__ void rms_row2_to_bf16(const float* xrow0, const float* xrow1, const float* g, bf16_t* orow0, bf16_t* orow1, int lane) {
    const f32x4* xa = (const f32x4*)xrow0 + lane; const f32x4* xb = (const f32x4*)xrow1 + lane; const f32x4* gr = (const f32x4*)g + lane;
    f32x4 va[4], vb[4]; float sa = 0.f, sb = 0.f;
#pragma unroll
    for (int j = 0; j < 4; ++j) { va[j] = __builtin_nontemporal_load(xa + 64 * j); vb[j] = __builtin_nontemporal_load(xb + 64 * j); }
#pragma unroll
    for (int j = 0; j < 4; ++j) { sa += (va[j].x * va[j].x + va[j].y * va[j].y) + (va[j].z * va[j].z + va[j].w * va[j].w); sb += (vb[j].x * vb[j].x + vb[j].y * vb[j].y) + (vb[j].z * vb[j].z + vb[j].w * vb[j].w); }
#pragma unroll
    for (int o = 1; o < 64; o <<= 1) { sa += __shfl_xor(sa, o); sb += __shfl_xor(sb, o); }
    const float ra = 1.0f / sqrtf(sa * (1.f / DM) + EPS), rb = 1.0f / sqrtf(sb * (1.f / DM) + EPS);
    u32x2* oa = (u32x2*)orow0 + lane; u32x2* ob = (u32x2*)orow1 + lane;
#pragma unroll
    for (int j = 0; j < 4; ++j) { const f32x4 gg = gr[64 * j]; u32x2 w;
        w.x = pk2(va[j].x * ra * gg.x, va[j].y * ra * gg.y); w.y = pk2(va[j].z * ra * gg.z, va[j].w * ra * gg.w); oa[64 * j] = w;
        w.x = pk2(vb[j].x * rb * gg.x, vb[j].y * rb * gg.y); w.y = pk2(vb[j].z * rb * gg.z, vb[j].w * rb * gg.w); ob[64 * j] = w; }
}
__device__ __forceinline__ void row2_to_bf16_rs(const float* xrow0, const float* xrow1, bf16_t* orow0, bf16_t* orow1, float* rs0, int lane) {
    const f32x4* xa = (const f32x4*)xrow0 + lane; const f32x4* xb = (const f32x4*)xrow1 + lane;
    f32x4 va[4], vb[4]; float sa = 0.f, sb = 0.f;
#pragma unroll
    for (int j = 0; j < 4; ++j) { va[j] = __builtin_nontemporal_load(xa + 64 * j); vb[j] = __builtin_nontemporal_load(xb + 64 * j); }
    u32x2* oa = (u32x2*)orow0 + lane; u32x2* ob = (u32x2*)orow1 + lane;
#pragma unroll
    for (int j = 0; j < 4; ++j) { u32x2 w; w.x = pk2(va[j].x, va[j].y); w.y = pk2(va[j].z, va[j].w); oa[64 * j] = w; w.x = pk2(vb[j].x, vb[j].y); w.y = pk2(vb[j].z, vb[j].w); ob[64 * j] = w; }
#pragma unroll
    for (int j = 0; j < 4; ++j) { sa += (va[j].x * va[j].x + va[j].y * va[j].y) + (va[j].z * va[j].z + va[j].w * va[j].w); sb += (vb[j].x * vb[j].x + vb[j].y * vb[j].y) + (vb[j].z * vb[j].z + vb[j].w * vb[j].w); }
#pragma unroll
    for (int o = 1; o < 64; o <<= 1) { sa += __shfl_xor(sa, o); sb += __shfl_xor(sb, o); }
    if (lane == 0) { rs0[0] = 1.0f / sqrtf(sa * (1.f / DM) + EPS); rs0[1] = 1.0f / sqrtf(sb * (1.f / DM) + EPS); }
}
__device__ __forceinline__ void rms_row_to_bf16(const float* xrow, const float* g, bf16_t* orow, int lane) {
    const f32x4* xr = (const f32x4*)xrow + lane; const f32x4* gr = (const f32x4*)g + lane;
    f32x4 v[4]; float s = 0.f;
#pragma unroll
    for (int j = 0; j < 4; ++j) { v[j] = xr[64 * j]; s += (v[j].x * v[j].x + v[j].y * v[j].y) + (v[j].z * v[j].z + v[j].w * v[j].w); }
    const float rstd = 1.0f / sqrtf(wave_sum(s) * (1.f / DM) + EPS);
    u32x2* o8 = (u32x2*)orow + lane;
#pragma unroll
    for (int j = 0; j < 4; ++j) { const f32x4 gg = gr[64 * j]; u32x2 w; w.x = pk2(v[j].x * rstd * gg.x, v[j].y * rstd * gg.y); w.y = pk2(v[j].z * rstd * gg.z, v[j].w * rstd * gg.w); o8[64 * j] = w; }
}

namespace pg8 {
constexpr int BM = 256, BK = 64, HALF = 128, HTB = HALF * BK * 2, STAGE_BYTES = 8 * HTB, KD = 1024;
__device__ __forceinline__ int lds_byte(int r, int c) { const int st = (r >> 4) * 2 + (c >> 5), rr = r & 15, cc = c & 31, ob = rr * 64 + cc * 2; return st * 1024 + (ob ^ (((ob >> 9) & 1) << 5)); }
__device__ __forceinline__ void stage_rc(int b, int& R, int& C) { const int st = b / 1024, sb = b % 1024, swz = sb ^ (((sb >> 9) & 1) << 5); R = (st >> 1) * 16 + swz / 64; C = (st & 1) * 32 + (swz % 64) / 2; }
__device__ __forceinline__ int perm32(int rho) { const int n = rho >> 4, i = rho & 15; return 8 * (i >> 2) + 4 * n + (i & 3); }
__device__ __forceinline__ unsigned cvt_pk_bf16(float lo, float hi) { unsigned r; asm volatile("v_cvt_pk_bf16_f32 %0, %1, %2" : "=v"(r) : "v"(lo), "v"(hi)); return r; }

struct Unit { const char* a; const char* b; int t, pn, e, mt; };

template <class Epi, class Sched, bool GATHER, bool F8 = false, int NTP = 0  >
__device__ __forceinline__ void gemm_phase(LAS unsigned char* lds, const Sched& S, const Epi& E, LAS unsigned* xoff) {
    const int tid = threadIdx.x, wid = __builtin_amdgcn_readfirstlane(tid >> 6), lane = tid & 63, wr = wid >> 2, wc = wid & 3, fr = lane & 15, fq = lane >> 4;
    constexpr int RB = F8 ? KD : KD * 2, nt = NTP ? NTP : RB / (BK * 2);
    unsigned voffA0[2], voffA1[2], voffB[2];
    Unit cur, nxt; int ui = 0;
    if (!S.next(0, cur)) return;
#pragma unroll
    for (int i = 0; i < 2; ++i) { int R, C; stage_rc(tid * 16 + i * 8192, R, C); const int Rb = Epi::PERM ? ((R & ~31) + perm32(R & 31)) : R;
        voffB[i] = (unsigned)(Rb * RB + C * 2);
        if (GATHER) { voffA0[i] = S.arow(cur, R) + (unsigned)C * 2u; voffA1[i] = S.arow(cur, R + HALF) + (unsigned)C * 2u; }
        else { voffA0[i] = (unsigned)(R * RB + C * 2); voffA1[i] = 0u; } }
    if (GATHER) {
        Unit u1; const bool h1 = S.next(1, u1); if (!h1) u1 = cur;
        unsigned x1[4];
#pragma unroll
        for (int i = 0; i < 2; ++i) { int R, C; stage_rc(tid * 16 + i * 8192, R, C); x1[i] = S.arow(u1, R) + (unsigned)C * 2u; x1[2 + i] = S.arow(u1, R + HALF) + (unsigned)C * 2u; }
#pragma unroll
        for (int i = 0; i < 4; ++i) xoff[tid * 4 + i] = x1[i];
    }
    const size_t kstep = (size_t)(BK * 2);
    const size_t hstep = (size_t)HALF * RB;
    const size_t hA = GATHER ? (size_t)0 : hstep;
#define PG8_VA1 (GATHER ? voffA1 : voffA0)
    const unsigned ldsw = (unsigned)wid * 1024u;
    const int aoff = lds_byte(wr * 64 + fr, fq * 8), boff = lds_byte(wc * 32 + fr, fq * 8);
#define PG8_SA(b, h) (((b) * 2 + (h)) * HTB)
#define PG8_SB(b, h) ((4 + (b) * 2 + (h)) * HTB)
#define PG8_STAGE(bufoff, gbase, voff) do { _Pragma("unroll") for (int _i = 0; _i < 2; ++_i) \
        __builtin_amdgcn_global_load_lds((const unsigned*)((const char*)(gbase) + (voff)[_i]), (LAS unsigned*)(lds + (bufoff) + ldsw + _i * 8192), 16, 0, 0); } while (0)
#define PG8_LD2(base) __builtin_shufflevector(*(const LAS i32x4*)(base), *(const LAS i32x4*)((base) + 1024), 0, 1, 2, 3, 4, 5, 6, 7)
#define PG8_LDA(dst, b, h) do { _Pragma("unroll") for (int m = 0; m < 4; ++m) dst[m] = PG8_LD2(lds + PG8_SA(b, h) + aoff + m * 2048); } while (0)
#define PG8_LDB(dst, b, h) do { _Pragma("unroll") for (int n = 0; n < 2; ++n) dst[n] = PG8_LD2(lds + PG8_SB(b, h) + boff + n * 2048); } while (0)
#define PG8_LO(x) __builtin_bit_cast(bf16x8, __builtin_shufflevector((x), (x), 0, 1, 2, 3))
#define PG8_HI(x) __builtin_bit_cast(bf16x8, __builtin_shufflevector((x), (x), 4, 5, 6, 7))
#define PG8_MMA(ai, bj, At, Bt) do { __builtin_amdgcn_s_setprio(1); _Pragma("unroll") for (int m = 0; m < 4; ++m) _Pragma("unroll") for (int n = 0; n < 2; ++n) { \
        if constexpr (F8) acc[ai][bj][m][n] = __builtin_amdgcn_mfma_scale_f32_16x16x128_f8f6f4(Bt[n], At[m], acc[ai][bj][m][n], 0, 0, 0, 0x7f7f7f7f, 0, 0x7f7f7f7f); \
        else { acc[ai][bj][m][n] = __builtin_amdgcn_mfma_f32_16x16x32_bf16(PG8_LO(Bt[n]), PG8_LO(At[m]), acc[ai][bj][m][n], 0, 0, 0); \
               acc[ai][bj][m][n] = __builtin_amdgcn_mfma_f32_16x16x32_bf16(PG8_HI(Bt[n]), PG8_HI(At[m]), acc[ai][bj][m][n], 0, 0, 0); } } __builtin_amdgcn_s_setprio(0); } while (0)
#define PG8_WAIT_V(n) asm volatile("s_waitcnt vmcnt(" #n ")" ::: "memory")
#define PG8_WAIT_L(n) asm volatile("s_waitcnt lgkmcnt(" #n ")" ::: "memory")
#define PG8_BAR __builtin_amdgcn_s_barrier()
#define PG8_SCHED __builtin_amdgcn_sched_barrier(0)
    f32x4 acc[2][2][4][2];
#pragma unroll
    for (int a = 0; a < 2; ++a)
#pragma unroll
        for (int b = 0; b < 2; ++b)
#pragma unroll
            for (int m = 0; m < 4; ++m)
#pragma unroll
                for (int n = 0; n < 2; ++n) acc[a][b][m][n] = (f32x4){0.f, 0.f, 0.f, 0.f};
    i32x8 At[4], B0[2], B1[2];
    const char* cA = cur.a; const char* cB = cur.b;
    PG8_WAIT_V(0);
    PG8_STAGE(PG8_SB(0, 0), cB, voffB); PG8_STAGE(PG8_SB(0, 1), cB + hstep, voffB); PG8_STAGE(PG8_SA(0, 0), cA, voffA0); PG8_STAGE(PG8_SA(0, 1), cA + hA, PG8_VA1);
    if (wr == 1) PG8_BAR;
    PG8_WAIT_V(2); PG8_BAR;
    PG8_STAGE(PG8_SB(1, 0), cB + kstep, voffB); PG8_STAGE(PG8_SA(1, 0), cA + kstep, voffA0); PG8_STAGE(PG8_SB(1, 1), cB + hstep + kstep, voffB);
    PG8_WAIT_V(6); PG8_BAR;
    for (;;) {
        const bool has_next = S.next(ui + 1, nxt);
        const char* nA = has_next ? nxt.a : cA; const char* nB = has_next ? nxt.b : cB;
#pragma unroll 1
        for (int t = 0; t < nt; t += 2) {
            const bool last = (t == nt - 2);
            const char* a1 = cA + (size_t)(t + 1) * kstep;
            const char* a2 = last ? nA : cA + (size_t)(t + 2) * kstep; const char* b2 = last ? nB : cB + (size_t)(t + 2) * kstep;
            const char* a3 = a2 + kstep; const char* b3 = b2 + kstep;
            PG8_LDB(B0, 0, 0); PG8_LDB(B1, 0, 1); PG8_SCHED; PG8_LDA(At, 0, 0); PG8_STAGE(PG8_SA(1, 1), a1 + hA, PG8_VA1);
            if (GATHER) { if (last && has_next) {
#pragma unroll
                for (int i = 0; i < 2; ++i) { voffA0[i] = xoff[tid * 4 + i]; voffA1[i] = xoff[tid * 4 + 2 + i]; } } }
            PG8_WAIT_V(8); PG8_WAIT_L(0); PG8_BAR; PG8_MMA(0, 0, At, B0); PG8_MMA(0, 1, At, B1); PG8_BAR; PG8_SCHED;
            PG8_LDA(At, 0, 1); PG8_STAGE(PG8_SB(0, 0), b2, voffB); PG8_STAGE(PG8_SB(0, 1), b2 + hstep, voffB); PG8_STAGE(PG8_SA(0, 0), a2, voffA0);
            PG8_WAIT_V(8); PG8_WAIT_L(0); PG8_BAR; PG8_MMA(1, 0, At, B0); PG8_MMA(1, 1, At, B1); PG8_BAR; PG8_SCHED;
            PG8_LDB(B0, 1, 0); PG8_LDB(B1, 1, 1); PG8_SCHED; PG8_LDA(At, 1, 0); PG8_STAGE(PG8_SA(0, 1), a2 + hA, PG8_VA1);
            PG8_WAIT_V(8); PG8_WAIT_L(0); PG8_BAR; PG8_MMA(0, 0, At, B0); PG8_MMA(0, 1, At, B1); PG8_BAR; PG8_SCHED;
            PG8_LDA(At, 1, 1); PG8_STAGE(PG8_SB(1, 0), b3, voffB); PG8_STAGE(PG8_SB(1, 1), b3 + hstep, voffB); PG8_STAGE(PG8_SA(1, 0), a3, voffA0);
            PG8_WAIT_V(8); PG8_WAIT_L(0); PG8_BAR; PG8_MMA(1, 0, At, B0); PG8_MMA(1, 1, At, B1); PG8_BAR; PG8_SCHED;
        }
        if (wr == 0) PG8_BAR;
        int nx[4] = {0, 0, 0, 0};
        if (GATHER) {
            Unit u2; if (!S.next(ui + 2, u2)) u2 = cur;
#pragma unroll
            for (int i = 0; i < 2; ++i) { int R, C; stage_rc(tid * 16 + i * 8192, R, C); nx[i] = S.araw(u2, R); nx[2 + i] = S.araw(u2, R + HALF); }
        }
        E(acc, cur, wr, wc, fr, fq);
        if (GATHER) {
#pragma unroll
            for (int i = 0; i < 2; ++i) { int R, C; stage_rc(tid * 16 + i * 8192, R, C); xoff[tid * 4 + i] = S.afin(nx[i]) + (unsigned)C * 2u; xoff[tid * 4 + 2 + i] = S.afin(nx[2 + i]) + (unsigned)C * 2u; }
        }
        if (!has_next) break;
#pragma unroll
        for (int a = 0; a < 2; ++a)
#pragma unroll
            for (int b = 0; b < 2; ++b)
#pragma unroll
                for (int m = 0; m < 4; ++m)
#pragma unroll
                    for (int n = 0; n < 2; ++n) acc[a][b][m][n] = (f32x4){0.f, 0.f, 0.f, 0.f};
        cur = nxt; cA = nA; cB = nB; ++ui;
        if (wr == 1) PG8_BAR;
    }
    PG8_WAIT_V(0);
    PG8_BAR;
#undef PG8_SA
#undef PG8_VA1
#undef PG8_SB
#undef PG8_STAGE
#undef PG8_LDA
#undef PG8_LDB
#undef PG8_MMA
#undef PG8_LD2
#undef PG8_LO
#undef PG8_HI
#undef PG8_WAIT_V
#undef PG8_WAIT_L
#undef PG8_BAR
#undef PG8_SCHED
}

struct DenseSched {
    const char* A; const char* B; int nN, total, G, c;
    __device__ __forceinline__ bool next(int i, Unit& u) const {
        const int per = G >> 3; const int L = (i * 8 + (c & 7)) * per + (c >> 3); if (L >= total) return false;
        const int pm = L / nN, pn = L % nN; u.a = A + (size_t)pm * (BM * KD * 2); u.b = B + (size_t)pn * (BM * KD * 2); u.t = pm; u.pn = pn; u.e = 0; u.mt = pm; return true;
    }
    __device__ __forceinline__ unsigned arow(const Unit&, int) const { return 0u; }
    __device__ __forceinline__ int araw(const Unit&, int) const { return 0; }
    __device__ __forceinline__ unsigned afin(int) const { return 0u; }
};
struct MoeSched {
    const char* A; const char* B; size_t b_expert_stride; const int* list; LAS const int* tstart; LAS const int* ecnt; LAS const int* texp; int nN, total, G, c; bool tile_major_a; int rb; bool hot = false;
    __device__ __forceinline__ bool next(int i, Unit& u) const {
        const int per = G >> 3; const int L = (i * 8 + (c & 7)) * per + (c >> 3); if (L >= total) return false;
        const int t = L / nN, pn = L % nN; const int e = texp[t];
        u.t = t; u.pn = pn; u.e = e; u.mt = t - tstart[e];
        u.a = tile_major_a ? A + (size_t)t * (size_t)(BM * rb) : A; u.b = B + (size_t)e * b_expert_stride + (size_t)pn * (size_t)(BM * rb);
        if (hot) u.b = B; return true;
    }
    __device__ __forceinline__ unsigned arow(const Unit& u, int R) const {
        if (tile_major_a || hot) return (unsigned)R * (unsigned)rb;
        return afin(araw(u, R));
    }
    __device__ __forceinline__ int araw(const Unit& u, int R) const {
        if (tile_major_a || hot) return R << 2;
        const int rank = min(u.mt * 256 + R, max(ecnt[u.e] - 1, 0)); return list[(size_t)u.e * M + rank];
    }
    __device__ __forceinline__ unsigned afin(int raw) const { return (unsigned)(raw >> 2) * (unsigned)rb; }
};

struct EpiResidual {
    static constexpr bool PERM = true;
    bf16_t* o;
    __device__ __forceinline__ void operator()(const f32x4 (&acc)[2][2][4][2], const Unit& u, int wr, int wc, int fr, int fq) const {
        asm volatile("" : "+v"(fr), "+v"(fq));
        const int col0 = u.pn * BM + wc * 32 + 8 * fq;
        const size_t base = (size_t)(u.t * BM + wr * 64 + fr) * DM + col0;
#pragma unroll
        for (int ai = 0; ai < 2; ++ai)
#pragma unroll
            for (int m = 0; m < 4; ++m) { const size_t off = base + (size_t)(ai * HALF + m * 16) * DM;
#pragma unroll
                for (int bj = 0; bj < 2; ++bj) { u32x4 w;
#pragma unroll
                    for (int n = 0; n < 2; ++n) { w[2 * n] = cvt_pk_bf16(acc[ai][bj][m][n][0], acc[ai][bj][m][n][1]); w[2 * n + 1] = cvt_pk_bf16(acc[ai][bj][m][n][2], acc[ai][bj][m][n][3]); }
                    *(u32x4*)(o + off + bj * HALF) = w; } }
    }
};
struct EpiSwiglu {
    static constexpr bool PERM = true;
    unsigned char* act; const float* b1; const float* rs; LAS const int* ecnt;
    __device__ __forceinline__ void operator()(const f32x4 (&acc)[2][2][4][2], const Unit& u, int wr, int wc, int fr, int fq) const {
        asm volatile("" : "+v"(fr), "+v"(fq));
        const int c0 = u.pn * HALF + wc * 32 + 8 * fq; const float* bg = b1 + (size_t)u.e * 2048 + c0; const int cnt = ecnt[u.e];
        f32x4 bv[2][2];
#pragma unroll
        for (int bj = 0; bj < 2; ++bj)
#pragma unroll
            for (int n = 0; n < 2; ++n) bv[bj][n] = *(const f32x4*)(bg + bj * 1024 + 4 * n);
        float rsv[2][4];
#pragma unroll
        for (int ai = 0; ai < 2; ++ai)
#pragma unroll
            for (int m = 0; m < 4; ++m) rsv[ai][m] = rs[(size_t)u.e * M + u.mt * 256 + ai * HALF + wr * 64 + m * 16 + fr];
        asm volatile("" : "+v"(rsv[0][0]), "+v"(rsv[0][1]), "+v"(rsv[0][2]), "+v"(rsv[0][3]), "+v"(rsv[1][0]), "+v"(rsv[1][1]), "+v"(rsv[1][2]), "+v"(rsv[1][3]));
#pragma unroll
        for (int ai = 0; ai < 2; ++ai)
#pragma unroll
            for (int m = 0; m < 4; ++m) {
                const int rl = ai * HALF + wr * 64 + m * 16 + fr, rank = u.mt * 256 + rl;
                const float r = rank < cnt ? rsv[ai][m] * (1.0f / 64.0f) : 0.f;
                float a8[8];
#pragma unroll
                for (int n = 0; n < 2; ++n)
#pragma unroll
                    for (int i = 0; i < 4; ++i) {
                        const float glu = fminf(acc[ai][0][m][n][i] * r + bv[0][n][i], 7.0f), lin = fminf(fmaxf(acc[ai][1][m][n][i] * r + bv[1][n][i], -7.0f), 7.0f);
                        a8[4 * n + i] = glu * __builtin_amdgcn_rcpf(1.0f + __builtin_amdgcn_exp2f(glu * (-1.702f * 1.4426950408889634f))) * (lin + 1.0f);
                    }
                int w0 = __builtin_amdgcn_cvt_pk_fp8_f32(a8[0], a8[1], 0, false); w0 = __builtin_amdgcn_cvt_pk_fp8_f32(a8[2], a8[3], w0, true);
                int w1 = __builtin_amdgcn_cvt_pk_fp8_f32(a8[4], a8[5], 0, false); w1 = __builtin_amdgcn_cvt_pk_fp8_f32(a8[6], a8[7], w1, true);
                *(u32x2*)(act + ((size_t)u.t * BM + rl) * DFF + c0) = (u32x2){(unsigned)w0, (unsigned)w1};
            }
    }
};
struct EpiGateScatter {
    static constexpr bool PERM = true;
    unsigned char* yb; const float* b2;
    __device__ __forceinline__ void operator()(const f32x4 (&acc)[2][2][4][2], const Unit& u, int wr, int wc, int fr, int fq) const {
        asm volatile("" : "+v"(fr), "+v"(fq));
        const int c0 = u.pn * BM + wc * 64 + 16 * fq; const float* bb = b2 + (size_t)u.e * DM + c0;
        f32x4 bv[2][2];
#pragma unroll
        for (int bj = 0; bj < 2; ++bj)
#pragma unroll
            for (int n = 0; n < 2; ++n) bv[bj][n] = *(const f32x4*)(bb + 8 * bj + 4 * n);
#pragma unroll
        for (int ai = 0; ai < 2; ++ai)
#pragma unroll
            for (int m = 0; m < 4; ++m) {
                const int rl = ai * HALF + wr * 64 + m * 16 + fr;
                u32x4 w;
#pragma unroll
                for (int bj = 0; bj < 2; ++bj) { const f32x4 v0 = acc[ai][bj][m][0] * (1.0f / 64.0f) + bv[bj][0], v1 = acc[ai][bj][m][1] * (1.0f / 64.0f) + bv[bj][1];
                    int w0 = __builtin_amdgcn_cvt_pk_fp8_f32(v0[0], v0[1], 0, false); w0 = __builtin_amdgcn_cvt_pk_fp8_f32(v0[2], v0[3], w0, true);
                    int w1 = __builtin_amdgcn_cvt_pk_fp8_f32(v1[0], v1[1], 0, false); w1 = __builtin_amdgcn_cvt_pk_fp8_f32(v1[2], v1[3], w1, true);
                    w[2 * bj] = (unsigned)w0; w[2 * bj + 1] = (unsigned)w1; }
                *(u32x4*)(yb + ((size_t)u.t * BM + rl) * DM + c0) = w;
            }
    }
};

struct EpiInProj {
    static constexpr bool PERM = true;
    unsigned char* wsb;
    template <bool ROPE>
    __device__ __forceinline__ void normed(const f32x4 (&acc)[2][2][4][2], const float* gp, float sc, bf16_t* dst, int pitch, int row0, int wc, int fq, const float* rsp) const {
        const float* cs = (const float*)(wsb + WS_CS);
        float rsv[8];
#pragma unroll
        for (int q = 0; q < 8; ++q) rsv[q] = rsp[(q >> 2) * HALF + (q & 3) * 16];
        f32x4 gv[2][2];
#pragma unroll
        for (int bj = 0; bj < 2; ++bj)
#pragma unroll
            for (int n = 0; n < 2; ++n) gv[bj][n] = *(const f32x4*)(gp + 16 * fq + 8 * bj + 4 * n) * sc;
        f32x4 cb[2][4];
#define IP_CS(q) do { const int rw = row0 + ((q) >> 2) * HALF + ((q) & 3) * 16; _Pragma("unroll") for (int j = 0; j < 4; ++j) cb[(q) & 1][j] = *(const f32x4*)(cs + (size_t)rw * 16 + 4 * j); } while (0)
        if (ROPE) IP_CS(0);
        float ss[8];
#pragma unroll
        for (int q = 0; q < 8; ++q) { float a = 0.f;
#pragma unroll
            for (int bj = 0; bj < 2; ++bj)
#pragma unroll
                for (int n = 0; n < 2; ++n) { const f32x4 v = acc[q >> 2][bj][q & 3][n]; a += (v[0] * v[0] + v[1] * v[1]) + (v[2] * v[2] + v[3] * v[3]); }
            ss[q] = a; }
#pragma unroll
        for (int q = 0; q < 8; ++q) ss[q] += __shfl_xor(ss[q], 16);
#pragma unroll
        for (int q = 0; q < 8; ++q) ss[q] += __shfl_xor(ss[q], 32);
#pragma unroll
        for (int q = 0; q < 8; ++q) {
            const int ai = q >> 2, m = q & 3, row = row0 + ai * HALF + m * 16;
            if (ROPE && q + 1 < 8) IP_CS(q + 1);
            const float rstd = rsv[q] * __builtin_amdgcn_rsqf(rsv[q] * rsv[q] * ss[q] * (1.f / 64) + EPS);
            f32x4 y[2][2];
#pragma unroll
            for (int bj = 0; bj < 2; ++bj)
#pragma unroll
                for (int n = 0; n < 2; ++n) y[bj][n] = acc[ai][bj][m][n] * rstd * gv[bj][n];
            if (ROPE) {
                const bool z = fq == 0;
#pragma unroll
                for (int n = 0; n < 2; ++n) { f32x4 c = cb[q & 1][n], sn = cb[q & 1][2 + n];
#pragma unroll
                    for (int i = 0; i < 4; ++i) { c[i] = z ? c[i] : 1.f; sn[i] = z ? sn[i] : 0.f; }
                    const f32x4 x1 = y[0][n], x2 = y[1][n]; y[0][n] = x1 * c - x2 * sn; y[1][n] = x2 * c + x1 * sn; }
            }
            bf16_t* o = dst + (size_t)row * pitch + wc * 64 + 16 * fq;
#pragma unroll
            for (int bj = 0; bj < 2; ++bj) { u32x4 w; w.x = cvt_pk_bf16(y[bj][0][0], y[bj][0][1]); w.y = cvt_pk_bf16(y[bj][0][2], y[bj][0][3]); w.z = cvt_pk_bf16(y[bj][1][0], y[bj][1][1]); w.w = cvt_pk_bf16(y[bj][1][2], y[bj][1][3]);
                *(u32x4*)(o + 8 * bj) = w; }
        }
#undef IP_CS
    }
    __device__ __forceinline__ void operator()(const f32x4 (&acc)[2][2][4][2], const Unit& u, int wr, int wc, int fr, int fq) const {
        asm volatile("" : "+v"(fr), "+v"(fq));
        const int pn = u.pn; const int row0 = u.t * BM + wr * 64 + fr;
        const float* rsp = (const float*)(wsb + WS_RSX) + (pn >= 9 ? M : 0) + row0;
        if (pn < 4 || pn == 8 || pn == 9) {
            const float* gp = (const float*)(wsb + WS_CTL + 4096) + 64 * (pn < 2 ? 0 : pn < 4 ? 1 : pn == 8 ? 2 : 3);
            const float sc = (pn < 2 || pn == 8) ? C2 : 1.0f;
            const size_t doff = pn < 2 ? WS_QB + (size_t)pn * 512 : pn < 4 ? WS_KB + (size_t)(pn - 2) * 512 : pn == 8 ? WS_MQB : WS_MEMK;
            bf16_t* dst = (bf16_t*)(wsb + doff); const int pitch = pn < 4 ? 512 : 256;
            if (pn < 4) normed<true>(acc, gp, sc, dst, pitch, row0, wc, fq, rsp); else normed<false>(acc, gp, sc, dst, pitch, row0, wc, fq, rsp);
        } else {
            const bool act = (pn == 6 || pn == 7);
            const size_t doff = pn < 6 ? WS_VB + (size_t)(pn - 4) * 512 : pn == 6 ? WS_UB : pn == 7 ? WS_VGB : WS_MEMV;
            bf16_t* dst = (bf16_t*)(wsb + doff); const int pitch = pn < 6 ? 512 : 256;
            float rsv[8];
#pragma unroll
            for (int q = 0; q < 8; ++q) rsv[q] = rsp[(q >> 2) * HALF + (q & 3) * 16];
#pragma unroll
            for (int ai = 0; ai < 2; ++ai)
#pragma unroll
                for (int m = 0; m < 4; ++m) {
                    bf16_t* o = dst + (size_t)(row0 + ai * HALF + m * 16) * pitch + wc * 32 + 8 * fq;
#pragma unroll
                    for (int bj = 0; bj < 2; ++bj) { f32x4 v0 = acc[ai][bj][m][0] * rsv[ai * 4 + m], v1 = acc[ai][bj][m][1] * rsv[ai * 4 + m];
                        if (act) {
#pragma unroll
                            for (int i = 0; i < 4; ++i) { v0[i] = gelu_tanh(v0[i]); v1[i] = gelu_tanh(v1[i]); } }
                        u32x4 w; w.x = cvt_pk_bf16(v0[0], v0[1]); w.y = cvt_pk_bf16(v0[2], v0[3]); w.z = cvt_pk_bf16(v1[0], v1[1]); w.w = cvt_pk_bf16(v1[2], v1[3]);
                        *(u32x4*)(o + bj * HALF) = w; }
                }
        }
    }
};
struct InProjSched {
    const char* XNb; const char* MEMNb; const char* B; int G, c;
    __device__ __forceinline__ bool next(int i, Unit& u) const {
        constexpr int N1 = (M / 256) * 9, N2 = (MM / 256) * 2;
        const int per = G >> 3; const int L = (i * 8 + (c & 7)) * per + (c >> 3); if (L >= N1 + N2) return false;
        int pm, pn; const char* a;
        if (L < N1) { pm = L / 9; pn = L % 9; a = XNb; } else { const int j = L - N1; pm = j >> 1; pn = 9 + (j & 1); a = MEMNb; }
        u.a = a + (size_t)pm * (BM * KD * 2); u.b = B + (size_t)pn * (BM * KD * 2); u.t = pm; u.pn = pn; u.e = 0; u.mt = pm; return true;
    }
    __device__ __forceinline__ unsigned arow(const Unit&, int) const { return 0u; }
    __device__ __forceinline__ int araw(const Unit&, int) const { return 0; }
    __device__ __forceinline__ unsigned afin(int) const { return 0u; }
};
}

namespace attn_body {
typedef unsigned short bf16;
using bf16x8=__attribute__((ext_vector_type(8)))short;
using s16x4=__attribute__((ext_vector_type(4)))short;
using f32x16=__attribute__((ext_vector_type(16)))float;
using u32x4=__attribute__((ext_vector_type(4)))unsigned;
using f32x4_t=__attribute__((ext_vector_type(4)))float;
constexpr int D=64;
constexpr int NW=8,QBLK=32,QB=QBLK*NW,KVBLK=64;
__device__ __forceinline__ int crow(int r,int hi){return (r&3)+8*(r>>2)+4*hi;}
#define SBAR() __builtin_amdgcn_sched_barrier(0)
__device__ __forceinline__ void cmask(f32x16&p0,f32x16&p1,int jb,int qrel,int hi){
  const float NEG=-INFINITY; const int lim=qrel-(64*jb+4*hi);
  #pragma unroll
  for(int r=0;r<16;++r){const int kc=(r&3)+8*(r>>2); if(kc>lim)p0[r]=NEG; if(kc+32>lim)p1[r]=NEG;}
}

constexpr int NSLOT=3, SLOTB=8192;
constexpr int LDS_K=0, LDS_V=NSLOT*SLOTB, LDS_WS=2*NSLOT*SLOTB, LDS_OST=LDS_WS+NW*64*4, LDS_BYTES=LDS_OST+NW*4096;
constexpr float C2=0.125f*1.4426950408889634f;
__device__ __forceinline__ void glds16(const void*gsrc,unsigned lds_dst){unsigned keep;
  asm volatile("s_mov_b32 %0, m0\n\ts_mov_b32 m0, %2\n\ts_nop 0\n\tglobal_load_lds_dwordx4 %1, off\n\ts_mov_b32 m0, %0":"=&s"(keep):"v"(gsrc),"s"(lds_dst):"memory");}
__device__ __forceinline__ float max3f(float a,float b,float c){float r;asm("v_max3_f32 %0, %1, %2, %3":"=v"(r):"v"(a),"v"(b),"v"(c));return r;}
__device__ __forceinline__ float max2f(float a,float b){float r;asm("v_max_f32_e32 %0, %1, %2":"=v"(r):"v"(a),"v"(b));return r;}
__device__ __forceinline__ float fadd_s(float a,float b){float r;asm("v_add_f32_e32 %0, %1, %2":"=v"(r):"v"(a),"v"(b));return r;}
__device__ __forceinline__ float fsub_s(float a,float b){float r;asm("v_sub_f32_e32 %0, %1, %2":"=v"(r):"v"(a),"v"(b));return r;}
typedef float f32x2_t __attribute__((ext_vector_type(2))); typedef __bf16 bf16x2_t __attribute__((ext_vector_type(2)));
__device__ __forceinline__ unsigned cvtpk_s(float lo,float hi){f32x2_t v={lo,hi};bf16x2_t b=__builtin_convertvector(v,bf16x2_t);return __builtin_bit_cast(unsigned,b);}
#define WAIT_BAR(N) asm volatile("s_waitcnt vmcnt(" #N ") lgkmcnt(0)\n\ts_barrier":::"memory")

__device__ __forceinline__ void qkt(f32x16&p0,f32x16&p1,const char*Kslot,const bf16x8*qr,const f32x16&negm,int r32,int hi){
  const char*kb=Kslot+hi*1024+r32*16;
  #pragma unroll
  for(int d0=0;d0<4;++d0){
    const bf16x8 b0=*reinterpret_cast<const bf16x8*>(kb+d0*2048);
    const bf16x8 b1=*reinterpret_cast<const bf16x8*>(kb+d0*2048+512);
    if(d0==0){p0=__builtin_amdgcn_mfma_f32_32x32x16_bf16(b0,qr[0],negm,0,0,0);p1=__builtin_amdgcn_mfma_f32_32x32x16_bf16(b1,qr[0],negm,0,0,0);}
    else{p0=__builtin_amdgcn_mfma_f32_32x32x16_bf16(b0,qr[d0],p0,0,0,0);p1=__builtin_amdgcn_mfma_f32_32x32x16_bf16(b1,qr[d0],p1,0,0,0);}}
}
typedef __attribute__((address_space(3))) const char* lds_cptr;
typedef short v4i16_t __attribute__((ext_vector_type(4)));
__device__ __forceinline__ void kload8(bf16x8*kf,lds_cptr kp){
  kf[0]=*(const __attribute__((address_space(3))) bf16x8*)(kp);      kf[1]=*(const __attribute__((address_space(3))) bf16x8*)(kp+512);
  kf[2]=*(const __attribute__((address_space(3))) bf16x8*)(kp+2048); kf[3]=*(const __attribute__((address_space(3))) bf16x8*)(kp+2560);
  kf[4]=*(const __attribute__((address_space(3))) bf16x8*)(kp+4096); kf[5]=*(const __attribute__((address_space(3))) bf16x8*)(kp+4608);
  kf[6]=*(const __attribute__((address_space(3))) bf16x8*)(kp+6144); kf[7]=*(const __attribute__((address_space(3))) bf16x8*)(kp+6656);
}
__device__ __forceinline__ void kload2(bf16x8*kf,lds_cptr kp,int j){ kf[2*j]=*(const __attribute__((address_space(3))) bf16x8*)(kp+j*2048); kf[2*j+1]=*(const __attribute__((address_space(3))) bf16x8*)(kp+j*2048+512); }
__device__ __forceinline__ s16x4 vtr(lds_cptr p){ return __builtin_bit_cast(s16x4,__builtin_amdgcn_ds_read_tr16_b64_v4i16((__attribute__((address_space(3))) v4i16_t*)p)); }
__device__ __forceinline__ float rowmax(const f32x16&p0,const f32x16&p1){
  float a=max3f(p0[0],p0[1],p1[0]),b=max3f(p0[2],p0[3],p1[1]);a=max3f(a,p1[2],p1[3]);
  #pragma unroll
  for(int r=4;r<16;r+=4){a=max3f(a,p0[r],p0[r+1]);b=max3f(b,p0[r+2],p0[r+3]);a=max3f(a,p1[r],p1[r+1]);b=max3f(b,p1[r+2],p1[r+3]);}
  const float m=max2f(a,b);
  auto rr=__builtin_amdgcn_permlane32_swap(__float_as_uint(m),__float_as_uint(m),false,false);
  return max2f(__uint_as_float(rr[0]),__uint_as_float(rr[1]));
}
__device__ __forceinline__ void pv(f32x16*o,int vb,bf16x8 pa0,bf16x8 pa1,bf16x8 pa2,bf16x8 pa3){
  #pragma unroll
  for(int d0=0;d0<2;++d0){s16x4 lo[4],hi[4];
    #pragma unroll
    for(int ks=0;ks<4;++ks){
      asm volatile("ds_read_b64_tr_b16 %0,%1 offset:%c2":"=&v"(lo[ks]):"v"(vb),"i"(d0*4096+ks*1024):"memory");
      asm volatile("ds_read_b64_tr_b16 %0,%1 offset:%c2":"=&v"(hi[ks]):"v"(vb),"i"(d0*4096+ks*1024+512):"memory");}
    asm volatile("s_waitcnt lgkmcnt(0)":::"memory");SBAR();
    #define PK(k) (bf16x8){lo[k][0],lo[k][1],lo[k][2],lo[k][3],hi[k][0],hi[k][1],hi[k][2],hi[k][3]}
    o[d0]=__builtin_amdgcn_mfma_f32_32x32x16_bf16(pa0,PK(0),o[d0],0,0,0);
    o[d0]=__builtin_amdgcn_mfma_f32_32x32x16_bf16(pa1,PK(1),o[d0],0,0,0);
    o[d0]=__builtin_amdgcn_mfma_f32_32x32x16_bf16(pa2,PK(2),o[d0],0,0,0);
    o[d0]=__builtin_amdgcn_mfma_f32_32x32x16_bf16(pa3,PK(3),o[d0],0,0,0);
    #undef PK
  }
}

#ifndef ATTN_STORE16
#define ATTN_STORE16(p,v) (*(u32x4*)(p)=(v))
#endif
template<int THRL,int LDQ,int LDK,int LDV,int LDO,bool CAUSAL> __device__ __forceinline__ void attn_unit(const bf16*Qu,const bf16*__restrict__ Kh,const bf16*__restrict__ Vh,bf16*Ou,const int NT,char*shm){
  const int tid=threadIdx.x,lane=tid&63,r32=lane&31,hi=lane>>5; const int wid=__builtin_amdgcn_readfirstlane(tid>>6);
  const bf16*Qw=Qu+(long)(wid*QBLK)*LDQ;
  const unsigned lds0=(unsigned)(uintptr_t)shm;
  float*wsf=(float*)(shm+LDS_WS)+wid*64;
  const bf16*ksrc=Kh+(long)lane*LDK+wid*8;
  const bf16*vsrc=Vh+(long)(16*(wid&3)+(lane>>2))*LDV+(wid>>2)*32+(lane&3)*8;
  const unsigned kdst=lds0+LDS_K+wid*1024, vdst=lds0+LDS_V+wid*1024;
  #define DMA_K(t,slot) glds16(ksrc+(long)(t)*KVBLK*LDK,(unsigned)__builtin_amdgcn_readfirstlane(kdst+(slot)))
  #define DMA_V(t,slot) glds16(vsrc+(long)(t)*KVBLK*LDV,(unsigned)__builtin_amdgcn_readfirstlane(vdst+(slot)))
  const int vb0=(int)(lds0+LDS_V)+((lane>>4)&1)*32+(lane&3)*8+(4*hi+((lane&15)>>2))*64;
  const char*Kbase=shm+LDS_K; bf16x8 kf[8];
  const lds_cptr shm3=(lds_cptr)shm; const lds_cptr kp0=shm3+LDS_K+hi*1024+r32*16; const lds_cptr vp0=shm3+LDS_V+((lane>>4)&1)*32+(lane&3)*8+(4*hi+((lane&15)>>2))*64;
  DMA_K(0,0);DMA_V(0,0);DMA_K(1,SLOTB);
  bf16x8 qr[4];
  #pragma unroll
  for(int d0=0;d0<4;++d0)qr[d0]=*reinterpret_cast<const bf16x8*>(&Qw[(long)r32*LDQ+d0*16+hi*8]);
  float mhat=0.f,l_reg=0.f;f32x16 o[2];o[0]=f32x16{};o[1]=f32x16{};float nms=0.f; const f32x16 zero16=f32x16{};
  const int qrel=wid*QBLK+r32;
  #define CMASK(P0,P1,t) do{ if(CAUSAL){int jb_=(t)-(NT-4); if(jb_>=0)cmask(P0,P1,jb_,qrel,hi);} }while(0)
  bool resc=false;
  #define START(P0,P1) do{ const float rm=rowmax(P0,P1); resc=false; \
    { const float dl=rm; mhat=fadd_s(mhat,dl); \
      _Pragma("unroll") for(int r=0;r<16;++r){P0[r]=fsub_s(P0[r],dl);P1[r]=fsub_s(P1[r],dl);} \
      nms=-mhat; } \
    _Pragma("unroll") for(int r=0;r<16;++r)P0[r]=__builtin_amdgcn_exp2f(P0[r]); }while(0)
  #define RESC() do{ if(resc){ asm volatile("s_waitcnt lgkmcnt(0)":::"memory"); \
      _Pragma("unroll") for(int d_=0;d_<2;++d_) _Pragma("unroll") for(int r=0;r<16;++r)o[d_][r]*=wsf[crow(r,hi)]; } }while(0)
  f32x16 pA0,pA1,pB0,pB1;
  int sl_prev=0,sl_cur=0,sl_next=SLOTB;
  #define ROT() do{sl_prev=sl_cur;sl_cur=sl_next;sl_next=(sl_next==(NSLOT-1)*SLOTB)?0:sl_next+SLOTB;}while(0)
  DMA_K(2,2*SLOTB);
  WAIT_BAR(3);
  qkt(pA0,pA1,Kbase,qr,zero16,r32,hi);asm volatile("s_nop 15\n\ts_nop 7":"+v"(pA0),"+v"(pA1));CMASK(pA0,pA1,0);
  START(pA0,pA1);
  _Pragma("unroll") for(int r=0;r<16;++r)pA1[r]=__builtin_amdgcn_exp2f(pA1[r]);
  WAIT_BAR(0);
  DMA_K(3,0);DMA_V(1,SLOTB);
  ROT();
  kload8(kf,kp0+sl_cur);
  WAIT_BAR(2);
  s16x4 vlo[8],vhi[8]; u32x4 pw0,pw1,pw2,pw3;
  #define PKW(P,B) cvtpk_s(P[B],P[B+1])
  #define PAF(k) __builtin_bit_cast(bf16x8,pw##k)
  #define VFR(i) (bf16x8){vlo[i][0],vlo[i][1],vlo[i][2],vlo[i][3],vhi[i][0],vhi[i][1],vhi[i][2],vhi[i][3]}
  #define PIN(x) asm volatile("":"+v"(x))
  #define MX3(a,b,c) __builtin_fmaxf(__builtin_fmaxf((a),(b)),(c))
  #define GAPA(MF,A0,A1,A2,A3,W0,W1,PW) do{ MF; sacc+=A0; sacc+=A1; sacc+=A2; sacc+=A3; PIN(sacc); W0; W1; PIN(PW); SBAR(); }while(0)
  #define EX(v) __builtin_amdgcn_exp2f(v)
  #define GAPB(MF,X,B) do{ MF; X[B]=EX(X[B]); X[B+1]=EX(X[B+1]); X[B+2]=EX(X[B+2]); X[B+3]=EX(X[B+3]); PIN(X); SBAR(); }while(0)
  #define VRD(i) do{ vlo[i]=vtr(vp_+(((i)>>2)*4096+((i)&3)*1024)); vhi[i]=vtr(vp_+(((i)>>2)*4096+((i)&3)*1024+512)); }while(0)
  #define KRD(G,j) do{ if(G){ kload2(kf,kp0+sl_next,j); SBAR(); } }while(0)
  #define STEP(C0,C1,P0,P1,t,GK,GV,GL) do{ SBAR(); \
    const lds_cptr vp_=vp0+sl_prev; \
    VRD(0); SBAR(); float sacc=(P0[0]+P0[1]); \
    GAPA(C0=__builtin_amdgcn_mfma_f32_32x32x16_bf16(kf[0],qr[0],zero16,0,0,0), P0[2],P0[3],P0[4],P0[5],     pw0[0]=PKW(P0,0), pw0[1]=PKW(P0,2), pw0); \
    VRD(4); SBAR(); GAPA(C1=__builtin_amdgcn_mfma_f32_32x32x16_bf16(kf[1],qr[0],zero16,0,0,0), P0[6],P0[7],P0[8],P0[9],     pw0[2]=PKW(P0,4), pw0[3]=PKW(P0,6), pw0); \
    VRD(1); SBAR(); GAPA(C0=__builtin_amdgcn_mfma_f32_32x32x16_bf16(kf[2],qr[1],C0,0,0,0),   P0[10],P0[11],P0[12],P0[13], pw1[0]=PKW(P0,8), pw1[1]=PKW(P0,10), pw1); \
    VRD(5); SBAR(); GAPA(C1=__builtin_amdgcn_mfma_f32_32x32x16_bf16(kf[3],qr[1],C1,0,0,0),   P0[14],P0[15],P1[0],P1[1],   pw1[2]=PKW(P0,12),pw1[3]=PKW(P0,14), pw1); \
    VRD(2); SBAR(); GAPA(C0=__builtin_amdgcn_mfma_f32_32x32x16_bf16(kf[4],qr[2],C0,0,0,0),   P1[2],P1[3],P1[4],P1[5],     pw2[0]=PKW(P1,0), pw2[1]=PKW(P1,2), pw2); \
    VRD(6); SBAR(); GAPA(C1=__builtin_amdgcn_mfma_f32_32x32x16_bf16(kf[5],qr[2],C1,0,0,0),   P1[6],P1[7],P1[8],P1[9],     pw2[2]=PKW(P1,4), pw2[3]=PKW(P1,6), pw2); \
    VRD(3); SBAR(); GAPA(C0=__builtin_amdgcn_mfma_f32_32x32x16_bf16(kf[6],qr[3],C0,0,0,0),   P1[10],P1[11],P1[12],P1[13], pw3[0]=PKW(P1,8), pw3[1]=PKW(P1,10), pw3); \
    VRD(7); SBAR(); GAPA(C1=__builtin_amdgcn_mfma_f32_32x32x16_bf16(kf[7],qr[3],C1,0,0,0),   P1[14],P1[15],0.f,0.f,       pw3[2]=PKW(P1,12),pw3[3]=PKW(P1,14), pw3); \
    l_reg+=sacc; \
    _Pragma("unroll") for(int r=0;r<16;++r){C0[r]+=nms;C1[r]+=nms;} \
    if(GK){DMA_K((t)+3,sl_cur);} if(GV){DMA_V((t)+1,sl_next);} \
    CMASK(C0,C1,t); \
    { float a=MX3(C0[0],C0[1],C1[0]),b=MX3(C0[2],C0[3],C1[1]); a=MX3(a,C1[2],C1[3]); \
      _Pragma("unroll") for(int r=4;r<16;r+=4){a=MX3(a,C0[r],C0[r+1]);b=MX3(b,C0[r+2],C0[r+3]);a=MX3(a,C1[r],C1[r+1]);b=MX3(b,C1[r+2],C1[r+3]);} \
      float rm=__builtin_fmaxf(a,b); { auto rr=__builtin_amdgcn_permlane32_swap(__float_as_uint(rm),__float_as_uint(rm),false,false); rm=__builtin_fmaxf(__uint_as_float(rr[0]),__uint_as_float(rr[1])); } \
      resc=false; \
      if(__builtin_expect(__any(rm>(float)THRL),0)){ const float dl=__builtin_fmaxf(rm,0.f); mhat+=dl; \
        _Pragma("unroll") for(int r=0;r<16;++r){C0[r]-=dl;C1[r]-=dl;} \
        nms=-mhat; \
        const float f=__builtin_amdgcn_exp2f(-dl); l_reg*=f; if(hi==0)wsf[r32]=f; resc=true; } } \
    SBAR(); \
    GAPB(o[0]=__builtin_amdgcn_mfma_f32_32x32x16_bf16(PAF(0),VFR(0),o[0],0,0,0), C0,0); \
    GAPB(o[1]=__builtin_amdgcn_mfma_f32_32x32x16_bf16(PAF(0),VFR(4),o[1],0,0,0), C0,4); \
    KRD(GL,0); GAPB(o[0]=__builtin_amdgcn_mfma_f32_32x32x16_bf16(PAF(1),VFR(1),o[0],0,0,0), C0,8); \
    KRD(GL,1); GAPB(o[1]=__builtin_amdgcn_mfma_f32_32x32x16_bf16(PAF(1),VFR(5),o[1],0,0,0), C0,12); \
    KRD(GL,2); GAPB(o[0]=__builtin_amdgcn_mfma_f32_32x32x16_bf16(PAF(2),VFR(2),o[0],0,0,0), C1,0); \
    KRD(GL,3); GAPB(o[1]=__builtin_amdgcn_mfma_f32_32x32x16_bf16(PAF(2),VFR(6),o[1],0,0,0), C1,4); \
    GAPB(o[0]=__builtin_amdgcn_mfma_f32_32x32x16_bf16(PAF(3),VFR(3),o[0],0,0,0), C1,8); \
    GAPB(o[1]=__builtin_amdgcn_mfma_f32_32x32x16_bf16(PAF(3),VFR(7),o[1],0,0,0), C1,12); \
    }while(0)
  int t=1;
  #undef CMASK
  #define CMASK(P0,P1,t) do{}while(0)
  for(;t+5<NT;t+=2){
    STEP(pB0,pB1,pA0,pA1,t,true,true,true);     WAIT_BAR(2); RESC(); ROT();
    STEP(pA0,pA1,pB0,pB1,t+1,true,true,true);   WAIT_BAR(2); RESC(); ROT();
  }
  #undef CMASK
  #define CMASK(P0,P1,t) do{ if(CAUSAL){int jb_=(t)-(NT-4); if(jb_>=0)cmask(P0,P1,jb_,qrel,hi);} }while(0)
  #define ENDW(tt) do{ if((tt)+3<NT){WAIT_BAR(2);} else if((tt)+2<NT){WAIT_BAR(1);} else {WAIT_BAR(0);} }while(0)
  for(;t+1<NT;t+=2){
    STEP(pB0,pB1,pA0,pA1,t,(t+3<NT),(t+1<NT),(t+1<NT));       ENDW(t);   RESC(); ROT();
    STEP(pA0,pA1,pB0,pB1,t+1,(t+4<NT),(t+2<NT),(t+2<NT));     ENDW(t+1); RESC(); ROT();
  }
  STEP(pB0,pB1,pA0,pA1,NT-1,false,false,false); RESC();
  { float sacc=pB0[0]+pB0[1]; _Pragma("unroll") for(int r=2;r<16;++r)sacc+=pB0[r]; _Pragma("unroll") for(int r=0;r<16;++r)sacc+=pB1[r]; l_reg+=sacc;
    pw0=(u32x4){PKW(pB0,0),PKW(pB0,2),PKW(pB0,4),PKW(pB0,6)};pw1=(u32x4){PKW(pB0,8),PKW(pB0,10),PKW(pB0,12),PKW(pB0,14)};pw2=(u32x4){PKW(pB1,0),PKW(pB1,2),PKW(pB1,4),PKW(pB1,6)};pw3=(u32x4){PKW(pB1,8),PKW(pB1,10),PKW(pB1,12),PKW(pB1,14)};
    SBAR(); pv(o,vb0+sl_cur,PAF(0),PAF(1),PAF(2),PAF(3)); }
  #undef PKW
  #undef PAF
  #undef VFR
  #undef PIN
  #undef MX3
  #undef GAPA
  #undef GAPB
  #undef EX
  #undef VRD
  #undef KRD
  #undef STEP
  #undef ENDW
  {auto rr=__builtin_amdgcn_permlane32_swap(__float_as_uint(l_reg),__float_as_uint(l_reg),false,false);l_reg=__uint_as_float(rr[0])+__uint_as_float(rr[1]);}
  if(hi==0)wsf[32+r32]=l_reg;asm volatile("s_waitcnt lgkmcnt(0)":::"memory");
  float rli[16];
  #pragma unroll
  for(int r=0;r<16;++r)rli[r]=__builtin_amdgcn_rcpf(wsf[32+crow(r,hi)]);
  bf16*Ow=Ou+(long)(wid*QBLK)*LDO;
  { bf16*stg=(bf16*)(shm+LDS_OST)+wid*2048;
    unsigned sbase=lds0+LDS_OST+(unsigned)wid*4096u+(unsigned)hi*512u+(unsigned)r32*2u; asm volatile("":"+v"(sbase));
    typedef __attribute__((address_space(3))) bf16* lds_hptr;
    #pragma unroll
    for(int r=0;r<16;++r){
      #pragma unroll
      for(int d0=0;d0<2;++d0)*(lds_hptr)(sbase+(unsigned)(((r&3)+8*(r>>2))*128+d0*64))=(bf16)(cvtpk_s(o[d0][r]*rli[r],0.f)&0xffffu);}
    asm volatile("s_waitcnt lgkmcnt(0)":::"memory");
    #pragma unroll
    for(int i=0;i<4;++i){const int row=i*8+(lane>>3),ch=lane&7; const u32x4 v=*(const u32x4*)(stg+row*64+ch*8); ATTN_STORE16(Ow+(long)row*LDO+ch*8,v);} }
  asm volatile("s_waitcnt lgkmcnt(0)\n\ts_barrier":::"memory");
  #undef DMA_K
  #undef DMA_V
  #undef CMASK
  #undef START
  #undef RESC
  #undef ROT
}

constexpr int V2_KS=8192, V2_VS=16384, V2_VOFF=3*V2_KS, V2_WS=V2_VOFF+4*V2_VS, V2_OST=V2_WS+NW*64*4, V2_BYTES=V2_OST+NW*8192;
template<int THRL,int LDQ,int LDK,int LDV,int LDO,bool CAUSAL,int MODE=0> __device__ __forceinline__ void attn_unit_v128(const bf16*Qu,const bf16*__restrict__ Kh,const bf16*__restrict__ Vh,bf16*Ou,const int qb,char*shm,const int nt_probe=0,const float lam=0.f,const float*gsub=nullptr,const int pmode=0){
  const int tid=threadIdx.x,lane=tid&63,r32=lane&31,hi=lane>>5; const int wid=__builtin_amdgcn_readfirstlane(tid>>6);
  const int NT=nt_probe?nt_probe:(CAUSAL?(qb*QB+QB)/KVBLK:4);
  const bool late=wid>=4&&pmode==4;
  const bf16*Qw=Qu+(long)(wid*QBLK)*LDQ;
  const unsigned lds0=(unsigned)(uintptr_t)shm;
  float*wsf=(float*)(shm+V2_WS)+wid*64;
  const bf16*ksrc=Kh+(long)lane*LDK+wid*8;
  const bf16*vsrc=Vh+(long)(16*(wid&3)+(lane>>2))*LDV+(wid>>2)*32+(lane&3)*8;
  const unsigned pdst=lds0+wid*1024;
  #define DMA3(t,ksl,vsl) do{ const unsigned dk_=(unsigned)__builtin_amdgcn_readfirstlane(pdst+(ksl)*V2_KS), dv_=(unsigned)__builtin_amdgcn_readfirstlane(pdst+V2_VOFF+(vsl)*V2_VS); \
      glds16(ksrc+(long)(t)*KVBLK*LDK,dk_); glds16(vsrc+(long)(t)*KVBLK*LDV,dv_); glds16(vsrc+64+(long)(t)*KVBLK*LDV,dv_+8192u); }while(0)
  bf16x8 qr[4];
  #pragma unroll
  for(int d0=0;d0<4;++d0)qr[d0]=*reinterpret_cast<const bf16x8*>(&Qw[(long)r32*LDQ+d0*16+hi*8]);
  DMA3(0,0,0); DMA3(1,1,1);
  const int vbl=(int)(lds0+V2_VOFF)+((lane>>4)&1)*32+(lane&3)*8+(4*hi+((lane&15)>>2))*64;
  float mhat=0.f,l_reg=0.f; f32x16 o[4]; o[0]=f32x16{};o[1]=f32x16{};o[2]=f32x16{};o[3]=f32x16{};
  f32x16 negm=f32x16{};
  const int qrel=wid*QBLK+r32;
  s16x4 vlA[4],vhA[4],vlB[4],vhB[4];
  #define VREADS(LO,HI,b) do{ _Pragma("unroll") for(int ks=0;ks<4;++ks){ \
      asm volatile("ds_read_b64_tr_b16 %0,%1 offset:%c2":"=&v"(LO[ks]):"v"(vb_),"i"((b)*4096+ks*1024):"memory"); \
      asm volatile("ds_read_b64_tr_b16 %0,%1 offset:%c2":"=&v"(HI[ks]):"v"(vb_),"i"((b)*4096+ks*1024+512):"memory");} }while(0)
  #define VPK(LO,HI,k) (bf16x8){LO[k][0],LO[k][1],LO[k][2],LO[k][3],HI[k][0],HI[k][1],HI[k][2],HI[k][3]}
  #define PVBLK(O,LO,HI,P0,P1,P2,P3) do{ O=__builtin_amdgcn_mfma_f32_32x32x16_bf16(__builtin_bit_cast(bf16x8,P0),VPK(LO,HI,0),O,0,0,0); O=__builtin_amdgcn_mfma_f32_32x32x16_bf16(__builtin_bit_cast(bf16x8,P1),VPK(LO,HI,1),O,0,0,0); \
      O=__builtin_amdgcn_mfma_f32_32x32x16_bf16(__builtin_bit_cast(bf16x8,P2),VPK(LO,HI,2),O,0,0,0); O=__builtin_amdgcn_mfma_f32_32x32x16_bf16(__builtin_bit_cast(bf16x8,P3),VPK(LO,HI,3),O,0,0,0); }while(0)
  #define PV_ALL(VB,P0,P1,P2,P3) do{ const int vb_=(VB); SBAR(); VREADS(vlA,vhA,0); VREADS(vlB,vhB,1); asm volatile("s_waitcnt lgkmcnt(8)":::"memory"); SBAR(); PVBLK(o[0],vlA,vhA,P0,P1,P2,P3); \
      SBAR(); VREADS(vlA,vhA,2); asm volatile("s_waitcnt lgkmcnt(8)":::"memory"); SBAR(); PVBLK(o[1],vlB,vhB,P0,P1,P2,P3); \
      SBAR(); VREADS(vlB,vhB,3); asm volatile("s_waitcnt lgkmcnt(8)":::"memory"); SBAR(); PVBLK(o[2],vlA,vhA,P0,P1,P2,P3); \
      asm volatile("s_waitcnt lgkmcnt(0)":::"memory"); SBAR(); PVBLK(o[3],vlB,vhB,P0,P1,P2,P3); SBAR(); }while(0)
  u32x4 q0=(u32x4){0u,0u,0u,0u},q1=q0,q2=q0,q3=q0; int vbP=0; bool pend=false;
  int ks=0,vs=0;
  for(int t=0;t<NT;++t){
    if(t+1<NT){WAIT_BAR(3);}else{WAIT_BAR(0);}
    if(t+2<NT&&pmode!=1){ DMA3(t+2,(ks==0)?2:ks-1,(vs+2)&3); }
    if(late&&pend){ PV_ALL(vbP,q0,q1,q2,q3); pend=false; }
    const int jb=t-(NT-4);
    const bool active=(!CAUSAL||jb<=0||64*jb<=32*wid+31)&&pmode!=2;
    if(active){
      f32x16 C0,C1;
      {
        const char*kb=shm+ks*V2_KS+hi*1024+r32*16; bf16x8 kf[8];
        #pragma unroll
        for(int d0=0;d0<4;++d0){kf[2*d0]=*reinterpret_cast<const bf16x8*>(kb+d0*2048);kf[2*d0+1]=*reinterpret_cast<const bf16x8*>(kb+d0*2048+512);}
        SBAR();
        C0=__builtin_amdgcn_mfma_f32_32x32x16_bf16(kf[0],qr[0],negm,0,0,0);C1=__builtin_amdgcn_mfma_f32_32x32x16_bf16(kf[1],qr[0],negm,0,0,0);
        #pragma unroll
        for(int d0=1;d0<4;++d0){C0=__builtin_amdgcn_mfma_f32_32x32x16_bf16(kf[2*d0],qr[d0],C0,0,0,0);C1=__builtin_amdgcn_mfma_f32_32x32x16_bf16(kf[2*d0+1],qr[d0],C1,0,0,0);}
        SBAR(); }
      if(CAUSAL&&jb>=0)cmask(C0,C1,jb,qrel,hi);
      float a=__builtin_fmaxf(__builtin_fmaxf(C0[0],C0[1]),C1[0]),b=__builtin_fmaxf(__builtin_fmaxf(C0[2],C0[3]),C1[1]); a=__builtin_fmaxf(__builtin_fmaxf(a,C1[2]),C1[3]);
      #pragma unroll
      for(int r=4;r<16;r+=4){a=__builtin_fmaxf(__builtin_fmaxf(a,C0[r]),C0[r+1]);b=__builtin_fmaxf(__builtin_fmaxf(b,C0[r+2]),C0[r+3]);a=__builtin_fmaxf(__builtin_fmaxf(a,C1[r]),C1[r+1]);b=__builtin_fmaxf(__builtin_fmaxf(b,C1[r+2]),C1[r+3]);}
      float rm=__builtin_fmaxf(a,b); { auto rr=__builtin_amdgcn_permlane32_swap(__float_as_uint(rm),__float_as_uint(rm),false,false); rm=__builtin_fmaxf(__uint_as_float(rr[0]),__uint_as_float(rr[1])); }
      bool resc=false;
      if(t==0){ mhat+=rm; _Pragma("unroll") for(int r=0;r<16;++r){C0[r]-=rm;C1[r]-=rm;negm[r]=-mhat;} }
      else if(__builtin_expect(__any(rm>(float)THRL),0)){ const float dl=__builtin_fmaxf(rm,0.f); mhat+=dl;
        _Pragma("unroll") for(int r=0;r<16;++r){C0[r]-=dl;C1[r]-=dl;negm[r]=-mhat;}
        const float f=__builtin_amdgcn_exp2f(-dl); l_reg*=f; if(hi==0)wsf[r32]=f; resc=true; }
      #pragma unroll
      for(int r=0;r<16;++r){C0[r]=__builtin_amdgcn_exp2f(C0[r]);C1[r]=__builtin_amdgcn_exp2f(C1[r]);}
      float sacc=0.f;
      #pragma unroll
      for(int r=0;r<16;++r)sacc+=C0[r]+C1[r];
      l_reg+=sacc;
      u32x4 pw0,pw1,pw2,pw3;
      pw0=(u32x4){cvtpk_s(C0[0],C0[1]),cvtpk_s(C0[2],C0[3]),cvtpk_s(C0[4],C0[5]),cvtpk_s(C0[6],C0[7])}; pw1=(u32x4){cvtpk_s(C0[8],C0[9]),cvtpk_s(C0[10],C0[11]),cvtpk_s(C0[12],C0[13]),cvtpk_s(C0[14],C0[15])};
      pw2=(u32x4){cvtpk_s(C1[0],C1[1]),cvtpk_s(C1[2],C1[3]),cvtpk_s(C1[4],C1[5]),cvtpk_s(C1[6],C1[7])}; pw3=(u32x4){cvtpk_s(C1[8],C1[9]),cvtpk_s(C1[10],C1[11]),cvtpk_s(C1[12],C1[13]),cvtpk_s(C1[14],C1[15])};
      if(resc){ asm volatile("s_waitcnt lgkmcnt(0)":::"memory");
        #pragma unroll
        for(int d_=0;d_<4;++d_)
          #pragma unroll
          for(int r=0;r<16;++r)o[d_][r]*=wsf[crow(r,hi)]; }
      const int vbc=vbl+vs*V2_VS;
      if(late){ q0=pw0;q1=pw1;q2=pw2;q3=pw3; vbP=vbc; pend=true; }
      else { PV_ALL(vbc,pw0,pw1,pw2,pw3); }
    }
    ks=(ks==2)?0:ks+1; vs=(vs+1)&3;
  }
  if(late&&pend){ PV_ALL(vbP,q0,q1,q2,q3); }
  {auto rr=__builtin_amdgcn_permlane32_swap(__float_as_uint(l_reg),__float_as_uint(l_reg),false,false);l_reg=__uint_as_float(rr[0])+__uint_as_float(rr[1]);}
  if(hi==0)wsf[32+r32]=l_reg;asm volatile("s_waitcnt lgkmcnt(0)":::"memory");
  float rli[16];
  #pragma unroll
  for(int r=0;r<16;++r)rli[r]=__builtin_amdgcn_rcpf(wsf[32+crow(r,hi)]);
  bf16*Ow=Ou+(long)(wid*QBLK)*LDO;
  { unsigned sbase=lds0+V2_OST+(unsigned)wid*8192u+(unsigned)hi*1024u+(unsigned)r32*2u; asm volatile("":"+v"(sbase));
    typedef __attribute__((address_space(3))) bf16* lds_hptr;
    #pragma unroll
    for(int r=0;r<16;++r){
      #pragma unroll
      for(int d0=0;d0<4;++d0){ const lds_hptr ap=(lds_hptr)(sbase+(unsigned)(((r&3)+8*(r>>2))*256+d0*64)); float v=o[d0][r]*rli[r];
        if(MODE==2)v=__uint_as_float(((unsigned)*ap)<<16)-lam*v;
        *ap=(bf16)(cvtpk_s(v,0.f)&0xffffu);} }
    asm volatile("s_waitcnt lgkmcnt(0)":::"memory");
    const bf16*stg=(const bf16*)(shm+V2_OST)+wid*4096;
    if(MODE==0){
      #pragma unroll
      for(int i=0;i<8;++i){const int row=i*4+(lane>>4),ch=lane&15; const u32x4 v=*(const u32x4*)(stg+row*128+ch*8); ATTN_STORE16(Ow+(long)row*LDO+ch*8,v);} }
    if(MODE==2){
      const int ch=lane&15; const f32x4_t g0=*(const f32x4_t*)(gsub+ch*8),g1=*(const f32x4_t*)(gsub+ch*8+4);
      #pragma unroll
      for(int i=0;i<8;++i){const int row=i*4+(lane>>4); const u32x4 v=*(const u32x4*)(stg+row*128+ch*8);
        float a[8];
        #pragma unroll
        for(int j=0;j<4;++j){a[2*j]=__uint_as_float(v[j]<<16);a[2*j+1]=__uint_as_float(v[j]&0xffff0000u);}
        float ss=0.f;
        #pragma unroll
        for(int j=0;j<8;++j)ss+=a[j]*a[j];
        ss+=__shfl_xor(ss,1);ss+=__shfl_xor(ss,2);ss+=__shfl_xor(ss,4);ss+=__shfl_xor(ss,8);
        const float rstd=0.8f*__builtin_amdgcn_rsqf(ss*(1.f/128)+1e-6f);
        u32x4 w; w[0]=cvtpk_s(a[0]*rstd*g0[0],a[1]*rstd*g0[1]); w[1]=cvtpk_s(a[2]*rstd*g0[2],a[3]*rstd*g0[3]); w[2]=cvtpk_s(a[4]*rstd*g1[0],a[5]*rstd*g1[1]); w[3]=cvtpk_s(a[6]*rstd*g1[2],a[7]*rstd*g1[3]);
        ATTN_STORE16(Ow+(long)row*LDO+ch*8,w);} } }
  asm volatile("s_waitcnt lgkmcnt(0)\n\ts_barrier":::"memory");
  #undef DMA3
  #undef VREADS
  #undef VPK
  #undef PVBLK
  #undef PV_ALL
}
constexpr int ATTN_LDS_BYTES=LDS_BYTES;
#undef SBAR
#undef WAIT_BAR
}

#define GAS __attribute__((address_space(1)))
#define XB_TMO      128
#define XB_XCNT(j)  (256  + 64 * (j))
#define XB_XSUB(j)  (1280 + 64 * (j))
#define XB_XGEN(j)  (2304 + 64 * (j))
#define XB_TOP      3328
#define XB_TOPGEN   3392
#define XCD_BAR_WORDS 3456
#define XB_SPIN_CAP (1u << 18)

__device__ __forceinline__ unsigned xb_ld(unsigned* p)              { return __hip_atomic_load(p, __ATOMIC_RELAXED, __HIP_MEMORY_SCOPE_AGENT); }
__device__ __forceinline__ unsigned xb_add(unsigned* p, unsigned v) { return __hip_atomic_fetch_add(p, v, __ATOMIC_RELAXED, __HIP_MEMORY_SCOPE_AGENT); }
__device__ __forceinline__ unsigned xb_xcc_id() { return (unsigned)__builtin_amdgcn_s_getreg((3 << 11) | 20) & 0xFu; }
#define XB_SPIN(cond, bar) do { unsigned _sp = 0; while (cond) { __builtin_amdgcn_s_sleep(1); \
    if ((++_sp & 255u) == 0u) { if (xb_ld(&(bar)[XB_TMO])) break; if (_sp > XB_SPIN_CAP) { atomicAdd(&(bar)[XB_TMO], 1u); break; } } } } while (0)

struct XcdBarrier {
    unsigned* bar; unsigned x;
    volatile LAS unsigned* st;
};

__device__ __forceinline__ XcdBarrier xcd_barrier_post(unsigned* bar, volatile LAS unsigned* st) {
    XcdBarrier b; b.bar = bar; b.x = xb_xcc_id(); b.st = st;
    if (threadIdx.x == 0) (void)xb_add(&bar[XB_XCNT(b.x)], 1u);
    return b;
}
__device__ __forceinline__ void xcd_barrier_complete(unsigned* bar, unsigned x, unsigned& nloc, unsigned& nx) {
    const unsigned G = gridDim.x * gridDim.y * gridDim.z;
    unsigned sum, cnt, mine, sp = 0u;
    for (;;) {
        sum = 0u; cnt = 0u; mine = 0u;
#pragma unroll
        for (unsigned j = 0; j < 16; ++j) { const unsigned c = xb_ld(&bar[XB_XCNT(j)]); sum += c; cnt += (c > 0u) ? 1u : 0u; mine = (j == x) ? c : mine; }
        if (sum == G) break;
        __builtin_amdgcn_s_sleep(1);
        if ((++sp & 255u) == 0u) { if (xb_ld(&bar[XB_TMO])) break; if (sp > XB_SPIN_CAP) { atomicAdd(&bar[XB_TMO], 1u); break; } }
    }
    nloc = mine > 0u ? mine : 1u; nx = cnt > 0u ? cnt : 1u;
}

__device__ __forceinline__ void xcd_barrier(const XcdBarrier& b) {
    asm volatile("s_waitcnt vmcnt(0)" ::: "memory");
    __syncthreads();
    if (threadIdx.x == 0) {
        unsigned* bar = b.bar;
        __builtin_amdgcn_s_waitcnt(0);
        unsigned nloc = b.st[0], nx = b.st[1];
        if (nloc == 0u) { xcd_barrier_complete(bar, b.x, nloc, nx); b.st[0] = nloc; b.st[1] = nx; }
        const unsigned old = xb_add(&bar[XB_XSUB(b.x)], 1u);
        const unsigned gen = old / nloc;
        if (old + 1u == (gen + 1u) * nloc) {
            __builtin_amdgcn_fence(__ATOMIC_RELEASE, "agent");
            asm volatile("s_waitcnt vmcnt(0)" ::: "memory");
            const unsigned og = xb_add(&bar[XB_TOP], 1u);
            const unsigned tg = og / nx;
            if (og + 1u == (tg + 1u) * nx) xb_add(&bar[XB_TOPGEN], 1u);
            else XB_SPIN(xb_ld(&bar[XB_TOPGEN]) == tg, bar);
            __builtin_amdgcn_fence(__ATOMIC_ACQUIRE, "agent");
            xb_add(&bar[XB_XGEN(b.x)], 1u);
            asm volatile("s_waitcnt vmcnt(0)" ::: "memory");
        } else {
            XB_SPIN(xb_ld(&bar[XB_XGEN(b.x)]) == gen, bar);
            __builtin_amdgcn_fence(__ATOMIC_ACQUIRE, "agent");
            asm volatile("s_waitcnt vmcnt(0)" ::: "memory");
        }
    }
    __syncthreads();
}


__global__ void __launch_bounds__(NTHREADS, 2) mk_fwd(Args args) {
    extern __shared__ __attribute__((aligned(16))) unsigned char lds_raw[];
    LAS unsigned char* lds = (LAS unsigned char*)lds_raw;
    const int tid = threadIdx.x, lane = tid & 63, wave = __builtin_amdgcn_readfirstlane(tid >> 6);
    const int G = gridDim.x, bid = blockIdx.x;
    const int gw = bid * NWAVES + wave, NGW = G * NWAVES;
#define DECL_ALL \
    unsigned char* ws = args.ws; \
    const float* x = (const float*)args.in[0]; const float* mem = (const float*)args.in[1]; const int* positions = (const int*)args.in[2]; \
    const float* g_mix = (const float*)args.in[3]; const float* w_in = (const float*)args.in[4]; \
    const float* g_dq = (const float*)args.in[5]; const float* g_dk = (const float*)args.in[6]; \
    const float* lq1 = (const float*)args.in[7]; const float* lk1 = (const float*)args.in[8]; const float* lq2 = (const float*)args.in[9]; const float* lk2 = (const float*)args.in[10]; \
    const float* g_sub = (const float*)args.in[11]; const float* g_sgu = (const float*)args.in[12]; \
    const float* w_sp = (const float*)args.in[13]; const float* b_sp = (const float*)args.in[14]; \
    const float* g_memn = (const float*)args.in[15]; const float* w_kv = (const float*)args.in[16]; \
    const float* g_cq = (const float*)args.in[17]; const float* g_ck = (const float*)args.in[18]; \
    const float* w_out = (const float*)args.in[19]; const float* g_ffn = (const float*)args.in[20]; \
    const float* w_router = (const float*)args.in[21]; const float* b_router = (const float*)args.in[22]; \
    const float* w_mlp1 = (const float*)args.in[23]; const float* b_mlp1 = (const float*)args.in[24]; \
    const float* w_mlp2 = (const float*)args.in[25]; const float* b_mlp2 = (const float*)args.in[26]; \
    float* out = args.out; \
    unsigned* ctl = (unsigned*)(ws + WS_CTL); \
    bf16_t* WIN_T = (bf16_t*)(ws + WS_WIN); bf16_t* WO_T = (bf16_t*)(ws + WS_WO); bf16_t* WKV_T = (bf16_t*)(ws + WS_WKV); \
    float* CS = (float*)(ws + WS_CS); int* LIST = (int*)(ws + WS_LIST); float* GLIST = (float*)(ws + WS_GLIST); float* RS = (float*)(ws + WS_RS); (void)RS; \
    bf16_t* MEMN = (bf16_t*)(ws + WS_MEMN); bf16_t* MEMK = (bf16_t*)(ws + WS_MEMK); bf16_t* MEMV = (bf16_t*)(ws + WS_MEMV); \
    bf16_t* W1T = (bf16_t*)(ws + WS_W1); bf16_t* W2T = (bf16_t*)(ws + WS_W2); bf16_t* H2 = (bf16_t*)(ws + WS_H2); bf16_t* ACT = (bf16_t*)(ws + WS_ACT); \
    bf16_t* XN = (bf16_t*)(ws + WS_XN); bf16_t* QB = (bf16_t*)(ws + WS_QB); bf16_t* KB = (bf16_t*)(ws + WS_KB); bf16_t* VB = (bf16_t*)(ws + WS_VB); \
    bf16_t* UB = (bf16_t*)(ws + WS_UB); bf16_t* VGB = (bf16_t*)(ws + WS_VGB); bf16_t* MQB = (bf16_t*)(ws + WS_MQB); \
    bf16_t* CAT = (bf16_t*)(ws + WS_CAT); bf16_t* X1B = (bf16_t*)(ws + WS_X1B); (void)X1B; bf16_t* YB = (bf16_t*)(ws + WS_YB); bf16_t* OT = (bf16_t*)(ws + WS_OT); (void)OT; \
    float* PROJ = (float*)(ws + WS_PROJ); float* KVT = (float*)(ws + WS_KVT); \
    (void)x; (void)mem; (void)positions; (void)g_mix; (void)w_in; (void)g_dq; (void)g_dk; (void)lq1; (void)lk1; (void)lq2; (void)lk2; (void)g_sub; (void)g_sgu; (void)w_sp; (void)b_sp; \
    (void)g_memn; (void)w_kv; (void)g_cq; (void)g_ck; (void)w_out; (void)g_ffn; (void)w_router; (void)b_router; (void)w_mlp1; (void)b_mlp1; (void)w_mlp2; (void)b_mlp2; (void)out; (void)ctl; \
    (void)WIN_T; (void)WO_T; (void)WKV_T; (void)CS; (void)LIST; (void)GLIST; (void)MEMN; (void)MEMK; (void)MEMV; (void)W1T; (void)W2T; (void)H2; (void)ACT; (void)XN; (void)QB; (void)KB; (void)VB; \
    (void)UB; (void)VGB; (void)MQB; (void)CAT; (void)YB; (void)PROJ; (void)KVT;

    const int lo = args.ph_lo, hi = args.ph_hi;
#ifndef PHMASK
#define PHMASK 0x1ff
#endif
#define IN(k) (((PHMASK >> (k)) & 1) && lo <= (k) && (k) < hi)
#define BOTH(k) (IN(k) && IN((k) + 1))
    volatile LAS unsigned* misc = (volatile LAS unsigned*)(lds + LDS_BYTES - 64);
    if (tid < 2) misc[tid] = 0u;
    __syncthreads();
    XcdBarrier xbar; xbar.bar = (unsigned*)(args.ws + WS_CTL) + CW_BAR; xbar.x = 0; xbar.st = misc;
    if (hi - lo > 1) xbar = xcd_barrier_post((unsigned*)(args.ws + WS_CTL) + CW_BAR, misc);
#define GRID_BAR() xcd_barrier(xbar)
#define PHASE_STAGGER(total_units, unit_us) do { if ((G & 7) == 0) { const int per_ = G >> 3, rounds_ = ((total_units) + G - 1) / G; int nb_ = 0; \
        for (int xx_ = 0; xx_ < 8; ++xx_) nb_ += (((rounds_ - 1) * 8 + xx_) * per_ < (total_units)) ? 1 : 0; \
        const int x_ = bid & 7; if (x_ >= nb_ && rounds_ > 1) { const int idle_ = 8 - nb_, r_ = (x_ - nb_) + idle_ * (bid >> 3) + 1;     \
            const int n_ = (int)((unit_us) * 2.4f * 1000.f / 2048.f) * r_ / (idle_ * per_ + 1); \
            for (int i_ = 0; i_ < n_; ++i_) __builtin_amdgcn_s_sleep(32); } } } while (0)
#ifndef DUP_PHASE
#define DUP_PHASE (-1)
#endif
#ifndef DUP_S3
#define DUP_S3 0
#endif
#ifndef DUP_S0
#define DUP_S0 0
#endif
#ifndef PROBE_AT
#define PROBE_AT 0
#endif
#ifndef PROBE_G1
#define PROBE_G1 0
#endif
#ifndef PROBE_PHASE
#define PROBE_PHASE (-1)
#endif
#define STAMP(k) do { if (PROBE_PHASE >= 0 && bid == 0 && tid == 0) ((unsigned*)(args.ws + WS_CTL))[64 + (k)] = (unsigned)__builtin_amdgcn_s_memrealtime(); } while (0)

    if (IN(0)) {
        DECL_ALL
        STAMP(0);
        for (int rep_ = 0; rep_ < ((DUP_PHASE == 0) ? 2 : 1); ++rep_) { if (rep_) GRID_BAR();
        LAS float* scr = (LAS float*)(lds + wave * 17024);
        constexpr int I_IN = 16 * (NPROJ / 32), I_O = 16 * 32, I_KV = 16 * 16, I_1 = 8 * 64, I_2 = 8 * 32;
        constexpr int NITEMS = I_IN + I_O + I_KV + NE * I_1 + NE * I_2;
        for (int it_ = gw; it_ < NITEMS * (DUP_S0 == 1 ? 2 : 1); it_ += NGW) {
            const int it = it_ >= NITEMS ? it_ - NITEMS : it_; int r = it;
            if (r < I_IN) { transpose_item_p<true>(w_in, DM, NPROJ, WIN_T, scr, r, lane, [](int n) {
                    if (n < 1024 || n >= 2048) { const int w = n & 255, d = w & 63; return (n & ~255) + 128 * ((d >> 3) & 1) + 32 * (w >> 6) + 8 * (d >> 4) + (d & 7); } return n; }, g_mix); continue; } r -= I_IN;
            if (r < I_O) { transpose_item(w_out, DM, DM, WO_T, scr, r, lane); continue; } r -= I_O;
            if (r < I_KV) { transpose_item_p(w_kv, DM, 512, WKV_T, scr, r, lane, [](int n) {
                    if (n < 256) { const int d = n & 63; return 128 * ((d >> 3) & 1) + 32 * (n >> 6) + 8 * (d >> 4) + (d & 7); } return n; }); continue; } r -= I_KV;
            if (r < NE * I_1) { const int e = r / I_1; transpose_item_f8(w_mlp1 + (size_t)e * DM * 2048, DM, 2048, (unsigned char*)W1T + (size_t)e * 2048 * DM, scr, r % I_1, lane,
                                                                   [](int n) { const int half = n >> 10, q = n & 1023; return 256 * (q >> 7) + 128 * half + (q & 127); }); continue; } r -= NE * I_1;
            { const int e = r / I_2; transpose_item_f8(w_mlp2 + (size_t)e * DFF * DM, DFF, DM, (unsigned char*)W2T + (size_t)e * DM * DFF, scr, r % I_2, lane,
                                       [](int n) { const int w = n & 255; return (n & ~255) + 128 * ((w >> 3) & 1) + 32 * (w >> 6) + 8 * ((w >> 4) & 3) + (w & 7); }); }
        }
        for (int m_ = 2 * gw; m_ < M * (DUP_S0 == 2 ? 2 : 1); m_ += 2 * NGW) { const int m = m_ & (M - 1); row2_to_bf16_rs(x + (size_t)m * DM, x + (size_t)(m + 1) * DM, XN + (size_t)m * DM, XN + (size_t)(m + 1) * DM, (float*)(ws + WS_RSX) + m, lane); }
        for (int i = bid * NTHREADS + tid; i < MM; i += G * NTHREADS) ((float*)(ws + WS_RSX))[M + i] = 1.0f;
        for (int m = gw; m < MM; m += NGW) rms_row_to_bf16(mem + (size_t)m * DM, g_memn, MEMN + (size_t)m * DM, lane);
        for (int i = bid * NTHREADS + tid; i < M * 8; i += G * NTHREADS) {
            const int tok = i >> 3, f = i & 7;
            const float inv = exp2f(-(float)f * (0.125f * 18.931568569324174f));
            const float ang = (float)positions[tok] * inv;
            const double a = (double)ang, kk = rint(a * 0.15915494309189535);
            const float r = (float)(a - kk * 6.283185307179586);
            CS[(size_t)tok * 16 + f] = cosf(r); CS[(size_t)tok * 16 + 8 + f] = sinf(r);
        }
        if (bid == 0 && tid < 64) { ctl[tid] = 0u; float* GT = (float*)(ws + WS_CTL + 4096); GT[tid] = g_dq[tid]; GT[64 + tid] = g_dk[tid]; GT[128 + tid] = g_cq[tid]; GT[192 + tid] = g_ck[tid]; }
        }
        if (BOTH(0)) GRID_BAR();
    }

    if (IN(1)) {
        DECL_ALL
        STAMP(1);
        for (int rep_ = 0; rep_ < ((DUP_PHASE == 1) ? 2 : 1); ++rep_) { if (rep_) GRID_BAR();
        PHASE_STAGGER((M / 256) * 9 + (MM / 256) * 2, 30.f);
        pg8::InProjSched S{(const char*)XN, (const char*)MEMN, (const char*)WIN_T, G, bid};
        pg8::EpiInProj E{ws};
        pg8::gemm_phase<pg8::EpiInProj, pg8::InProjSched, false>(lds, S, E, nullptr);
        }
        if (BOTH(1)) GRID_BAR();
    }

    if (IN(2)) {
        DECL_ALL
        STAMP(2);
    }

    if (IN(3)) {
        DECL_ALL
        STAMP(3);
        for (int rep_ = 0; rep_ < ((DUP_PHASE == 3) ? 2 : 1); ++rep_) { if (rep_) GRID_BAR();
        const int vcu = (G % 8 == 0) ? (bid % 8) * (G / 8) + bid / 8 : bid;
        float lam;
        { int ln = lane; asm volatile("" : "+v"(ln));
          const float l0 = __expf(wave_sum(lq1[ln] * lk1[ln])) - __expf(wave_sum(lq2[ln] * lk2[ln])) + 0.2f; lam = __uint_as_float(__builtin_amdgcn_readfirstlane(__float_as_uint(l0))); }
        for (int pair_ = vcu; pair_ < BATCH * 4 * 4 * (DUP_S3 == 1 ? 2 : 1); pair_ += G) {
            const int pair = pair_ & 255; const int bh = pair >> 2, s4 = pair & 3, b = bh >> 2, h = bh & 3; const size_t rb = (size_t)b * SEQ;
            for (int u = 0; u < 2; ++u) {
                const int qb = u ? 7 - s4 : s4;
                attn_body::attn_unit_v128<8, 512, 512, 512, 1024, true, 1>(QB + (rb + qb * 256) * 512 + (h * 2 + 0) * 64, KB + rb * 512 + (h * 2 + 0) * 64, VB + rb * 512 + h * 128,
                                                                           OT, qb, (char*)lds_raw);
                attn_body::attn_unit_v128<8, 512, 512, 512, 1024, true, 2>(QB + (rb + qb * 256) * 512 + (h * 2 + 1) * 64, KB + rb * 512 + (h * 2 + 1) * 64, VB + rb * 512 + h * 128,
                                                                           CAT + (rb + qb * 256) * 1024 + h * 128, qb, (char*)lds_raw, 0, lam, g_sub);
            }
        }
        if (PROBE_AT) {
            for (int pair = vcu; pair < BATCH * 4 * 4; pair += G) {
                const int bh = pair >> 2, s4 = pair & 3, b = bh >> 2, h = bh & 3; const size_t rb = (size_t)b * SEQ;
                for (int u = 0; u < 4; ++u) {
                    const int qb = (u & 2) ? 7 - s4 : s4, c = u & 1;
                    attn_body::attn_unit_v128<8, 512, 512, 512, 1024, false>(QB + (rb + qb * 256) * 512 + (h * 2 + c) * 64, KB + rb * 512 + (h * 2 + c) * 64, VB + rb * 512 + h * 128,
                                                                             ACT + (rb + qb * 256) * 1024 + h * 256 + c * 128, qb, (char*)lds_raw, PROBE_AT & 63, 0.f, nullptr, PROBE_AT >> 6);
                }
            }
        }
        for (int j_ = vcu; j_ < BATCH * 4 * 8 * (DUP_S3 == 2 ? 2 : 1); j_ += G) {
            const int j = j_ & 511; const int bh = j >> 3, qb = j & 7, b = bh >> 2, h = bh & 3; const size_t rb = (size_t)b * SEQ;
            attn_body::attn_unit<8, 256, 256, 256, 1024, false>(MQB + (rb + qb * 256) * 256 + h * 64, MEMK + (size_t)b * MEML * 256 + h * 64, MEMV + (size_t)b * MEML * 256 + h * 64,
                                                                CAT + (rb + qb * 256) * 1024 + 768 + h * 64, MEML / 64, (char*)lds_raw);
        }
        __syncthreads();
        {
        LAS bf16_t* vnT = (LAS bf16_t*)lds;
        int ln = lane; asm volatile("" : "+v"(ln));
        const int fr = ln & 15, fq = ln >> 4, g = wave >> 1, th = wave & 1;
        for (int it_ = bid; it_ < BATCH * 16 * (DUP_S3 == 3 ? 2 : 1); it_ += G) {
            const int it = it_ & 255; const size_t r0 = (size_t)it * 128;
            const f32x4 gg = *(const f32x4*)(g_sgu + 4 * ln);
            for (int r4 = 0; r4 < 16; r4 += 4) {
                u32x2 w[4]; float v[4][4], mean[4], rstd[4];
#pragma unroll
                for (int q = 0; q < 4; ++q) w[q] = *(const u32x2*)(VGB + (r0 + wave + 8 * (r4 + q)) * 256 + 4 * ln);
#pragma unroll
                for (int q = 0; q < 4; ++q) { v[q][0] = bf2f(w[q].x & 0xffffu); v[q][1] = bf2f(w[q].x >> 16); v[q][2] = bf2f(w[q].y & 0xffffu); v[q][3] = bf2f(w[q].y >> 16); mean[q] = (v[q][0] + v[q][1]) + (v[q][2] + v[q][3]); }
#pragma unroll
                for (int o = 1; o < 64; o <<= 1)
#pragma unroll
                    for (int q = 0; q < 4; ++q) mean[q] += __shfl_xor(mean[q], o);
#pragma unroll
                for (int q = 0; q < 4; ++q) { mean[q] *= (1.f / 256);
#pragma unroll
                    for (int i = 0; i < 4; ++i) v[q][i] -= mean[q];
                    rstd[q] = (v[q][0] * v[q][0] + v[q][1] * v[q][1]) + (v[q][2] * v[q][2] + v[q][3] * v[q][3]); }
#pragma unroll
                for (int o = 1; o < 64; o <<= 1)
#pragma unroll
                    for (int q = 0; q < 4; ++q) rstd[q] += __shfl_xor(rstd[q], o);
#pragma unroll
                for (int q = 0; q < 4; ++q) { const float rs = 1.0f / sqrtf(rstd[q] * (1.f / 256) + EPS); const int rr = wave + 8 * (r4 + q);
                    LAS bf16_t* o = vnT + (4 * ln) * 136 + rr;
                    o[0] = (bf16_t)f2bf(v[q][0] * rs * gg.x); o[136] = (bf16_t)f2bf(v[q][1] * rs * gg.y); o[272] = (bf16_t)f2bf(v[q][2] * rs * gg.z); o[408] = (bf16_t)f2bf(v[q][3] * rs * gg.w); }
            }
            __syncthreads();
            f32x4 acc[4][4];
#pragma unroll
            for (int m = 0; m < 4; ++m)
#pragma unroll
                for (int n = 0; n < 4; ++n) acc[m][n] = (f32x4){0.f, 0.f, 0.f, 0.f};
            const int nks = th ? 4 : 2;
            for (int ks = 0; ks < nks; ++ks) {
                bf16x8 af[4], bfr[4];
#pragma unroll
                for (int m = 0; m < 4; ++m) af[m] = *(const LAS bf16x8*)(vnT + (g * 64 + 16 * m + fr) * 136 + 32 * ks + 8 * fq);
#pragma unroll
                for (int n = 0; n < 4; ++n) {
                    const int t = th * 64 + 16 * n + fr, s0 = 32 * ks + 8 * fq;
                    const float* wp = w_sp + ((size_t)g * 128 + t) * 128 + s0;
                    const f32x4 wa = *(const f32x4*)wp, wb = *(const f32x4*)(wp + 4);
                    u32x4 pk; pk.x = pk2(s0 + 0 <= t ? wa[0] : 0.f, s0 + 1 <= t ? wa[1] : 0.f); pk.y = pk2(s0 + 2 <= t ? wa[2] : 0.f, s0 + 3 <= t ? wa[3] : 0.f);
                    pk.z = pk2(s0 + 4 <= t ? wb[0] : 0.f, s0 + 5 <= t ? wb[1] : 0.f); pk.w = pk2(s0 + 6 <= t ? wb[2] : 0.f, s0 + 7 <= t ? wb[3] : 0.f);
                    bfr[n] = __builtin_bit_cast(bf16x8, pk);
                }
#pragma unroll
                for (int m = 0; m < 4; ++m)
#pragma unroll
                    for (int n = 0; n < 4; ++n) acc[m][n] = __builtin_amdgcn_mfma_f32_16x16x32_bf16(af[m], bfr[n], acc[m][n], 0, 0, 0);
            }
#pragma unroll
            for (int n = 0; n < 4; ++n) {
                const int t = th * 64 + 16 * n + fr; const float bt = b_sp[g * 128 + t];
#pragma unroll
                for (int m = 0; m < 4; ++m) {
                    const int ch = g * 64 + 16 * m + 4 * fq;
                    const u32x2 uw = *(const u32x2*)(UB + (r0 + t) * 256 + ch);
                    u32x2 ow; ow.x = pk2(bf2f(uw.x & 0xffffu) * (acc[m][n][0] + bt), bf2f(uw.x >> 16) * (acc[m][n][1] + bt)); ow.y = pk2(bf2f(uw.y & 0xffffu) * (acc[m][n][2] + bt), bf2f(uw.y >> 16) * (acc[m][n][3] + bt));
                    *(u32x2*)(CAT + (r0 + t) * 1024 + 512 + ch) = ow;
                }
            }
            __syncthreads();
        }
        }
        }
        if (BOTH(3)) GRID_BAR();
    }

#define ROUTER_TABLE_FILL() do { LAS unsigned short* th_ = (LAS unsigned short*)lds; LAS unsigned short* tl_ = th_ + 32768; f32x4 wv[16]; float gk[16]; \
        ((LAS float*)(lds + 142 * 1024))[tid] = g_ffn[tid]; ((LAS float*)(lds + 142 * 1024))[tid + NTHREADS] = g_ffn[tid + NTHREADS];     \
        _Pragma("unroll") for (int i = 0; i < 16; ++i) { const int f = tid + NTHREADS * i; wv[i] = *(const f32x4*)(w_router + 4 * f); gk[i] = g_ffn[f >> 3]; } \
        _Pragma("unroll") for (int i = 0; i < 16; ++i) { const int f = tid + NTHREADS * i, k = f >> 3, e0 = 4 * (f & 7); const int o = ((k >> 3) * 32 + e0) * 8 + (k & 7); \
            _Pragma("unroll") for (int q = 0; q < 4; ++q) { const float v = wv[i][q] * gk[i]; const unsigned h = pk2(v, 0.f) & 0xffffu; const float r = v - bf2f(h); \
                th_[o + 8 * q] = (unsigned short)h; tl_[o + 8 * q] = (unsigned short)(pk2(r, 0.f) & 0xffffu); } } } while (0)

    if (IN(4)) {
        DECL_ALL
        STAMP(4);
        for (int rep_ = 0; rep_ < ((DUP_PHASE == 4) ? 2 : 1); ++rep_) { if (rep_) GRID_BAR();
        pg8::DenseSched S{(const char*)CAT, (const char*)WO_T, DM / 256, (M / 256) * (DM / 256), G, bid};
        pg8::EpiResidual E{(bf16_t*)(ws + WS_M1B)};
        pg8::gemm_phase<pg8::EpiResidual, pg8::DenseSched, false>(lds, S, E, nullptr);
        }
        if (IN(5)) { ROUTER_TABLE_FILL(); }
        if (BOTH(4)) GRID_BAR();
    }

    if (IN(5)) {
        DECL_ALL
        STAMP(5);
        if (!IN(4)) { ROUTER_TABLE_FILL(); }
        LAS unsigned* lcnt = (LAS unsigned*)(lds + 141 * 1024); LAS unsigned* lbase = lcnt + 32;
        const int i16 = lane & 15, kq = lane >> 4;
        const float be0 = b_router[i16], be1 = b_router[16 + i16];
        for (int tile = bid; tile < M / 128; tile += G) {
            if (tid < 32) lcnt[tid] = 0u;
            __syncthreads();
            const int tok0 = tile * 128 + wave * 16;
            const size_t rowoff = (size_t)(tok0 + i16) * DM + 8 * kq;
            const bf16_t* mp = (const bf16_t*)(ws + WS_M1B) + rowoff; const bf16_t* xp = XN + rowoff; bf16_t* x1p = X1B + rowoff; unsigned char* h2p = (unsigned char*)H2 + rowoff;
            const LAS unsigned char* wp = (const LAS unsigned char*)lds + (kq * 32 + i16) * 16;
            const LAS float* gtab = (const LAS float*)(lds + 142 * 1024) + 8 * kq;
            f32x4 acc0 = (f32x4){0.f, 0.f, 0.f, 0.f}, acc1 = (f32x4){0.f, 0.f, 0.f, 0.f}; float ss = 0.f;
            u32x4 mb[2][8], xb[2][8];
#define S5_LOAD(b_) do { _Pragma("unroll") for (int jj = 0; jj < 8; ++jj) { mb[(b_) & 1][jj] = *(const u32x4*)(mp + 32 * (8 * (b_) + jj)); xb[(b_) & 1][jj] = *(const u32x4*)(xp + 32 * (8 * (b_) + jj)); } } while (0)
            S5_LOAD(0);
#pragma unroll
            for (int b = 0; b < 4; ++b) {
                if (b + 1 < 4) S5_LOAD(b + 1);
#pragma unroll
                for (int jj = 0; jj < 8; ++jj) { const int j = 8 * b + jj;
                    const u32x4 mw = mb[b & 1][jj], xw0 = xb[b & 1][jj]; u32x4 xw; float x1f[8];
#pragma unroll
                    for (int q = 0; q < 4; ++q) { x1f[2 * q] = bf2f(mw[q] & 0xffffu) + bf2f(xw0[q] & 0xffffu); x1f[2 * q + 1] = __uint_as_float(mw[q] & 0xffff0000u) + __uint_as_float(xw0[q] & 0xffff0000u);
                        xw[q] = pg8::cvt_pk_bf16(x1f[2 * q], x1f[2 * q + 1]);
                        const float lo = bf2f(xw[q] & 0xffffu), hi = __uint_as_float(xw[q] & 0xffff0000u); ss += lo * lo + hi * hi; }
                    *(u32x4*)(x1p + 32 * j) = xw;
                    const f32x4 g0 = *(const LAS f32x4*)(gtab + 32 * j), g1 = *(const LAS f32x4*)(gtab + 32 * j + 4);
                    int w0 = __builtin_amdgcn_cvt_pk_fp8_f32(x1f[0] * g0[0], x1f[1] * g0[1], 0, false); w0 = __builtin_amdgcn_cvt_pk_fp8_f32(x1f[2] * g0[2], x1f[3] * g0[3], w0, true);
                    int w1 = __builtin_amdgcn_cvt_pk_fp8_f32(x1f[4] * g1[0], x1f[5] * g1[1], 0, false); w1 = __builtin_amdgcn_cvt_pk_fp8_f32(x1f[6] * g1[2], x1f[7] * g1[3], w1, true);
                    *(u32x2*)(h2p + 32 * j) = (u32x2){(unsigned)w0, (unsigned)w1};
                    const bf16x8 xa = __builtin_bit_cast(bf16x8, xw);
                    const bf16x8 h0 = *(const LAS bf16x8*)(wp + j * 2048), h1 = *(const LAS bf16x8*)(wp + j * 2048 + 256), l0 = *(const LAS bf16x8*)(wp + 65536 + j * 2048), l1 = *(const LAS bf16x8*)(wp + 65536 + j * 2048 + 256);
                    acc0 = __builtin_amdgcn_mfma_f32_16x16x32_bf16(xa, l0, acc0, 0, 0, 0); acc1 = __builtin_amdgcn_mfma_f32_16x16x32_bf16(xa, l1, acc1, 0, 0, 0);
                    acc0 = __builtin_amdgcn_mfma_f32_16x16x32_bf16(xa, h0, acc0, 0, 0, 0); acc1 = __builtin_amdgcn_mfma_f32_16x16x32_bf16(xa, h1, acc1, 0, 0, 0);
                }
            }
#undef S5_LOAD
            ss += __shfl_xor(ss, 16); ss += __shfl_xor(ss, 32);
            const float rstd = 1.0f / sqrtf(ss * (1.f / DM) + EPS);
            unsigned key0[4], key1[4]; float rsr[4];
#pragma unroll
            for (int reg = 0; reg < 4; ++reg) {
                rsr[reg] = __shfl(rstd, 4 * kq + reg);
                const float l0 = acc0[reg] * rsr[reg] + be0, l1 = acc1[reg] * rsr[reg] + be1;
                unsigned u0 = __float_as_uint(l0), u1 = __float_as_uint(l1);
                u0 ^= (u0 >> 31) ? 0xffffffffu : 0x80000000u; u1 ^= (u1 >> 31) ? 0xffffffffu : 0x80000000u;
                key0[reg] = (u0 & ~31u) | (unsigned)(31 - i16); key1[reg] = (u1 & ~31u) | (unsigned)(15 - i16);
            }
            unsigned win[4][4];
#pragma unroll
            for (int k = 0; k < 4; ++k)
#pragma unroll
                for (int reg = 0; reg < 4; ++reg) {
                    unsigned mk = key0[reg] > key1[reg] ? key0[reg] : key1[reg];
#pragma unroll
                    for (int o = 1; o < 16; o <<= 1) { const unsigned ok = (unsigned)__shfl_xor((int)mk, o); mk = ok > mk ? ok : mk; }
                    win[reg][k] = mk;
                    if (key0[reg] == mk) key0[reg] = 0u; if (key1[reg] == mk) key1[reg] = 0u;
                }
            unsigned mym = 0u; float myg = 0.f, myrs = 0.f;
#pragma unroll
            for (int reg = 0; reg < 4; ++reg) {
                float v[4], ex[4], sum = 0.f;
#pragma unroll
                for (int k = 0; k < 4; ++k) { unsigned uu = win[reg][k] & ~31u; uu ^= (uu >> 31) ? 0x80000000u : 0xffffffffu; v[k] = __uint_as_float(uu); }
#pragma unroll
                for (int k = 0; k < 4; ++k) { ex[k] = __expf(v[k] - v[0]); sum += ex[k]; }
                const float rsum = 1.0f / sum;
#pragma unroll
                for (int k = 0; k < 4; ++k) if (i16 == 4 * reg + k) { mym = win[reg][k]; myg = ex[k] * rsum; myrs = rsr[reg]; }
            }
            const int e_sel = 31 - (int)(mym & 31u);
            const unsigned lr = atomicAdd((unsigned*)&lcnt[e_sel], 1u);
            __syncthreads();
            if (tid < 32) { const unsigned c = lcnt[tid]; lbase[tid] = c ? atomicAdd(&ctl[2048 + 32 * tid], c) : 0u; }
            __syncthreads();
            const size_t slot = (size_t)e_sel * M + lbase[e_sel] + lr;
            LIST[slot] = (tok0 + 4 * kq + (i16 >> 2)) * 4 + (i16 & 3); GLIST[(size_t)(tok0 + 4 * kq + (i16 >> 2)) * 4 + (i16 & 3)] = myg; RS[slot] = myrs;
            ((int*)(ws + WS_SLOTS))[(size_t)(tok0 + 4 * kq + (i16 >> 2)) * 4 + (i16 & 3)] = (e_sel << 16) | (int)(lbase[e_sel] + lr);
        }
        if (BOTH(5)) GRID_BAR();
    }

    LAS int* tstart = (LAS int*)(lds + 140 * 1024); LAS int* ecnt = tstart + 40; LAS int* texp = tstart + 80;
    if (IN(6) || IN(7) || IN(8)) {
        DECL_ALL
        __syncthreads();
        if (tid < NE) ecnt[tid] = (int)__hip_atomic_load(&ctl[2048 + 32 * tid], __ATOMIC_RELAXED, __HIP_MEMORY_SCOPE_AGENT);
        __syncthreads();
        if (tid == 0) { int acc = 0; for (int e = 0; e < NE; ++e) { tstart[e] = acc; acc += (ecnt[e] + 255) / 256; } tstart[NE] = acc; }
        __syncthreads();
        for (int t = tid; t < MAXTILES; t += NTHREADS) { int e = 0; for (int q = 1; q < NE; ++q) if (tstart[q] <= t) e = q; texp[t] = e; }
        __syncthreads();
    }
    if (IN(6)) {
        DECL_ALL
        STAMP(6);
        for (int rep_ = 0; rep_ < ((DUP_PHASE == 6) ? 2 : 1); ++rep_) { if (rep_) GRID_BAR();
        const int ntiles = tstart[NE];
        PHASE_STAGGER(ntiles * 8, 15.f);
        pg8::MoeSched S{(const char*)H2, (const char*)W1T, (size_t)2048 * DM, LIST, tstart, ecnt, texp, 8, ntiles * 8, G, bid, false, DM};
        pg8::EpiSwiglu E{(unsigned char*)ACT, b_mlp1, RS, ecnt};
        pg8::gemm_phase<pg8::EpiSwiglu, pg8::MoeSched, true, true>(lds, S, E, (LAS unsigned*)(lds + 131072));
        if (PROBE_G1) {
            GRID_BAR();
            pg8::MoeSched S2 = S; S2.hot = (PROBE_G1 >= 2);
            pg8::EpiSwiglu E2{(unsigned char*)YB, b_mlp1, RS, ecnt};
            if (PROBE_G1 == 3) pg8::gemm_phase<pg8::EpiSwiglu, pg8::MoeSched, true, true, 4>(lds, S2, E2, (LAS unsigned*)(lds + 131072));
            else if (PROBE_G1 == 4) pg8::gemm_phase<pg8::EpiSwiglu, pg8::MoeSched, true, true, 2>(lds, S2, E2, (LAS unsigned*)(lds + 131072));
            else pg8::gemm_phase<pg8::EpiSwiglu, pg8::MoeSched, true, true>(lds, S2, E2, (LAS unsigned*)(lds + 131072));
        }
        }
        if (BOTH(6)) GRID_BAR();
    }
    if (IN(7)) {
        DECL_ALL
        STAMP(7);
        for (int rep_ = 0; rep_ < ((DUP_PHASE == 7) ? 2 : 1); ++rep_) { if (rep_) GRID_BAR();
        const int ntiles = tstart[NE];
        PHASE_STAGGER(ntiles * 4, 16.f);
        pg8::MoeSched S{(const char*)ACT, (const char*)W2T, (size_t)DM * DFF, LIST, tstart, ecnt, texp, 4, ntiles * 4, G, bid, true, DFF};
        pg8::EpiGateScatter E{(unsigned char*)YB, b_mlp2};
        pg8::gemm_phase<pg8::EpiGateScatter, pg8::MoeSched, true, true>(lds, S, E, (LAS unsigned*)(lds + 131072));
        }
        if (BOTH(7)) GRID_BAR();
    }
    if (IN(8)) {
        DECL_ALL
        STAMP(8);
        const size_t i0 = (size_t)bid * NTHREADS + tid, istep = (size_t)G * NTHREADS, iend = (size_t)M * DM / 16;
        u32x4 sl_n = (u32x4){0u, 0u, 0u, 0u}; f32x4 gt_n = (f32x4){0.f, 0.f, 0.f, 0.f};
        if (i0 < iend) { const size_t tok = i0 / (DM / 16); sl_n = *(const u32x4*)((const int*)(ws + WS_SLOTS) + tok * 4); gt_n = *(const f32x4*)(GLIST + tok * 4); }
        for (size_t i = i0; i < iend; i += istep) {
            const size_t tok = i / (DM / 16); const int c = (int)(i % (DM / 16)) * 16;
            f32x4 a[4]; u32x4 y[4]; const f32x4 gt = gt_n; const u32x4 sl = sl_n;
#pragma unroll
            for (int k = 0; k < 4; ++k) { const size_t row = (size_t)tstart[sl[k] >> 16] * 256 + (sl[k] & 0xffffu); y[k] = *(const u32x4*)((const unsigned char*)YB + row * DM + c); }
            u32x4 xw[2];
#pragma unroll
            for (int j = 0; j < 2; ++j) xw[j] = *(const u32x4*)(X1B + tok * DM + c + 8 * j);
            if (i + istep < iend) { const size_t tn = (i + istep) / (DM / 16); sl_n = *(const u32x4*)((const int*)(ws + WS_SLOTS) + tn * 4); gt_n = *(const f32x4*)(GLIST + tn * 4); }
#pragma unroll
            for (int j = 0; j < 2; ++j) {
                a[2 * j] = (f32x4){bf2f(xw[j].x & 0xffffu), __uint_as_float(xw[j].x & 0xffff0000u), bf2f(xw[j].y & 0xffffu), __uint_as_float(xw[j].y & 0xffff0000u)};
                a[2 * j + 1] = (f32x4){bf2f(xw[j].z & 0xffffu), __uint_as_float(xw[j].z & 0xffff0000u), bf2f(xw[j].w & 0xffffu), __uint_as_float(xw[j].w & 0xffff0000u)}; }
#pragma unroll
            for (int k = 0; k < 4; ++k)
#pragma unroll
                for (int j = 0; j < 4; ++j) { const int w = (int)y[k][j]; const float g = gt[k];
                    a[j].x += g * __builtin_amdgcn_cvt_f32_fp8(w, 0); a[j].y += g * __builtin_amdgcn_cvt_f32_fp8(w, 1); a[j].z += g * __builtin_amdgcn_cvt_f32_fp8(w, 2); a[j].w += g * __builtin_amdgcn_cvt_f32_fp8(w, 3); }
#pragma unroll
            for (int j = 0; j < 4; ++j) *(f32x4*)(out + tok * DM + c + 4 * j) = a[j];
        }
    }
#undef IN
#undef BOTH
}

extern "C" void kernel_launch(void* const* d_in, const int* in_sizes, int n_in, void* d_out, int out_size, void* d_ws, size_t ws_size, hipStream_t stream) {
    static int grid = 0;
    if (grid == 0) {
        if (n_in != 27 || out_size != M * DM || ws_size < WS_END) { fprintf(stderr, "kernel_launch: unexpected problem (n_in %d out %d ws %zu)\n", n_in, out_size, ws_size); grid = -1; return; }
        int dev = 0, cus = 0, per_cu = 0;
        hipGetDevice(&dev); hipDeviceGetAttribute(&cus, hipDeviceAttributeMultiprocessorCount, dev);
        if (hipFuncSetAttribute((const void*)mk_fwd, hipFuncAttributeMaxDynamicSharedMemorySize, LDS_BYTES) != hipSuccess) { fprintf(stderr, "kernel_launch: hipFuncSetAttribute failed\n"); grid = -1; return; }
        hipOccupancyMaxActiveBlocksPerMultiprocessor(&per_cu, (const void*)mk_fwd, NTHREADS, LDS_BYTES);
        (void)hipGetLastError();
        if (per_cu < 1) { fprintf(stderr, "kernel_launch: occupancy query says %d blocks per CU\n", per_cu); per_cu = 1; }
        grid = cus;
    }
    if (grid < 0) return;
    if (hipMemsetAsync((char*)d_ws + WS_CTL, 0, CTL_ZERO_BYTES, stream) != hipSuccess) { fprintf(stderr, "kernel_launch: hipMemsetAsync failed\n"); return; }
    Args a{};
    for (int i = 0; i < 27; ++i) a.in[i] = d_in[i];
    a.out = (float*)d_out; a.ws = (unsigned char*)d_ws;
    constexpr int NPH = 9;
    if (MK_N_LAUNCHES == 1) {
        a.ph_lo = 0; a.ph_hi = NPH;
        void* kargs[] = {&a};
        hipError_t e = hipLaunchCooperativeKernel((const void*)mk_fwd, dim3(grid), dim3(NTHREADS), kargs, LDS_BYTES, stream);
        if (e != hipSuccess) fprintf(stderr, "cooperative launch failed: %s (grid %d)\n", hipGetErrorString(e), grid);
    } else {
        for (int p = 0; p < NPH; ++p) { a.ph_lo = p; a.ph_hi = p + 1; hipLaunchKernelGGL(mk_fwd, dim3(grid), dim3(NTHREADS), LDS_BYTES, stream, a); }
    }
}
```

```cpp
#include <hip/hip_runtime.h>
#include <hip/hip_cooperative_groups.h>
#include <cstdio>
#include <cstdint>
namespace cg = cooperative_groups;

#ifndef MK_N_LAUNCHES
#define MK_N_LAUNCHES 1
#endif

constexpr int BATCH = 16, SEQ = 2048, DM = 1024, M = BATCH * SEQ;
constexpr int NPROJ = 2304;
constexpr int MEML = 256, MM = BATCH * MEML;
constexpr int NE = 32, TOPK = 4, DFF = 1024;
constexpr int MAXTILES = (M * TOPK) / 256 + NE;
constexpr int NSLOT = MAXTILES * 256;
constexpr float EPS = 1e-6f;
constexpr float C2 = 0.125f * 1.4426950408889634f;
constexpr int NWAVES = 8, NTHREADS = 512;
constexpr int LDS_BYTES = 163840;

constexpr size_t MiB = 1u << 20;
constexpr size_t WS_CTL = 0, CTL_ZERO_BYTES = 65536;
constexpr int CW_BAR = 4096;
constexpr size_t WS_WIN = 2 * MiB, WS_WKV = WS_WIN + (size_t)NPROJ * DM * 2  , WS_WO = 8 * MiB, WS_CS = 10 * MiB, WS_LIST = 12 * MiB, WS_GLIST = 16 * MiB;
constexpr size_t WS_MEMN = 20 * MiB, WS_MEMK = 28 * MiB, WS_MEMV = 30 * MiB;
constexpr size_t WS_W1 = 32 * MiB, WS_W2 = 160 * MiB, WS_H2 = 224 * MiB, WS_ACT = 288 * MiB;
constexpr size_t WS_XN = 560 * MiB, WS_QB = 624 * MiB, WS_KB = 656 * MiB, WS_VB = 688 * MiB, WS_UB = 720 * MiB, WS_VGB = 736 * MiB, WS_MQB = 752 * MiB;
constexpr size_t WS_OT = 768 * MiB, WS_CAT = 832 * MiB, WS_RS = 896 * MiB  , WS_END = 900 * MiB;
constexpr size_t WS_RSX = 1 * MiB;
constexpr size_t WS_SLOTS = 17 * MiB;
constexpr size_t WS_X1B = 424 * MiB;
constexpr size_t WS_YB = 560 * MiB;
constexpr size_t WS_PROJ = 224 * MiB;
constexpr size_t WS_KVT = 512 * MiB;
static_assert(WS_ACT + (size_t)NSLOT * DFF * 2 <= WS_XN, "act");
static_assert(WS_ACT + (size_t)NSLOT * DFF <= WS_X1B && WS_X1B + (size_t)M * DM * 2 <= WS_XN, "x1b");
static_assert(WS_PROJ + (size_t)M * NPROJ * 4 <= WS_KVT && WS_KVT + (size_t)MM * 512 * 4 <= WS_XN, "proj temp");

#define LAS __attribute__((address_space(3)))
typedef unsigned short bf16_t;
typedef short bf16x8 __attribute__((ext_vector_type(8)));
typedef float f32x4 __attribute__((ext_vector_type(4)));
typedef unsigned u32x4 __attribute__((ext_vector_type(4)));
typedef unsigned u32x2 __attribute__((ext_vector_type(2)));
typedef int i32x4 __attribute__((ext_vector_type(4)));
typedef int i32x8 __attribute__((ext_vector_type(8)));

__device__ __forceinline__ unsigned f2bf(float f) { unsigned u = __float_as_uint(f); return (u + 0x7fffu + ((u >> 16) & 1u)) >> 16; }
__device__ __forceinline__ float bf2f(unsigned h) { return __uint_as_float(h << 16); }
__device__ __forceinline__ unsigned pk2(float lo, float hi) { return f2bf(lo) | (f2bf(hi) << 16); }
__device__ __forceinline__ float wave_sum(float v) {
#pragma unroll
    for (int o = 1; o < 64; o <<= 1) v += __shfl_xor(v, o);
    return v;
}
__device__ __forceinline__ float gelu_tanh(float x) {
    constexpr float K1 = -2.f * 0.7978845608028654f * 1.4426950408889634f, K2 = K1 * 0.044715f;
    return x * __builtin_amdgcn_rcpf(1.f + __builtin_amdgcn_exp2f(x * (K1 + K2 * (x * x))));
}

struct Args {
    const void* in[27]; float* out; unsigned char* ws; int ph_lo, ph_hi;
};

template <bool KSCALE = false, class RowMap>
__device__ __forceinline__ void transpose_item_p(const float* W, int K, int N, bf16_t* WT, LAS float* scr, int item, int lane, RowMap rm, const float* ks = nullptr) {
    const int nblk = N / 32, kb = item / nblk, nb = item % nblk, k0 = 64 * kb, n0 = 32 * nb;
#pragma unroll 8
    for (int i = 0; i < 32; ++i) { const int kk = 2 * i + (lane >> 5); float wv = W[(size_t)(k0 + kk) * N + n0 + (lane & 31)]; if (KSCALE) wv *= ks[k0 + kk]; scr[kk * 33 + (lane & 31)] = wv; }
    asm volatile("s_waitcnt lgkmcnt(0)" ::: "memory");
    const int c = lane & 7;
#pragma unroll
    for (int j = 0; j < 4; ++j) { const int n = (lane >> 3) + 8 * j; const LAS float* s = scr + (8 * c) * 33 + n;
        u32x4 o; o.x = pk2(s[0 * 33], s[1 * 33]); o.y = pk2(s[2 * 33], s[3 * 33]); o.z = pk2(s[4 * 33], s[5 * 33]); o.w = pk2(s[6 * 33], s[7 * 33]);
        *(u32x4*)(WT + (size_t)rm(n0 + n) * K + k0 + 8 * c) = o; }
    asm volatile("s_waitcnt lgkmcnt(0)" ::: "memory");
}
template <class RowMap>
__device__ __forceinline__ void transpose_item_f8(const float* W, int K, int N, unsigned char* WT, LAS float* scr, int item, int lane, RowMap rm) {
    const int nblk = N / 32, kb = item / nblk, nb = item % nblk, k0 = 128 * kb, n0 = 32 * nb;
    const int lk = lane >> 3, lp = lane & 7;
    const float* src = W + (size_t)(k0 + lk) * N + n0 + 4 * lp;
#pragma unroll 4
    for (int i = 0; i < 16; ++i) { const int kk = 8 * i + lk; const f32x4 v = __builtin_nontemporal_load((const f32x4*)(src + (size_t)(8 * i) * N));
        LAS float* d = scr + kk * 33 + 16 * (kk >> 6) + 4 * lp; d[0] = v[0]; d[1] = v[1]; d[2] = v[2]; d[3] = v[3]; }
    asm volatile("s_waitcnt lgkmcnt(0)" ::: "memory");
    const int n = lane >> 1, kh = lane & 1; const LAS float* s = scr + (64 * kh) * 33 + 16 * kh + n;
    unsigned char* o = WT + (size_t)rm(n0 + n) * K + k0 + 64 * kh;
#pragma unroll
    for (int q = 0; q < 4; ++q) { u32x4 w;
#pragma unroll
        for (int j = 0; j < 4; ++j) { const LAS float* t = s + (16 * q + 4 * j) * 33;
            int p = __builtin_amdgcn_cvt_pk_fp8_f32(t[0] * 64.f, t[33] * 64.f, 0, false); p = __builtin_amdgcn_cvt_pk_fp8_f32(t[66] * 64.f, t[99] * 64.f, p, true); w[j] = (unsigned)p; }
        *(u32x4*)(o + 16 * q) = w; }
    asm volatile("s_waitcnt lgkmcnt(0)" ::: "memory");
}
__device__ __forceinline__ void transpose_item(const float* W, int K, int N, bf16_t* WT, LAS float* scr, int item, int lane) {
    const int nblk = N / 32, kb = item / nblk, nb = item % nblk, k0 = 64 * kb, n0 = 32 * nb;
#pragma unroll 8
    for (int i = 0; i < 32; ++i) { const int kk = 2 * i + (lane >> 5); scr[kk * 33 + (lane & 31)] = W[(size_t)(k0 + kk) * N + n0 + (lane & 31)]; }
    asm volatile("s_waitcnt lgkmcnt(0)" ::: "memory");
    const int c = lane & 7;
#pragma unroll
    for (int j = 0; j < 4; ++j) { const int n = (lane >> 3) + 8 * j; const LAS float* s = scr + (8 * c) * 33 + n;
        u32x4 o; o.x = pk2(s[0 * 33], s[1 * 33]); o.y = pk2(s[2 * 33], s[3 * 33]); o.z = pk2(s[4 * 33], s[5 * 33]); o.w = pk2(s[6 * 33], s[7 * 33]);
        *(u32x4*)(WT + (size_t)(n0 + n) * K + k0 + 8 * c) = o; }
    asm volatile("s_waitcnt lgkmcnt(0)" ::: "memory");
}
__device__ __forceinline__ void rms_row2_to_bf16(const float* xrow0, const float* xrow1, const float* g, bf16_t* orow0, bf16_t* orow1, int lane) {
    const f32x4* xa = (const f32x4*)xrow0 + lane; const f32x4* xb = (const f32x4*)xrow1 + lane; const f32x4* gr = (const f32x4*)g + lane;
    f32x4 va[4], vb[4]; float sa = 0.f, sb = 0.f;
#pragma unroll
    for (int j = 0; j < 4; ++j) { va[j] = __builtin_nontemporal_load(xa + 64 * j); vb[j] = __builtin_nontemporal_load(xb + 64 * j); }
#pragma unroll
    for (int j = 0; j < 4; ++j) { sa += (va[j].x * va[j].x + va[j].y * va[j].y) + (va[j].z * va[j].z + va[j].w * va[j].w); sb += (vb[j].x * vb[j].x + vb[j].y * vb[j].y) + (vb[j].z * vb[j].z + vb[j].w * vb[j].w); }
#pragma unroll
    for (int o = 1; o < 64; o <<= 1) { sa += __shfl_xor(sa, o); sb += __shfl_xor(sb, o); }
    const float ra = 1.0f / sqrtf(sa * (1.f / DM) + EPS), rb = 1.0f / sqrtf(sb * (1.f / DM) + EPS);
    u32x2* oa = (u32x2*)orow0 + lane; u32x2* ob = (u32x2*)orow1 + lane;
#pragma unroll
    for (int j = 0; j < 4; ++j) { const f32x4 gg = gr[64 * j]; u32x2 w;
        w.x = pk2(va[j].x * ra * gg.x, va[j].y * ra * gg.y); w.y = pk2(va[j].z * ra * gg.z, va[j].w * ra * gg.w); oa[64 * j] = w;
        w.x = pk2(vb[j].x * rb * gg.x, vb[j].y * rb * gg.y); w.y = pk2(vb[j].z * rb * gg.z, vb[j].w * rb * gg.w); ob[64 * j] = w; }
}
__device__ __forceinline__ void row2_to_bf16_rs(const float* xrow0, const float* xrow1, bf16_t* orow0, bf16_t* orow1, float* rs0, int lane) {
    const f32x4* xa = (const f32x4*)xrow0 + lane; const f32x4* xb = (const f32x4*)xrow1 + lane;
    f32x4 va[4], vb[4]; float sa = 0.f, sb = 0.f;
#pragma unroll
    for (int j = 0; j < 4; ++j) { va[j] = __builtin_nontemporal_load(xa + 64 * j); vb[j] = __builtin_nontemporal_load(xb + 64 * j); }
    u32x2* oa = (u32x2*)orow0 + lane; u32x2* ob = (u32x2*)orow1 + lane;
#pragma unroll
    for (int j = 0; j < 4; ++j) { u32x2 w; w.x = pk2(va[j].x, va[j].y); w.y = pk2(va[j].z, va[j].w); oa[64 * j] = w; w.x = pk2(vb[j].x, vb[j].y); w.y = pk2(vb[j].z, vb[j].w); ob[64 * j] = w; }
#pragma unroll
    for (int j = 0; j < 4; ++j) { sa += (va[j].x * va[j].x + va[j].y * va[j].y) + (va[j].z * va[j].z + va[j].w * va[j].w); sb += (vb[j].x * vb[j].x + vb[j].y * vb[j].y) + (vb[j].z * vb[j].z + vb[j].w * vb[j].w); }
#pragma unroll
    for (int o = 1; o < 64; o <<= 1) { sa += __shfl_xor(sa, o); sb += __shfl_xor(sb, o); }
    if (lane == 0) { rs0[0] = 1.0f / sqrtf(sa * (1.f / DM) + EPS); rs0[1] = 1.0f / sqrtf(sb * (1.f / DM) + EPS); }
}
__device__ __forceinline__ void rms_row_to_bf16(const float* xrow, const float* g, bf16_t* orow, int lane) {
    const f32x4* xr = (const f32x4*)xrow + lane; const f32x4* gr = (const f32x4*)g + lane;
    f32x4 v[4]; float s = 0.f;
#pragma unroll
    for (int j = 0; j < 4; ++j) { v[j] = xr[64 * j]; s += (v[j].x * v[j].x + v[j].y * v[j].y) + (v[j].z * v[j].z + v[j].w * v[j].w); }
    const float rstd = 1.0f / sqrtf(wave_sum(s) * (1.f / DM) + EPS);
    u32x2* o8 = (u32x2*)orow + lane;
#pragma unroll
    for (int j = 0; j < 4; ++j) { const f32x4 gg = gr[64 * j]; u32x2 w; w.x = pk2(v[j].x * rstd * gg.x, v[j].y * rstd * gg.y); w.y = pk2(v[j].z * rstd * gg.z, v[j].w * rstd * gg.w); o8[64 * j] = w; }
}

namespace pg8 {
constexpr int BM = 256, BK = 64, HALF = 128, HTB = HALF * BK * 2, STAGE_BYTES = 8 * HTB, KD = 1024;
constexpr int PF_LDS = 144 * 1024;
__device__ __forceinline__ int lds_byte(int r, int c) { const int st = (r >> 4) * 2 + (c >> 5), rr = r & 15, cc = c & 31, ob = rr * 64 + cc * 2; return st * 1024 + (ob ^ (((ob >> 9) & 1) << 5)); }
__device__ __forceinline__ void stage_rc(int b, int& R, int& C) { const int st = b / 1024, sb = b % 1024, swz = sb ^ (((sb >> 9) & 1) << 5); R = (st >> 1) * 16 + swz / 64; C = (st & 1) * 32 + (swz % 64) / 2; }
__device__ __forceinline__ int perm32(int rho) { const int n = rho >> 4, i = rho & 15; return 8 * (i >> 2) + 4 * n + (i & 3); }
__device__ __forceinline__ unsigned cvt_pk_bf16(float lo, float hi) { unsigned r; asm volatile("v_cvt_pk_bf16_f32 %0, %1, %2" : "=v"(r) : "v"(lo), "v"(hi)); return r; }

struct Unit { const char* a; const char* b; int t, pn, e, mt; };

template <class Epi, class Sched, bool GATHER, bool F8 = false, int NTP = 0  >
__device__ __forceinline__ void gemm_phase(LAS unsigned char* lds, const Sched& S, const Epi& E, LAS unsigned* xoff) {
    const int tid = threadIdx.x, wid = __builtin_amdgcn_readfirstlane(tid >> 6), lane = tid & 63, wr = wid >> 2, wc = wid & 3, fr = lane & 15, fq = lane >> 4;
    constexpr int RB = F8 ? KD : KD * 2, nt = NTP ? NTP : RB / (BK * 2);
    unsigned voffA0[2], voffA1[2], voffB[2];
    Unit cur, nxt; int ui = 0;
    if (!S.next(0, cur)) return;
#pragma unroll
    for (int i = 0; i < 2; ++i) { int R, C; stage_rc(tid * 16 + i * 8192, R, C); const int Rb = Epi::PERM ? ((R & ~31) + perm32(R & 31)) : R;
        voffB[i] = (unsigned)(Rb * RB + C * 2);
        if (GATHER) { voffA0[i] = S.arow(cur, R) + (unsigned)C * 2u; voffA1[i] = S.arow(cur, R + HALF) + (unsigned)C * 2u; }
        else { voffA0[i] = (unsigned)(R * RB + C * 2); voffA1[i] = 0u; } }
    if (GATHER) {
        Unit u1; const bool h1 = S.next(1, u1); if (!h1) u1 = cur;
        unsigned x1[4];
#pragma unroll
        for (int i = 0; i < 2; ++i) { int R, C; stage_rc(tid * 16 + i * 8192, R, C); x1[i] = S.arow(u1, R) + (unsigned)C * 2u; x1[2 + i] = S.arow(u1, R + HALF) + (unsigned)C * 2u; }
#pragma unroll
        for (int i = 0; i < 4; ++i) xoff[tid * 4 + i] = x1[i];
    }
    const size_t kstep = (size_t)(BK * 2);
    const size_t hstep = (size_t)HALF * RB;
    const size_t hA = GATHER ? (size_t)0 : hstep;
#define PG8_VA1 (GATHER ? voffA1 : voffA0)
    const unsigned ldsw = (unsigned)wid * 1024u;
    const int aoff = lds_byte(wr * 64 + fr, fq * 8), boff = lds_byte(wc * 32 + fr, fq * 8);
#define PG8_SA(b, h) (((b) * 2 + (h)) * HTB)
#define PG8_SB(b, h) ((4 + (b) * 2 + (h)) * HTB)
#define PG8_STAGE(bufoff, gbase, voff) do { _Pragma("unroll") for (int _i = 0; _i < 2; ++_i) \
        __builtin_amdgcn_global_load_lds((const unsigned*)((const char*)(gbase) + (voff)[_i]), (LAS unsigned*)(lds + (bufoff) + ldsw + _i * 8192), 16, 0, 0); } while (0)
#define PG8_LD2(base) __builtin_shufflevector(*(const LAS i32x4*)(base), *(const LAS i32x4*)((base) + 1024), 0, 1, 2, 3, 4, 5, 6, 7)
#define PG8_LDA(dst, b, h) do { _Pragma("unroll") for (int m = 0; m < 4; ++m) dst[m] = PG8_LD2(lds + PG8_SA(b, h) + aoff + m * 2048); } while (0)
#define PG8_LDB(dst, b, h) do { _Pragma("unroll") for (int n = 0; n < 2; ++n) dst[n] = PG8_LD2(lds + PG8_SB(b, h) + boff + n * 2048); } while (0)
#define PG8_LO(x) __builtin_bit_cast(bf16x8, __builtin_shufflevector((x), (x), 0, 1, 2, 3))
#define PG8_HI(x) __builtin_bit_cast(bf16x8, __builtin_shufflevector((x), (x), 4, 5, 6, 7))
#define PG8_MMA(ai, bj, At, Bt) do { __builtin_amdgcn_s_setprio(1); _Pragma("unroll") for (int m = 0; m < 4; ++m) _Pragma("unroll") for (int n = 0; n < 2; ++n) { \
        if constexpr (F8) acc[ai][bj][m][n] = __builtin_amdgcn_mfma_scale_f32_16x16x128_f8f6f4(Bt[n], At[m], acc[ai][bj][m][n], 0, 0, 0, 0x7f7f7f7f, 0, 0x7f7f7f7f); \
        else { acc[ai][bj][m][n] = __builtin_amdgcn_mfma_f32_16x16x32_bf16(PG8_LO(Bt[n]), PG8_LO(At[m]), acc[ai][bj][m][n], 0, 0, 0); \
               acc[ai][bj][m][n] = __builtin_amdgcn_mfma_f32_16x16x32_bf16(PG8_HI(Bt[n]), PG8_HI(At[m]), acc[ai][bj][m][n], 0, 0, 0); } } __builtin_amdgcn_s_setprio(0); } while (0)
#define PG8_WAIT_V(n) asm volatile("s_waitcnt vmcnt(" #n ")" ::: "memory")
#define PG8_WAIT_L(n) asm volatile("s_waitcnt lgkmcnt(" #n ")" ::: "memory")
#define PG8_BAR __builtin_amdgcn_s_barrier()
#define PG8_SCHED __builtin_amdgcn_sched_barrier(0)
    f32x4 acc[2][2][4][2];
#pragma unroll
    for (int a = 0; a < 2; ++a)
#pragma unroll
        for (int b = 0; b < 2; ++b)
#pragma unroll
            for (int m = 0; m < 4; ++m)
#pragma unroll
                for (int n = 0; n < 2; ++n) acc[a][b][m][n] = (f32x4){0.f, 0.f, 0.f, 0.f};
    i32x8 At[4], B0[2], B1[2];
    const char* cA = cur.a; const char* cB = cur.b;
    LAS unsigned* pfrow = (LAS unsigned*)(lds + PF_LDS) + wid * ((Epi::NPF_ROWS + Epi::NPG_ROWS) * 64);
    LAS unsigned* pgrow = pfrow + Epi::NPF_ROWS * 64;
    PG8_WAIT_V(0);
    if constexpr (Epi::NPF_ROWS > 0) { E.pf_issue(cur, wr, wc, lane, pfrow);
        if (GATHER) { Unit u2; if (S.next(2, u2)) S.pfg_issue(u2, tid, pgrow); } }
    PG8_STAGE(PG8_SB(0, 0), cB, voffB); PG8_STAGE(PG8_SB(0, 1), cB + hstep, voffB); PG8_STAGE(PG8_SA(0, 0), cA, voffA0); PG8_STAGE(PG8_SA(0, 1), cA + hA, PG8_VA1);
    if (wr == 1) PG8_BAR;
    PG8_WAIT_V(2); PG8_BAR;
    PG8_STAGE(PG8_SB(1, 0), cB + kstep, voffB); PG8_STAGE(PG8_SA(1, 0), cA + kstep, voffA0); PG8_STAGE(PG8_SB(1, 1), cB + hstep + kstep, voffB);
    PG8_WAIT_V(6); PG8_BAR;
    for (;;) {
        const bool has_next = S.next(ui + 1, nxt);
        const char* nA = has_next ? nxt.a : cA; const char* nB = has_next ? nxt.b : cB;
#pragma unroll 1
        for (int t = 0; t < nt; t += 2) {
            const bool last = (t == nt - 2);
            const char* a1 = cA + (size_t)(t + 1) * kstep;
            const char* a2 = last ? nA : cA + (size_t)(t + 2) * kstep; const char* b2 = last ? nB : cB + (size_t)(t + 2) * kstep;
            const char* a3 = a2 + kstep; const char* b3 = b2 + kstep;
            PG8_LDB(B0, 0, 0); PG8_LDB(B1, 0, 1); PG8_SCHED; PG8_LDA(At, 0, 0); PG8_STAGE(PG8_SA(1, 1), a1 + hA, PG8_VA1);
            if (GATHER) { if (last && has_next) {
#pragma unroll
                for (int i = 0; i < 2; ++i) { voffA0[i] = xoff[tid * 4 + i]; voffA1[i] = xoff[tid * 4 + 2 + i]; } } }
            PG8_WAIT_V(8); PG8_WAIT_L(0); PG8_BAR; PG8_MMA(0, 0, At, B0); PG8_MMA(0, 1, At, B1); PG8_BAR; PG8_SCHED;
            PG8_LDA(At, 0, 1); PG8_STAGE(PG8_SB(0, 0), b2, voffB); PG8_STAGE(PG8_SB(0, 1), b2 + hstep, voffB); PG8_STAGE(PG8_SA(0, 0), a2, voffA0);
            PG8_WAIT_V(8); PG8_WAIT_L(0); PG8_BAR; PG8_MMA(1, 0, At, B0); PG8_MMA(1, 1, At, B1); PG8_BAR; PG8_SCHED;
            PG8_LDB(B0, 1, 0); PG8_LDB(B1, 1, 1); PG8_SCHED; PG8_LDA(At, 1, 0); PG8_STAGE(PG8_SA(0, 1), a2 + hA, PG8_VA1);
            PG8_WAIT_V(8); PG8_WAIT_L(0); PG8_BAR; PG8_MMA(0, 0, At, B0); PG8_MMA(0, 1, At, B1); PG8_BAR; PG8_SCHED;
            PG8_LDA(At, 1, 1); PG8_STAGE(PG8_SB(1, 0), b3, voffB); PG8_STAGE(PG8_SB(1, 1), b3 + hstep, voffB); PG8_STAGE(PG8_SA(1, 0), a3, voffA0);
            PG8_WAIT_V(8); PG8_WAIT_L(0); PG8_BAR; PG8_MMA(1, 0, At, B0); PG8_MMA(1, 1, At, B1); PG8_BAR; PG8_SCHED;
        }
        if (wr == 0) PG8_BAR;
        int nx[4] = {0, 0, 0, 0};
        if (GATHER) {
            if constexpr (Epi::NPF_ROWS > 0) {
#pragma unroll
                for (int i = 0; i < 2; ++i) { int R, C; stage_rc(tid * 16 + i * 8192, R, C); nx[i] = S.pfg_read(pgrow, lane, i, R); nx[2 + i] = S.pfg_read(pgrow, lane, 2 + i, R + HALF); }
                asm volatile("s_waitcnt lgkmcnt(0)" ::: "memory");
                Unit u3; if (S.next(ui + 3, u3)) S.pfg_issue(u3, tid, pgrow);
            } else {
                Unit u2; if (!S.next(ui + 2, u2)) u2 = cur;
#pragma unroll
                for (int i = 0; i < 2; ++i) { int R, C; stage_rc(tid * 16 + i * 8192, R, C); nx[i] = S.araw(u2, R); nx[2 + i] = S.araw(u2, R + HALF); }
            }
        }
        if constexpr (Epi::NPF_ROWS > 0) E(acc, cur, nxt, has_next, wr, wc, fr, fq, lane, pfrow); else E(acc, cur, wr, wc, fr, fq);
        if (GATHER) {
#pragma unroll
            for (int i = 0; i < 2; ++i) { int R, C; stage_rc(tid * 16 + i * 8192, R, C); xoff[tid * 4 + i] = S.afin(nx[i]) + (unsigned)C * 2u; xoff[tid * 4 + 2 + i] = S.afin(nx[2 + i]) + (unsigned)C * 2u; }
        }
        if (!has_next) break;
#pragma unroll
        for (int a = 0; a < 2; ++a)
#pragma unroll
            for (int b = 0; b < 2; ++b)
#pragma unroll
                for (int m = 0; m < 4; ++m)
#pragma unroll
                    for (int n = 0; n < 2; ++n) acc[a][b][m][n] = (f32x4){0.f, 0.f, 0.f, 0.f};
        cur = nxt; cA = nA; cB = nB; ++ui;
        if (wr == 1) PG8_BAR;
    }
    PG8_WAIT_V(0);
    PG8_BAR;
#undef PG8_SA
#undef PG8_VA1
#undef PG8_SB
#undef PG8_STAGE
#undef PG8_LDA
#undef PG8_LDB
#undef PG8_MMA
#undef PG8_LD2
#undef PG8_LO
#undef PG8_HI
#undef PG8_WAIT_V
#undef PG8_WAIT_L
#undef PG8_BAR
#undef PG8_SCHED
}

struct DenseSched {
    const char* A; const char* B; int nN, total, G, c;
    __device__ __forceinline__ bool next(int i, Unit& u) const {
        const int per = G >> 3; const int L = (i * 8 + (c & 7)) * per + (c >> 3); if (L >= total) return false;
        const int pm = L / nN, pn = L % nN; u.a = A + (size_t)pm * (BM * KD * 2); u.b = B + (size_t)pn * (BM * KD * 2); u.t = pm; u.pn = pn; u.e = 0; u.mt = pm; return true;
    }
    __device__ __forceinline__ unsigned arow(const Unit&, int) const { return 0u; }
    __device__ __forceinline__ int araw(const Unit&, int) const { return 0; }
    __device__ __forceinline__ unsigned afin(int) const { return 0u; }
    __device__ __forceinline__ void pfg_issue(const Unit&, int, LAS unsigned*) const {}
    __device__ __forceinline__ int pfg_read(LAS const unsigned*, int, int, int) const { return 0; }
};
struct MoeSched {
    const char* A; const char* B; size_t b_expert_stride; const int* list; LAS const int* tstart; LAS const int* ecnt; LAS const int* texp; int nN, total, G, c; bool tile_major_a; int rb; bool hot = false;
    __device__ __forceinline__ bool next(int i, Unit& u) const {
        const int per = G >> 3; const int L = (i * 8 + (c & 7)) * per + (c >> 3); if (L >= total) return false;
        const int t = L / nN, pn = L % nN; const int e = texp[t];
        u.t = t; u.pn = pn; u.e = e; u.mt = t - tstart[e];
        u.a = tile_major_a ? A + (size_t)t * (size_t)(BM * rb) : A; u.b = B + (size_t)e * b_expert_stride + (size_t)pn * (size_t)(BM * rb);
        if (hot) u.b = B; return true;
    }
    __device__ __forceinline__ unsigned arow(const Unit& u, int R) const {
        if (tile_major_a || hot) return (unsigned)R * (unsigned)rb;
        return afin(araw(u, R));
    }
    __device__ __forceinline__ int araw(const Unit& u, int R) const {
        if (tile_major_a || hot) return R << 2;
        const int rank = min(u.mt * 256 + R, max(ecnt[u.e] - 1, 0)); return list[(size_t)u.e * M + rank];
    }
    __device__ __forceinline__ unsigned afin(int raw) const { return (unsigned)(raw >> 2) * (unsigned)rb; }
    __device__ __forceinline__ void pfg_issue(const Unit& u, int tid, LAS unsigned* g) const {
        if (tile_major_a || hot) return;
        const int cl = max(ecnt[u.e] - 1, 0); const int* base = list + (size_t)u.e * M;
#pragma unroll
        for (int i = 0; i < 2; ++i) { int R, C; stage_rc(tid * 16 + i * 8192, R, C);
            __builtin_amdgcn_global_load_lds((const unsigned*)(base + min(u.mt * 256 + R, cl)), g + i * 64, 4, 0, 0);
            __builtin_amdgcn_global_load_lds((const unsigned*)(base + min(u.mt * 256 + R + HALF, cl)), g + (2 + i) * 64, 4, 0, 0); }
    }
    __device__ __forceinline__ int pfg_read(LAS const unsigned* g, int lane, int j, int R) const { return (tile_major_a || hot) ? (R << 2) : (int)g[j * 64 + lane]; }
};

struct EpiResidual {
    static constexpr int NPF_ROWS = 0, NPG_ROWS = 0;
    static constexpr bool PERM = true;
    const bf16_t* res; bf16_t* o; unsigned char* h2; const float* gain;
    __device__ __forceinline__ void operator()(const f32x4 (&acc)[2][2][4][2], const Unit& u, int wr, int wc, int fr, int fq) const {
        asm volatile("" : "+v"(fr), "+v"(fq));
        const int col0 = u.pn * BM + wc * 32 + 8 * fq;
        f32x4 gv[2][2];
#pragma unroll
        for (int bj = 0; bj < 2; ++bj)
#pragma unroll
            for (int n = 0; n < 2; ++n) gv[bj][n] = *(const f32x4*)(gain + col0 + bj * HALF + 4 * n);
        const size_t base = (size_t)(u.t * BM + wr * 64 + fr) * DM + col0;
        u32x4 rb[2][2][2];
#define ER_LOAD(b) do { _Pragma("unroll") for (int rr = 0; rr < 2; ++rr) { const int q = 2 * (b) + rr; const size_t off = base + (size_t)((q >> 2) * HALF + (q & 3) * 16) * DM; \
            _Pragma("unroll") for (int bj = 0; bj < 2; ++bj) rb[(b) & 1][rr][bj] = *(const u32x4*)(res + off + bj * HALF); } } while (0)
        ER_LOAD(0);
#pragma unroll
        for (int b = 0; b < 4; ++b) {
            if (b + 1 < 4) ER_LOAD(b + 1);
#pragma unroll
            for (int rr = 0; rr < 2; ++rr) { const int q = 2 * b + rr, ai = q >> 2, m = q & 3; const size_t off = base + (size_t)(ai * HALF + m * 16) * DM;
#pragma unroll
                for (int bj = 0; bj < 2; ++bj) { int w[2]; u32x4 xw;
#pragma unroll
                    for (int n = 0; n < 2; ++n) { const unsigned r0 = rb[b & 1][rr][bj][2 * n], r1 = rb[b & 1][rr][bj][2 * n + 1];
                        const f32x4 x1 = (f32x4){bf2f(r0 & 0xffffu), __uint_as_float(r0 & 0xffff0000u), bf2f(r1 & 0xffffu), __uint_as_float(r1 & 0xffff0000u)} + acc[ai][bj][m][n]; xw[2 * n] = cvt_pk_bf16(x1[0], x1[1]); xw[2 * n + 1] = cvt_pk_bf16(x1[2], x1[3]);
                        const f32x4 hh = x1 * gv[bj][n]; int ww = __builtin_amdgcn_cvt_pk_fp8_f32(hh[0], hh[1], 0, false); ww = __builtin_amdgcn_cvt_pk_fp8_f32(hh[2], hh[3], ww, true); w[n] = ww; }
                    *(u32x4*)(o + off + bj * HALF) = xw;
                    *(u32x2*)(h2 + off + bj * HALF) = (u32x2){(unsigned)w[0], (unsigned)w[1]}; } }
        }
#undef ER_LOAD
    }
};
struct EpiSwiglu {
    static constexpr bool PERM = true;
    unsigned char* act; const float* b1; const float* rs; LAS const int* ecnt;
    static constexpr int NPF_ROWS = 3, NPG_ROWS = 4;
    __device__ __forceinline__ void pf_issue(const Unit& u, int wr, int wc, int lane, LAS unsigned* rows) const {
        int pl = lane; asm volatile("" : "+v"(pl));
        const float* r0 = rs + (size_t)u.e * M + u.mt * 256 + wr * 64 + pl;
        __builtin_amdgcn_global_load_lds((const unsigned*)r0, rows, 4, 0, 0);
        __builtin_amdgcn_global_load_lds((const unsigned*)(r0 + HALF), rows + 64, 4, 0, 0);
        __builtin_amdgcn_global_load_lds((const unsigned*)(b1 + (size_t)u.e * 2048 + (pl >> 5) * 1024 + u.pn * HALF + wc * 32 + (pl & 31)), rows + 128, 4, 0, 0);
    }
    __device__ __forceinline__ void operator()(const f32x4 (&acc)[2][2][4][2], const Unit& u, const Unit& un, bool has_next, int wr, int wc, int fr, int fq, int lane, LAS unsigned* rows) const {
        asm volatile("" : "+v"(fr), "+v"(fq));
        const int c0 = u.pn * HALF + wc * 32 + 8 * fq; const int cnt = ecnt[u.e];
        f32x4 bv[2][2]; float rsv[2][4];
#pragma unroll
        for (int bj = 0; bj < 2; ++bj)
#pragma unroll
            for (int n = 0; n < 2; ++n) bv[bj][n] = *(const LAS f32x4*)(rows + 128 + bj * 32 + 8 * fq + 4 * n);
#pragma unroll
        for (int ai = 0; ai < 2; ++ai)
#pragma unroll
            for (int m = 0; m < 4; ++m) rsv[ai][m] = __uint_as_float(rows[ai * 64 + m * 16 + fr]);
        asm volatile("s_waitcnt lgkmcnt(0)" ::: "memory");
        if (has_next) pf_issue(un, wr, wc, lane, rows);
#pragma unroll
        for (int ai = 0; ai < 2; ++ai)
#pragma unroll
            for (int m = 0; m < 4; ++m) {
                const int rl = ai * HALF + wr * 64 + m * 16 + fr, rank = u.mt * 256 + rl;
                const float r = rank < cnt ? rsv[ai][m] * (1.0f / 64.0f) : 0.f;
                float a8[8];
#pragma unroll
                for (int n = 0; n < 2; ++n)
#pragma unroll
                    for (int i = 0; i < 4; ++i) {
                        const float glu = fminf(acc[ai][0][m][n][i] * r + bv[0][n][i], 7.0f), lin = fminf(fmaxf(acc[ai][1][m][n][i] * r + bv[1][n][i], -7.0f), 7.0f);
                        a8[4 * n + i] = glu * __builtin_amdgcn_rcpf(1.0f + __builtin_amdgcn_exp2f(glu * (-1.702f * 1.4426950408889634f))) * (lin + 1.0f);
                    }
                int w0 = __builtin_amdgcn_cvt_pk_fp8_f32(a8[0], a8[1], 0, false); w0 = __builtin_amdgcn_cvt_pk_fp8_f32(a8[2], a8[3], w0, true);
                int w1 = __builtin_amdgcn_cvt_pk_fp8_f32(a8[4], a8[5], 0, false); w1 = __builtin_amdgcn_cvt_pk_fp8_f32(a8[6], a8[7], w1, true);
                *(u32x2*)(act + ((size_t)u.t * BM + rl) * DFF + c0) = (u32x2){(unsigned)w0, (unsigned)w1};
            }
    }
};
struct EpiGateScatter {
    static constexpr int NPF_ROWS = 0, NPG_ROWS = 0;
    static constexpr bool PERM = true;
    unsigned char* yb; const float* b2;
    __device__ __forceinline__ void operator()(const f32x4 (&acc)[2][2][4][2], const Unit& u, int wr, int wc, int fr, int fq) const {
        asm volatile("" : "+v"(fr), "+v"(fq));
        const int c0 = u.pn * BM + wc * 64 + 16 * fq; const float* bb = b2 + (size_t)u.e * DM + c0;
        f32x4 bv[2][2];
#pragma unroll
        for (int bj = 0; bj < 2; ++bj)
#pragma unroll
            for (int n = 0; n < 2; ++n) bv[bj][n] = *(const f32x4*)(bb + 8 * bj + 4 * n);
#pragma unroll
        for (int ai = 0; ai < 2; ++ai)
#pragma unroll
            for (int m = 0; m < 4; ++m) {
                const int rl = ai * HALF + wr * 64 + m * 16 + fr;
                u32x4 w;
#pragma unroll
                for (int bj = 0; bj < 2; ++bj) { const f32x4 v0 = acc[ai][bj][m][0] * (1.0f / 64.0f) + bv[bj][0], v1 = acc[ai][bj][m][1] * (1.0f / 64.0f) + bv[bj][1];
                    int w0 = __builtin_amdgcn_cvt_pk_fp8_f32(v0[0], v0[1], 0, false); w0 = __builtin_amdgcn_cvt_pk_fp8_f32(v0[2], v0[3], w0, true);
                    int w1 = __builtin_amdgcn_cvt_pk_fp8_f32(v1[0], v1[1], 0, false); w1 = __builtin_amdgcn_cvt_pk_fp8_f32(v1[2], v1[3], w1, true);
                    w[2 * bj] = (unsigned)w0; w[2 * bj + 1] = (unsigned)w1; }
                *(u32x4*)(yb + ((size_t)u.t * BM + rl) * DM + c0) = w;
            }
    }
};

struct EpiInProj {
    static constexpr int NPF_ROWS = 0, NPG_ROWS = 0;
    static constexpr bool PERM = true;
    unsigned char* wsb;
    template <bool ROPE>
    __device__ __forceinline__ void normed(const f32x4 (&acc)[2][2][4][2], const float* gp, float sc, bf16_t* dst, int pitch, int row0, int wc, int fq, const float* rsp) const {
        const float* cs = (const float*)(wsb + WS_CS);
        float rsv[8];
#pragma unroll
        for (int q = 0; q < 8; ++q) rsv[q] = rsp[(q >> 2) * HALF + (q & 3) * 16];
        f32x4 gv[2][2];
#pragma unroll
        for (int bj = 0; bj < 2; ++bj)
#pragma unroll
            for (int n = 0; n < 2; ++n) gv[bj][n] = *(const f32x4*)(gp + 16 * fq + 8 * bj + 4 * n) * sc;
        f32x4 cb[2][4];
#define IP_CS(q) do { const int rw = row0 + ((q) >> 2) * HALF + ((q) & 3) * 16; _Pragma("unroll") for (int j = 0; j < 4; ++j) cb[(q) & 1][j] = *(const f32x4*)(cs + (size_t)rw * 16 + 4 * j); } while (0)
        if (ROPE) IP_CS(0);
        float ss[8];
#pragma unroll
        for (int q = 0; q < 8; ++q) { float a = 0.f;
#pragma unroll
            for (int bj = 0; bj < 2; ++bj)
#pragma unroll
                for (int n = 0; n < 2; ++n) { const f32x4 v = acc[q >> 2][bj][q & 3][n]; a += (v[0] * v[0] + v[1] * v[1]) + (v[2] * v[2] + v[3] * v[3]); }
            ss[q] = a; }
#pragma unroll
        for (int q = 0; q < 8; ++q) ss[q] += __shfl_xor(ss[q], 16);
#pragma unroll
        for (int q = 0; q < 8; ++q) ss[q] += __shfl_xor(ss[q], 32);
#pragma unroll
        for (int q = 0; q < 8; ++q) {
            const int ai = q >> 2, m = q & 3, row = row0 + ai * HALF + m * 16;
            if (ROPE && q + 1 < 8) IP_CS(q + 1);
            const float rstd = rsv[q] * __builtin_amdgcn_rsqf(rsv[q] * rsv[q] * ss[q] * (1.f / 64) + EPS);
            f32x4 y[2][2];
#pragma unroll
            for (int bj = 0; bj < 2; ++bj)
#pragma unroll
                for (int n = 0; n < 2; ++n) y[bj][n] = acc[ai][bj][m][n] * rstd * gv[bj][n];
            if (ROPE) {
                const bool z = fq == 0;
#pragma unroll
                for (int n = 0; n < 2; ++n) { f32x4 c = cb[q & 1][n], sn = cb[q & 1][2 + n];
#pragma unroll
                    for (int i = 0; i < 4; ++i) { c[i] = z ? c[i] : 1.f; sn[i] = z ? sn[i] : 0.f; }
                    const f32x4 x1 = y[0][n], x2 = y[1][n]; y[0][n] = x1 * c - x2 * sn; y[1][n] = x2 * c + x1 * sn; }
            }
            bf16_t* o = dst + (size_t)row * pitch + wc * 64 + 16 * fq;
#pragma unroll
            for (int bj = 0; bj < 2; ++bj) { u32x4 w; w.x = cvt_pk_bf16(y[bj][0][0], y[bj][0][1]); w.y = cvt_pk_bf16(y[bj][0][2], y[bj][0][3]); w.z = cvt_pk_bf16(y[bj][1][0], y[bj][1][1]); w.w = cvt_pk_bf16(y[bj][1][2], y[bj][1][3]);
                *(u32x4*)(o + 8 * bj) = w; }
        }
#undef IP_CS
    }
    __device__ __forceinline__ void operator()(const f32x4 (&acc)[2][2][4][2], const Unit& u, int wr, int wc, int fr, int fq) const {
        asm volatile("" : "+v"(fr), "+v"(fq));
        const int pn = u.pn; const int row0 = u.t * BM + wr * 64 + fr;
        const float* rsp = (const float*)(wsb + WS_RSX) + (pn >= 9 ? M : 0) + row0;
        if (pn < 4 || pn == 8 || pn == 9) {
            const float* gp = (const float*)(wsb + WS_CTL + 4096) + 64 * (pn < 2 ? 0 : pn < 4 ? 1 : pn == 8 ? 2 : 3);
            const float sc = (pn < 2 || pn == 8) ? C2 : 1.0f;
            const size_t doff = pn < 2 ? WS_QB + (size_t)pn * 512 : pn < 4 ? WS_KB + (size_t)(pn - 2) * 512 : pn == 8 ? WS_MQB : WS_MEMK;
            bf16_t* dst = (bf16_t*)(wsb + doff); const int pitch = pn < 4 ? 512 : 256;
            if (pn < 4) normed<true>(acc, gp, sc, dst, pitch, row0, wc, fq, rsp); else normed<false>(acc, gp, sc, dst, pitch, row0, wc, fq, rsp);
        } else {
            const bool act = (pn == 6 || pn == 7);
            const size_t doff = pn < 6 ? WS_VB + (size_t)(pn - 4) * 512 : pn == 6 ? WS_UB : pn == 7 ? WS_VGB : WS_MEMV;
            bf16_t* dst = (bf16_t*)(wsb + doff); const int pitch = pn < 6 ? 512 : 256;
            float rsv[8];
#pragma unroll
            for (int q = 0; q < 8; ++q) rsv[q] = rsp[(q >> 2) * HALF + (q & 3) * 16];
#pragma unroll
            for (int ai = 0; ai < 2; ++ai)
#pragma unroll
                for (int m = 0; m < 4; ++m) {
                    bf16_t* o = dst + (size_t)(row0 + ai * HALF + m * 16) * pitch + wc * 32 + 8 * fq;
#pragma unroll
                    for (int bj = 0; bj < 2; ++bj) { f32x4 v0 = acc[ai][bj][m][0] * rsv[ai * 4 + m], v1 = acc[ai][bj][m][1] * rsv[ai * 4 + m];
                        if (act) {
#pragma unroll
                            for (int i = 0; i < 4; ++i) { v0[i] = gelu_tanh(v0[i]); v1[i] = gelu_tanh(v1[i]); } }
                        u32x4 w; w.x = cvt_pk_bf16(v0[0], v0[1]); w.y = cvt_pk_bf16(v0[2], v0[3]); w.z = cvt_pk_bf16(v1[0], v1[1]); w.w = cvt_pk_bf16(v1[2], v1[3]);
                        *(u32x4*)(o + bj * HALF) = w; }
                }
        }
    }
};
struct InProjSched {
    const char* XNb; const char* MEMNb; const char* B; int G, c;
    __device__ __forceinline__ bool next(int i, Unit& u) const {
        constexpr int N1 = (M / 256) * 9, N2 = (MM / 256) * 2;
        const int per = G >> 3; const int L = (i * 8 + (c & 7)) * per + (c >> 3); if (L >= N1 + N2) return false;
        int pm, pn; const char* a;
        if (L < N1) { pm = L / 9; pn = L % 9; a = XNb; } else { const int j = L - N1; pm = j >> 1; pn = 9 + (j & 1); a = MEMNb; }
        u.a = a + (size_t)pm * (BM * KD * 2); u.b = B + (size_t)pn * (BM * KD * 2); u.t = pm; u.pn = pn; u.e = 0; u.mt = pm; return true;
    }
    __device__ __forceinline__ unsigned arow(const Unit&, int) const { return 0u; }
    __device__ __forceinline__ int araw(const Unit&, int) const { return 0; }
    __device__ __forceinline__ unsigned afin(int) const { return 0u; }
    __device__ __forceinline__ void pfg_issue(const Unit&, int, LAS unsigned*) const {}
    __device__ __forceinline__ int pfg_read(LAS const unsigned*, int, int, int) const { return 0; }
};
}

namespace attn_body {
typedef unsigned short bf16;
using bf16x8=__attribute__((ext_vector_type(8)))short;
using s16x4=__attribute__((ext_vector_type(4)))short;
using f32x16=__attribute__((ext_vector_type(16)))float;
using u32x4=__attribute__((ext_vector_type(4)))unsigned;
using f32x4_t=__attribute__((ext_vector_type(4)))float;
constexpr int D=64;
constexpr int NW=8,QBLK=32,QB=QBLK*NW,KVBLK=64;
__device__ __forceinline__ int crow(int r,int hi){return (r&3)+8*(r>>2)+4*hi;}
#define SBAR() __builtin_amdgcn_sched_barrier(0)
__device__ __forceinline__ void cmask(f32x16&p0,f32x16&p1,int jb,int qrel,int hi){
  const float NEG=-INFINITY; const int lim=qrel-(64*jb+4*hi);
  #pragma unroll
  for(int r=0;r<16;++r){const int kc=(r&3)+8*(r>>2); if(kc>lim)p0[r]=NEG; if(kc+32>lim)p1[r]=NEG;}
}

constexpr int NSLOT=3, SLOTB=8192;
constexpr int LDS_K=0, LDS_V=NSLOT*SLOTB, LDS_WS=2*NSLOT*SLOTB, LDS_OST=LDS_WS+NW*64*4, LDS_BYTES=LDS_OST+NW*4096;
constexpr float C2=0.125f*1.4426950408889634f;
__device__ __forceinline__ void glds16(const void*gsrc,unsigned lds_dst){unsigned keep;
  asm volatile("s_mov_b32 %0, m0\n\ts_mov_b32 m0, %2\n\ts_nop 0\n\tglobal_load_lds_dwordx4 %1, off\n\ts_mov_b32 m0, %0":"=&s"(keep):"v"(gsrc),"s"(lds_dst):"memory");}
__device__ __forceinline__ float max3f(float a,float b,float c){float r;asm("v_max3_f32 %0, %1, %2, %3":"=v"(r):"v"(a),"v"(b),"v"(c));return r;}
__device__ __forceinline__ float max2f(float a,float b){float r;asm("v_max_f32_e32 %0, %1, %2":"=v"(r):"v"(a),"v"(b));return r;}
__device__ __forceinline__ float fadd_s(float a,float b){float r;asm("v_add_f32_e32 %0, %1, %2":"=v"(r):"v"(a),"v"(b));return r;}
__device__ __forceinline__ float fsub_s(float a,float b){float r;asm("v_sub_f32_e32 %0, %1, %2":"=v"(r):"v"(a),"v"(b));return r;}
typedef float f32x2_t __attribute__((ext_vector_type(2))); typedef __bf16 bf16x2_t __attribute__((ext_vector_type(2)));
__device__ __forceinline__ unsigned cvtpk_s(float lo,float hi){f32x2_t v={lo,hi};bf16x2_t b=__builtin_convertvector(v,bf16x2_t);return __builtin_bit_cast(unsigned,b);}
#define WAIT_BAR(N) asm volatile("s_waitcnt vmcnt(" #N ") lgkmcnt(0)\n\ts_barrier":::"memory")

__device__ __forceinline__ void qkt(f32x16&p0,f32x16&p1,const char*Kslot,const bf16x8*qr,const f32x16&negm,int r32,int hi){
  const char*kb=Kslot+hi*1024+r32*16;
  #pragma unroll
  for(int d0=0;d0<4;++d0){
    const bf16x8 b0=*reinterpret_cast<const bf16x8*>(kb+d0*2048);
    const bf16x8 b1=*reinterpret_cast<const bf16x8*>(kb+d0*2048+512);
    if(d0==0){p0=__builtin_amdgcn_mfma_f32_32x32x16_bf16(b0,qr[0],negm,0,0,0);p1=__builtin_amdgcn_mfma_f32_32x32x16_bf16(b1,qr[0],negm,0,0,0);}
    else{p0=__builtin_amdgcn_mfma_f32_32x32x16_bf16(b0,qr[d0],p0,0,0,0);p1=__builtin_amdgcn_mfma_f32_32x32x16_bf16(b1,qr[d0],p1,0,0,0);}}
}
typedef __attribute__((address_space(3))) const char* lds_cptr;
typedef short v4i16_t __attribute__((ext_vector_type(4)));
__device__ __forceinline__ void kload8(bf16x8*kf,lds_cptr kp){
  kf[0]=*(const __attribute__((address_space(3))) bf16x8*)(kp);      kf[1]=*(const __attribute__((address_space(3))) bf16x8*)(kp+512);
  kf[2]=*(const __attribute__((address_space(3))) bf16x8*)(kp+2048); kf[3]=*(const __attribute__((address_space(3))) bf16x8*)(kp+2560);
  kf[4]=*(const __attribute__((address_space(3))) bf16x8*)(kp+4096); kf[5]=*(const __attribute__((address_space(3))) bf16x8*)(kp+4608);
  kf[6]=*(const __attribute__((address_space(3))) bf16x8*)(kp+6144); kf[7]=*(const __attribute__((address_space(3))) bf16x8*)(kp+6656);
}
__device__ __forceinline__ void kload2(bf16x8*kf,lds_cptr kp,int j){ kf[2*j]=*(const __attribute__((address_space(3))) bf16x8*)(kp+j*2048); kf[2*j+1]=*(const __attribute__((address_space(3))) bf16x8*)(kp+j*2048+512); }
__device__ __forceinline__ s16x4 vtr(lds_cptr p){ return __builtin_bit_cast(s16x4,__builtin_amdgcn_ds_read_tr16_b64_v4i16((__attribute__((address_space(3))) v4i16_t*)p)); }
__device__ __forceinline__ float rowmax(const f32x16&p0,const f32x16&p1){
  float a=max3f(p0[0],p0[1],p1[0]),b=max3f(p0[2],p0[3],p1[1]);a=max3f(a,p1[2],p1[3]);
  #pragma unroll
  for(int r=4;r<16;r+=4){a=max3f(a,p0[r],p0[r+1]);b=max3f(b,p0[r+2],p0[r+3]);a=max3f(a,p1[r],p1[r+1]);b=max3f(b,p1[r+2],p1[r+3]);}
  const float m=max2f(a,b);
  auto rr=__builtin_amdgcn_permlane32_swap(__float_as_uint(m),__float_as_uint(m),false,false);
  return max2f(__uint_as_float(rr[0]),__uint_as_float(rr[1]));
}
__device__ __forceinline__ void pv(f32x16*o,int vb,bf16x8 pa0,bf16x8 pa1,bf16x8 pa2,bf16x8 pa3){
  #pragma unroll
  for(int d0=0;d0<2;++d0){s16x4 lo[4],hi[4];
    #pragma unroll
    for(int ks=0;ks<4;++ks){
      asm volatile("ds_read_b64_tr_b16 %0,%1 offset:%c2":"=&v"(lo[ks]):"v"(vb),"i"(d0*4096+ks*1024):"memory");
      asm volatile("ds_read_b64_tr_b16 %0,%1 offset:%c2":"=&v"(hi[ks]):"v"(vb),"i"(d0*4096+ks*1024+512):"memory");}
    asm volatile("s_waitcnt lgkmcnt(0)":::"memory");SBAR();
    #define PK(k) (bf16x8){lo[k][0],lo[k][1],lo[k][2],lo[k][3],hi[k][0],hi[k][1],hi[k][2],hi[k][3]}
    o[d0]=__builtin_amdgcn_mfma_f32_32x32x16_bf16(pa0,PK(0),o[d0],0,0,0);
    o[d0]=__builtin_amdgcn_mfma_f32_32x32x16_bf16(pa1,PK(1),o[d0],0,0,0);
    o[d0]=__builtin_amdgcn_mfma_f32_32x32x16_bf16(pa2,PK(2),o[d0],0,0,0);
    o[d0]=__builtin_amdgcn_mfma_f32_32x32x16_bf16(pa3,PK(3),o[d0],0,0,0);
    #undef PK
  }
}

#ifndef ATTN_STORE16
#define ATTN_STORE16(p,v) (*(u32x4*)(p)=(v))
#endif
template<int THRL,int LDQ,int LDK,int LDV,int LDO,bool CAUSAL> __device__ __forceinline__ void attn_unit(const bf16*Qu,const bf16*__restrict__ Kh,const bf16*__restrict__ Vh,bf16*Ou,const int NT,char*shm){
  const int tid=threadIdx.x,lane=tid&63,r32=lane&31,hi=lane>>5; const int wid=__builtin_amdgcn_readfirstlane(tid>>6);
  const bf16*Qw=Qu+(long)(wid*QBLK)*LDQ;
  const unsigned lds0=(unsigned)(uintptr_t)shm;
  float*wsf=(float*)(shm+LDS_WS)+wid*64;
  const bf16*ksrc=Kh+(long)lane*LDK+wid*8;
  const bf16*vsrc=Vh+(long)(16*(wid&3)+(lane>>2))*LDV+(wid>>2)*32+(lane&3)*8;
  const unsigned kdst=lds0+LDS_K+wid*1024, vdst=lds0+LDS_V+wid*1024;
  #define DMA_K(t,slot) glds16(ksrc+(long)(t)*KVBLK*LDK,(unsigned)__builtin_amdgcn_readfirstlane(kdst+(slot)))
  #define DMA_V(t,slot) glds16(vsrc+(long)(t)*KVBLK*LDV,(unsigned)__builtin_amdgcn_readfirstlane(vdst+(slot)))
  const int vb0=(int)(lds0+LDS_V)+((lane>>4)&1)*32+(lane&3)*8+(4*hi+((lane&15)>>2))*64;
  const char*Kbase=shm+LDS_K; bf16x8 kf[8];
  const lds_cptr shm3=(lds_cptr)shm; const lds_cptr kp0=shm3+LDS_K+hi*1024+r32*16; const lds_cptr vp0=shm3+LDS_V+((lane>>4)&1)*32+(lane&3)*8+(4*hi+((lane&15)>>2))*64;
  DMA_K(0,0);DMA_V(0,0);DMA_K(1,SLOTB);
  bf16x8 qr[4];
  #pragma unroll
  for(int d0=0;d0<4;++d0)qr[d0]=*reinterpret_cast<const bf16x8*>(&Qw[(long)r32*LDQ+d0*16+hi*8]);
  float mhat=0.f,l_reg=0.f;f32x16 o[2];o[0]=f32x16{};o[1]=f32x16{};float nms=0.f; const f32x16 zero16=f32x16{};
  const int qrel=wid*QBLK+r32;
  #define CMASK(P0,P1,t) do{ if(CAUSAL){int jb_=(t)-(NT-4); if(jb_>=0)cmask(P0,P1,jb_,qrel,hi);} }while(0)
  bool resc=false;
  #define START(P0,P1) do{ const float rm=rowmax(P0,P1); resc=false; \
    { const float dl=rm; mhat=fadd_s(mhat,dl); \
      _Pragma("unroll") for(int r=0;r<16;++r){P0[r]=fsub_s(P0[r],dl);P1[r]=fsub_s(P1[r],dl);} \
      nms=-mhat; } \
    _Pragma("unroll") for(int r=0;r<16;++r)P0[r]=__builtin_amdgcn_exp2f(P0[r]); }while(0)
  #define RESC() do{ if(resc){ asm volatile("s_waitcnt lgkmcnt(0)":::"memory"); \
      _Pragma("unroll") for(int d_=0;d_<2;++d_) _Pragma("unroll") for(int r=0;r<16;++r)o[d_][r]*=wsf[crow(r,hi)]; } }while(0)
  f32x16 pA0,pA1,pB0,pB1;
  int sl_prev=0,sl_cur=0,sl_next=SLOTB;
  #define ROT() do{sl_prev=sl_cur;sl_cur=sl_next;sl_next=(sl_next==(NSLOT-1)*SLOTB)?0:sl_next+SLOTB;}while(0)
  DMA_K(2,2*SLOTB);
  WAIT_BAR(3);
  qkt(pA0,pA1,Kbase,qr,zero16,r32,hi);asm volatile("s_nop 15\n\ts_nop 7":"+v"(pA0),"+v"(pA1));CMASK(pA0,pA1,0);
  START(pA0,pA1);
  _Pragma("unroll") for(int r=0;r<16;++r)pA1[r]=__builtin_amdgcn_exp2f(pA1[r]);
  WAIT_BAR(0);
  DMA_K(3,0);DMA_V(1,SLOTB);
  ROT();
  kload8(kf,kp0+sl_cur);
  WAIT_BAR(2);
  s16x4 vlo[8],vhi[8]; u32x4 pw0,pw1,pw2,pw3;
  #define PKW(P,B) cvtpk_s(P[B],P[B+1])
  #define PAF(k) __builtin_bit_cast(bf16x8,pw##k)
  #define VFR(i) (bf16x8){vlo[i][0],vlo[i][1],vlo[i][2],vlo[i][3],vhi[i][0],vhi[i][1],vhi[i][2],vhi[i][3]}
  #define PIN(x) asm volatile("":"+v"(x))
  #define MX3(a,b,c) __builtin_fmaxf(__builtin_fmaxf((a),(b)),(c))
  #define GAPA(MF,A0,A1,A2,A3,W0,W1,PW) do{ MF; sacc+=A0; sacc+=A1; sacc+=A2; sacc+=A3; PIN(sacc); W0; W1; PIN(PW); SBAR(); }while(0)
  #define EX(v) __builtin_amdgcn_exp2f(v)
  #define GAPB(MF,X,B) do{ MF; X[B]=EX(X[B]); X[B+1]=EX(X[B+1]); X[B+2]=EX(X[B+2]); X[B+3]=EX(X[B+3]); PIN(X); SBAR(); }while(0)
  #define VRD(i) do{ vlo[i]=vtr(vp_+(((i)>>2)*4096+((i)&3)*1024)); vhi[i]=vtr(vp_+(((i)>>2)*4096+((i)&3)*1024+512)); }while(0)
  #define KRD(G,j) do{ if(G){ kload2(kf,kp0+sl_next,j); SBAR(); } }while(0)
  #define STEP(C0,C1,P0,P1,t,GK,GV,GL) do{ SBAR(); \
    const lds_cptr vp_=vp0+sl_prev; \
    VRD(0); SBAR(); float sacc=(P0[0]+P0[1]); \
    GAPA(C0=__builtin_amdgcn_mfma_f32_32x32x16_bf16(kf[0],qr[0],zero16,0,0,0), P0[2],P0[3],P0[4],P0[5],     pw0[0]=PKW(P0,0), pw0[1]=PKW(P0,2), pw0); \
    VRD(4); SBAR(); GAPA(C1=__builtin_amdgcn_mfma_f32_32x32x16_bf16(kf[1],qr[0],zero16,0,0,0), P0[6],P0[7],P0[8],P0[9],     pw0[2]=PKW(P0,4), pw0[3]=PKW(P0,6), pw0); \
    VRD(1); SBAR(); GAPA(C0=__builtin_amdgcn_mfma_f32_32x32x16_bf16(kf[2],qr[1],C0,0,0,0),   P0[10],P0[11],P0[12],P0[13], pw1[0]=PKW(P0,8), pw1[1]=PKW(P0,10), pw1); \
    VRD(5); SBAR(); GAPA(C1=__builtin_amdgcn_mfma_f32_32x32x16_bf16(kf[3],qr[1],C1,0,0,0),   P0[14],P0[15],P1[0],P1[1],   pw1[2]=PKW(P0,12),pw1[3]=PKW(P0,14), pw1); \
    VRD(2); SBAR(); GAPA(C0=__builtin_amdgcn_mfma_f32_32x32x16_bf16(kf[4],qr[2],C0,0,0,0),   P1[2],P1[3],P1[4],P1[5],     pw2[0]=PKW(P1,0), pw2[1]=PKW(P1,2), pw2); \
    VRD(6); SBAR(); GAPA(C1=__builtin_amdgcn_mfma_f32_32x32x16_bf16(kf[5],qr[2],C1,0,0,0),   P1[6],P1[7],P1[8],P1[9],     pw2[2]=PKW(P1,4), pw2[3]=PKW(P1,6), pw2); \
    VRD(3); SBAR(); GAPA(C0=__builtin_amdgcn_mfma_f32_32x32x16_bf16(kf[6],qr[3],C0,0,0,0),   P1[10],P1[11],P1[12],P1[13], pw3[0]=PKW(P1,8), pw3[1]=PKW(P1,10), pw3); \
    VRD(7); SBAR(); GAPA(C1=__builtin_amdgcn_mfma_f32_32x32x16_bf16(kf[7],qr[3],C1,0,0,0),   P1[14],P1[15],0.f,0.f,       pw3[2]=PKW(P1,12),pw3[3]=PKW(P1,14), pw3); \
    l_reg+=sacc; \
    _Pragma("unroll") for(int r=0;r<16;++r){C0[r]+=nms;C1[r]+=nms;} \
    if(GK){DMA_K((t)+3,sl_cur);} if(GV){DMA_V((t)+1,sl_next);} \
    CMASK(C0,C1,t); \
    { float a=MX3(C0[0],C0[1],C1[0]),b=MX3(C0[2],C0[3],C1[1]); a=MX3(a,C1[2],C1[3]); \
      _Pragma("unroll") for(int r=4;r<16;r+=4){a=MX3(a,C0[r],C0[r+1]);b=MX3(b,C0[r+2],C0[r+3]);a=MX3(a,C1[r],C1[r+1]);b=MX3(b,C1[r+2],C1[r+3]);} \
      float rm=__builtin_fmaxf(a,b); { auto rr=__builtin_amdgcn_permlane32_swap(__float_as_uint(rm),__float_as_uint(rm),false,false); rm=__builtin_fmaxf(__uint_as_float(rr[0]),__uint_as_float(rr[1])); } \
      resc=false; \
      if(__builtin_expect(__any(rm>(float)THRL),0)){ const float dl=__builtin_fmaxf(rm,0.f); mhat+=dl; \
        _Pragma("unroll") for(int r=0;r<16;++r){C0[r]-=dl;C1[r]-=dl;} \
        nms=-mhat; \
        const float f=__builtin_amdgcn_exp2f(-dl); l_reg*=f; if(hi==0)wsf[r32]=f; resc=true; } } \
    SBAR(); \
    GAPB(o[0]=__builtin_amdgcn_mfma_f32_32x32x16_bf16(PAF(0),VFR(0),o[0],0,0,0), C0,0); \
    GAPB(o[1]=__builtin_amdgcn_mfma_f32_32x32x16_bf16(PAF(0),VFR(4),o[1],0,0,0), C0,4); \
    KRD(GL,0); GAPB(o[0]=__builtin_amdgcn_mfma_f32_32x32x16_bf16(PAF(1),VFR(1),o[0],0,0,0), C0,8); \
    KRD(GL,1); GAPB(o[1]=__builtin_amdgcn_mfma_f32_32x32x16_bf16(PAF(1),VFR(5),o[1],0,0,0), C0,12); \
    KRD(GL,2); GAPB(o[0]=__builtin_amdgcn_mfma_f32_32x32x16_bf16(PAF(2),VFR(2),o[0],0,0,0), C1,0); \
    KRD(GL,3); GAPB(o[1]=__builtin_amdgcn_mfma_f32_32x32x16_bf16(PAF(2),VFR(6),o[1],0,0,0), C1,4); \
    GAPB(o[0]=__builtin_amdgcn_mfma_f32_32x32x16_bf16(PAF(3),VFR(3),o[0],0,0,0), C1,8); \
    GAPB(o[1]=__builtin_amdgcn_mfma_f32_32x32x16_bf16(PAF(3),VFR(7),o[1],0,0,0), C1,12); \
    }while(0)
  int t=1;
  #undef CMASK
  #define CMASK(P0,P1,t) do{}while(0)
  for(;t+5<NT;t+=2){
    STEP(pB0,pB1,pA0,pA1,t,true,true,true);     WAIT_BAR(2); RESC(); ROT();
    STEP(pA0,pA1,pB0,pB1,t+1,true,true,true);   WAIT_BAR(2); RESC(); ROT();
  }
  #undef CMASK
  #define CMASK(P0,P1,t) do{ if(CAUSAL){int jb_=(t)-(NT-4); if(jb_>=0)cmask(P0,P1,jb_,qrel,hi);} }while(0)
  #define ENDW(tt) do{ if((tt)+3<NT){WAIT_BAR(2);} else if((tt)+2<NT){WAIT_BAR(1);} else {WAIT_BAR(0);} }while(0)
  for(;t+1<NT;t+=2){
    STEP(pB0,pB1,pA0,pA1,t,(t+3<NT),(t+1<NT),(t+1<NT));       ENDW(t);   RESC(); ROT();
    STEP(pA0,pA1,pB0,pB1,t+1,(t+4<NT),(t+2<NT),(t+2<NT));     ENDW(t+1); RESC(); ROT();
  }
  STEP(pB0,pB1,pA0,pA1,NT-1,false,false,false); RESC();
  { float sacc=pB0[0]+pB0[1]; _Pragma("unroll") for(int r=2;r<16;++r)sacc+=pB0[r]; _Pragma("unroll") for(int r=0;r<16;++r)sacc+=pB1[r]; l_reg+=sacc;
    pw0=(u32x4){PKW(pB0,0),PKW(pB0,2),PKW(pB0,4),PKW(pB0,6)};pw1=(u32x4){PKW(pB0,8),PKW(pB0,10),PKW(pB0,12),PKW(pB0,14)};pw2=(u32x4){PKW(pB1,0),PKW(pB1,2),PKW(pB1,4),PKW(pB1,6)};pw3=(u32x4){PKW(pB1,8),PKW(pB1,10),PKW(pB1,12),PKW(pB1,14)};
    SBAR(); pv(o,vb0+sl_cur,PAF(0),PAF(1),PAF(2),PAF(3)); }
  #undef PKW
  #undef PAF
  #undef VFR
  #undef PIN
  #undef MX3
  #undef GAPA
  #undef GAPB
  #undef EX
  #undef VRD
  #undef KRD
  #undef STEP
  #undef ENDW
  {auto rr=__builtin_amdgcn_permlane32_swap(__float_as_uint(l_reg),__float_as_uint(l_reg),false,false);l_reg=__uint_as_float(rr[0])+__uint_as_float(rr[1]);}
  if(hi==0)wsf[32+r32]=l_reg;asm volatile("s_waitcnt lgkmcnt(0)":::"memory");
  float rli[16];
  #pragma unroll
  for(int r=0;r<16;++r)rli[r]=__builtin_amdgcn_rcpf(wsf[32+crow(r,hi)]);
  bf16*Ow=Ou+(long)(wid*QBLK)*LDO;
  { bf16*stg=(bf16*)(shm+LDS_OST)+wid*2048;
    unsigned sbase=lds0+LDS_OST+(unsigned)wid*4096u+(unsigned)hi*512u+(unsigned)r32*2u; asm volatile("":"+v"(sbase));
    typedef __attribute__((address_space(3))) bf16* lds_hptr;
    #pragma unroll
    for(int r=0;r<16;++r){
      #pragma unroll
      for(int d0=0;d0<2;++d0)*(lds_hptr)(sbase+(unsigned)(((r&3)+8*(r>>2))*128+d0*64))=(bf16)(cvtpk_s(o[d0][r]*rli[r],0.f)&0xffffu);}
    asm volatile("s_waitcnt lgkmcnt(0)":::"memory");
    #pragma unroll
    for(int i=0;i<4;++i){const int row=i*8+(lane>>3),ch=lane&7; const u32x4 v=*(const u32x4*)(stg+row*64+ch*8); ATTN_STORE16(Ow+(long)row*LDO+ch*8,v);} }
  asm volatile("s_waitcnt lgkmcnt(0)\n\ts_barrier":::"memory");
  #undef DMA_K
  #undef DMA_V
  #undef CMASK
  #undef START
  #undef RESC
  #undef ROT
}

constexpr int V2_KS=8192, V2_VS=16384, V2_VOFF=3*V2_KS, V2_WS=V2_VOFF+4*V2_VS, V2_OST=V2_WS+NW*64*4, V2_BYTES=V2_OST+NW*8192;
template<int THRL,int LDQ,int LDK,int LDV,int LDO,bool CAUSAL,int MODE=0> __device__ __forceinline__ void attn_unit_v128(const bf16*Qu,const bf16*__restrict__ Kh,const bf16*__restrict__ Vh,bf16*Ou,const int qb,char*shm,const int nt_probe=0,const float lam=0.f,const float*gsub=nullptr,const int pmode=0){
  const int tid=threadIdx.x,lane=tid&63,r32=lane&31,hi=lane>>5; const int wid=__builtin_amdgcn_readfirstlane(tid>>6);
  const int NT=nt_probe?nt_probe:(CAUSAL?(qb*QB+QB)/KVBLK:4);
  const bool late=wid>=4&&pmode==4;
  if(wid>=4)__builtin_amdgcn_s_setprio(1);
  const bf16*Qw=Qu+(long)(wid*QBLK)*LDQ;
  const unsigned lds0=(unsigned)(uintptr_t)shm;
  float*wsf=(float*)(shm+V2_WS)+wid*64;
  const bf16*ksrc=Kh+(long)lane*LDK+wid*8;
  const bf16*vsrc=Vh+(long)(16*(wid&3)+(lane>>2))*LDV+(wid>>2)*32+(lane&3)*8;
  const unsigned pdst=lds0+wid*1024;
  #define DMA3(t,ksl,vsl) do{ const unsigned dk_=(unsigned)__builtin_amdgcn_readfirstlane(pdst+(ksl)*V2_KS), dv_=(unsigned)__builtin_amdgcn_readfirstlane(pdst+V2_VOFF+(vsl)*V2_VS); \
      glds16(ksrc+(long)(t)*KVBLK*LDK,dk_); glds16(vsrc+(long)(t)*KVBLK*LDV,dv_); glds16(vsrc+64+(long)(t)*KVBLK*LDV,dv_+8192u); }while(0)
  bf16x8 qr[4];
  #pragma unroll
  for(int d0=0;d0<4;++d0)qr[d0]=*reinterpret_cast<const bf16x8*>(&Qw[(long)r32*LDQ+d0*16+hi*8]);
  DMA3(0,0,0); DMA3(1,1,1);
  asm volatile("":"+v"(qr[0]),"+v"(qr[1]),"+v"(qr[2]),"+v"(qr[3]));
  const int vbl=(int)(lds0+V2_VOFF)+((lane>>4)&1)*32+(lane&3)*8+(4*hi+((lane&15)>>2))*64;
  float mhat=0.f,l_reg=0.f; f32x16 o[4]; o[0]=f32x16{};o[1]=f32x16{};o[2]=f32x16{};o[3]=f32x16{};
  f32x16 negm=f32x16{};
  const int qrel=wid*QBLK+r32;
  s16x4 vlA[4],vhA[4],vlB[4],vhB[4];
  #define VREADS(LO,HI,b) do{ _Pragma("unroll") for(int ks=0;ks<4;++ks){ \
      asm volatile("ds_read_b64_tr_b16 %0,%1 offset:%c2":"=&v"(LO[ks]):"v"(vb_),"i"((b)*4096+ks*1024):"memory"); \
      asm volatile("ds_read_b64_tr_b16 %0,%1 offset:%c2":"=&v"(HI[ks]):"v"(vb_),"i"((b)*4096+ks*1024+512):"memory");} }while(0)
  #define VPK(LO,HI,k) (bf16x8){LO[k][0],LO[k][1],LO[k][2],LO[k][3],HI[k][0],HI[k][1],HI[k][2],HI[k][3]}
  #define PVBLK(O,LO,HI,P0,P1,P2,P3) do{ O=__builtin_amdgcn_mfma_f32_32x32x16_bf16(__builtin_bit_cast(bf16x8,P0),VPK(LO,HI,0),O,0,0,0); O=__builtin_amdgcn_mfma_f32_32x32x16_bf16(__builtin_bit_cast(bf16x8,P1),VPK(LO,HI,1),O,0,0,0); \
      O=__builtin_amdgcn_mfma_f32_32x32x16_bf16(__builtin_bit_cast(bf16x8,P2),VPK(LO,HI,2),O,0,0,0); O=__builtin_amdgcn_mfma_f32_32x32x16_bf16(__builtin_bit_cast(bf16x8,P3),VPK(LO,HI,3),O,0,0,0); }while(0)
  #define PV_ALL(VB,P0,P1,P2,P3) do{ const int vb_=(VB); SBAR(); VREADS(vlA,vhA,0); VREADS(vlB,vhB,1); asm volatile("s_waitcnt lgkmcnt(8)":::"memory"); SBAR(); PVBLK(o[0],vlA,vhA,P0,P1,P2,P3); \
      SBAR(); VREADS(vlA,vhA,2); asm volatile("s_waitcnt lgkmcnt(8)":::"memory"); SBAR(); PVBLK(o[1],vlB,vhB,P0,P1,P2,P3); \
      SBAR(); VREADS(vlB,vhB,3); asm volatile("s_waitcnt lgkmcnt(8)":::"memory"); SBAR(); PVBLK(o[2],vlA,vhA,P0,P1,P2,P3); \
      asm volatile("s_waitcnt lgkmcnt(0)":::"memory"); SBAR(); PVBLK(o[3],vlB,vhB,P0,P1,P2,P3); SBAR(); }while(0)
  u32x4 q0=(u32x4){0u,0u,0u,0u},q1=q0,q2=q0,q3=q0; int vbP=0; bool pend=false;
  int ks=0,vs=0;
  for(int t=0;t<NT;++t){
    if(t+1<NT){WAIT_BAR(3);}else{WAIT_BAR(0);}
    if(t+2<NT&&pmode!=1){ DMA3(t+2,(ks==0)?2:ks-1,(vs+2)&3); }
    if(late&&pend){ PV_ALL(vbP,q0,q1,q2,q3); pend=false; }
    const int jb=t-(NT-4);
    const bool active=(!CAUSAL||jb<=0||64*jb<=32*wid+31)&&pmode!=2;
    if(active){
      f32x16 C0,C1;
      {
        const char*kb=shm+ks*V2_KS+hi*1024+r32*16; bf16x8 kf[8];
        #pragma unroll
        for(int d0=0;d0<4;++d0){kf[2*d0]=*reinterpret_cast<const bf16x8*>(kb+d0*2048);kf[2*d0+1]=*reinterpret_cast<const bf16x8*>(kb+d0*2048+512);}
        SBAR();
        C0=__builtin_amdgcn_mfma_f32_32x32x16_bf16(kf[0],qr[0],negm,0,0,0);C1=__builtin_amdgcn_mfma_f32_32x32x16_bf16(kf[1],qr[0],negm,0,0,0);
        #pragma unroll
        for(int d0=1;d0<4;++d0){C0=__builtin_amdgcn_mfma_f32_32x32x16_bf16(kf[2*d0],qr[d0],C0,0,0,0);C1=__builtin_amdgcn_mfma_f32_32x32x16_bf16(kf[2*d0+1],qr[d0],C1,0,0,0);}
        SBAR(); }
      if(CAUSAL&&jb>=0)cmask(C0,C1,jb,qrel,hi);
      float a=__builtin_fmaxf(__builtin_fmaxf(C0[0],C0[1]),C1[0]),b=__builtin_fmaxf(__builtin_fmaxf(C0[2],C0[3]),C1[1]); a=__builtin_fmaxf(__builtin_fmaxf(a,C1[2]),C1[3]);
      #pragma unroll
      for(int r=4;r<16;r+=4){a=__builtin_fmaxf(__builtin_fmaxf(a,C0[r]),C0[r+1]);b=__builtin_fmaxf(__builtin_fmaxf(b,C0[r+2]),C0[r+3]);a=__builtin_fmaxf(__builtin_fmaxf(a,C1[r]),C1[r+1]);b=__builtin_fmaxf(__builtin_fmaxf(b,C1[r+2]),C1[r+3]);}
      float rm=__builtin_fmaxf(a,b); { auto rr=__builtin_amdgcn_permlane32_swap(__float_as_uint(rm),__float_as_uint(rm),false,false); rm=__builtin_fmaxf(__uint_as_float(rr[0]),__uint_as_float(rr[1])); }
      bool resc=false;
      if(t==0){ mhat+=rm; _Pragma("unroll") for(int r=0;r<16;++r){C0[r]-=rm;C1[r]-=rm;negm[r]=-mhat;} }
      else if(__builtin_expect(__any(rm>(float)THRL),0)){ const float dl=__builtin_fmaxf(rm,0.f); mhat+=dl;
        _Pragma("unroll") for(int r=0;r<16;++r){C0[r]-=dl;C1[r]-=dl;negm[r]=-mhat;}
        const float f=__builtin_amdgcn_exp2f(-dl); l_reg*=f; if(hi==0)wsf[r32]=f; resc=true; }
      #pragma unroll
      for(int r=0;r<16;++r){C0[r]=__builtin_amdgcn_exp2f(C0[r]);C1[r]=__builtin_amdgcn_exp2f(C1[r]);}
      float sacc=0.f;
      #pragma unroll
      for(int r=0;r<16;++r)sacc+=C0[r]+C1[r];
      l_reg+=sacc;
      u32x4 pw0,pw1,pw2,pw3;
      pw0=(u32x4){cvtpk_s(C0[0],C0[1]),cvtpk_s(C0[2],C0[3]),cvtpk_s(C0[4],C0[5]),cvtpk_s(C0[6],C0[7])}; pw1=(u32x4){cvtpk_s(C0[8],C0[9]),cvtpk_s(C0[10],C0[11]),cvtpk_s(C0[12],C0[13]),cvtpk_s(C0[14],C0[15])};
      pw2=(u32x4){cvtpk_s(C1[0],C1[1]),cvtpk_s(C1[2],C1[3]),cvtpk_s(C1[4],C1[5]),cvtpk_s(C1[6],C1[7])}; pw3=(u32x4){cvtpk_s(C1[8],C1[9]),cvtpk_s(C1[10],C1[11]),cvtpk_s(C1[12],C1[13]),cvtpk_s(C1[14],C1[15])};
      if(resc){ asm volatile("s_waitcnt lgkmcnt(0)":::"memory");
        #pragma unroll
        for(int d_=0;d_<4;++d_)
          #pragma unroll
          for(int r=0;r<16;++r)o[d_][r]*=wsf[crow(r,hi)]; }
      const int vbc=vbl+vs*V2_VS;
      if(late){ q0=pw0;q1=pw1;q2=pw2;q3=pw3; vbP=vbc; pend=true; }
      else { PV_ALL(vbc,pw0,pw1,pw2,pw3); }
    }
    ks=(ks==2)?0:ks+1; vs=(vs+1)&3;
  }
  if(late&&pend){ PV_ALL(vbP,q0,q1,q2,q3); }
  {auto rr=__builtin_amdgcn_permlane32_swap(__float_as_uint(l_reg),__float_as_uint(l_reg),false,false);l_reg=__uint_as_float(rr[0])+__uint_as_float(rr[1]);}
  if(hi==0)wsf[32+r32]=l_reg;asm volatile("s_waitcnt lgkmcnt(0)":::"memory");
  float rli[16];
  #pragma unroll
  for(int r=0;r<16;++r)rli[r]=__builtin_amdgcn_rcpf(wsf[32+crow(r,hi)]);
  bf16*Ow=Ou+(long)(wid*QBLK)*LDO;
  { unsigned sbase=lds0+V2_OST+(unsigned)wid*8192u+(unsigned)hi*1024u+(unsigned)r32*2u; asm volatile("":"+v"(sbase));
    typedef __attribute__((address_space(3))) bf16* lds_hptr;
    #pragma unroll
    for(int r=0;r<16;++r){
      #pragma unroll
      for(int d0=0;d0<4;++d0){ const lds_hptr ap=(lds_hptr)(sbase+(unsigned)(((r&3)+8*(r>>2))*256+d0*64)); float v=o[d0][r]*rli[r];
        if(MODE==2)v=__uint_as_float(((unsigned)*ap)<<16)-lam*v;
        *ap=(bf16)(cvtpk_s(v,0.f)&0xffffu);} }
    asm volatile("s_waitcnt lgkmcnt(0)":::"memory");
    const bf16*stg=(const bf16*)(shm+V2_OST)+wid*4096;
    if(MODE==0){
      #pragma unroll
      for(int i=0;i<8;++i){const int row=i*4+(lane>>4),ch=lane&15; const u32x4 v=*(const u32x4*)(stg+row*128+ch*8); ATTN_STORE16(Ow+(long)row*LDO+ch*8,v);} }
    if(MODE==2){
      const int ch=lane&15; const f32x4_t g0=*(const f32x4_t*)(gsub+ch*8),g1=*(const f32x4_t*)(gsub+ch*8+4);
      #pragma unroll
      for(int i=0;i<8;++i){const int row=i*4+(lane>>4); const u32x4 v=*(const u32x4*)(stg+row*128+ch*8);
        float a[8];
        #pragma unroll
        for(int j=0;j<4;++j){a[2*j]=__uint_as_float(v[j]<<16);a[2*j+1]=__uint_as_float(v[j]&0xffff0000u);}
        float ss=0.f;
        #pragma unroll
        for(int j=0;j<8;++j)ss+=a[j]*a[j];
        ss+=__shfl_xor(ss,1);ss+=__shfl_xor(ss,2);ss+=__shfl_xor(ss,4);ss+=__shfl_xor(ss,8);
        const float rstd=0.8f*__builtin_amdgcn_rsqf(ss*(1.f/128)+1e-6f);
        u32x4 w; w[0]=cvtpk_s(a[0]*rstd*g0[0],a[1]*rstd*g0[1]); w[1]=cvtpk_s(a[2]*rstd*g0[2],a[3]*rstd*g0[3]); w[2]=cvtpk_s(a[4]*rstd*g1[0],a[5]*rstd*g1[1]); w[3]=cvtpk_s(a[6]*rstd*g1[2],a[7]*rstd*g1[3]);
        ATTN_STORE16(Ow+(long)row*LDO+ch*8,w);} } }
  __builtin_amdgcn_s_setprio(0);
  asm volatile("s_waitcnt lgkmcnt(0)\n\ts_barrier":::"memory");
  #undef DMA3
  #undef VREADS
  #undef VPK
  #undef PVBLK
  #undef PV_ALL
}
constexpr int ATTN_LDS_BYTES=LDS_BYTES;
#undef SBAR
#undef WAIT_BAR
}

#define GAS __attribute__((address_space(1)))
#define XB_TMO      128
#define XB_XCNT(j)  (256  + 64 * (j))
#define XB_XSUB(j)  (1280 + 64 * (j))
#define XB_XGEN(j)  (2304 + 64 * (j))
#define XB_TOP      3328
#define XB_TOPGEN   3392
#define XCD_BAR_WORDS 3456
#define XB_SPIN_CAP (1u << 18)

__device__ __forceinline__ unsigned xb_ld(unsigned* p)              { return __hip_atomic_load(p, __ATOMIC_RELAXED, __HIP_MEMORY_SCOPE_AGENT); }
__device__ __forceinline__ unsigned xb_add(unsigned* p, unsigned v) { return __hip_atomic_fetch_add(p, v, __ATOMIC_RELAXED, __HIP_MEMORY_SCOPE_AGENT); }
__device__ __forceinline__ unsigned xb_xcc_id() { return (unsigned)__builtin_amdgcn_s_getreg((3 << 11) | 20) & 0xFu; }
#define XB_SPIN(cond, bar) do { unsigned _sp = 0; while (cond) { __builtin_amdgcn_s_sleep(1); \
    if ((++_sp & 255u) == 0u) { if (xb_ld(&(bar)[XB_TMO])) break; if (_sp > XB_SPIN_CAP) { atomicAdd(&(bar)[XB_TMO], 1u); break; } } } } while (0)

struct XcdBarrier {
    unsigned* bar; unsigned x;
    volatile LAS unsigned* st;
};

__device__ __forceinline__ XcdBarrier xcd_barrier_post(unsigned* bar, volatile LAS unsigned* st) {
    XcdBarrier b; b.bar = bar; b.x = xb_xcc_id(); b.st = st;
    if (threadIdx.x == 0) (void)xb_add(&bar[XB_XCNT(b.x)], 1u);
    return b;
}
__device__ __forceinline__ void xcd_barrier_complete(unsigned* bar, unsigned x, unsigned& nloc, unsigned& nx) {
    const unsigned G = gridDim.x * gridDim.y * gridDim.z;
    unsigned sum, cnt, mine, sp = 0u;
    for (;;) {
        sum = 0u; cnt = 0u; mine = 0u;
#pragma unroll
        for (unsigned j = 0; j < 16; ++j) { const unsigned c = xb_ld(&bar[XB_XCNT(j)]); sum += c; cnt += (c > 0u) ? 1u : 0u; mine = (j == x) ? c : mine; }
        if (sum == G) break;
        __builtin_amdgcn_s_sleep(1);
        if ((++sp & 255u) == 0u) { if (xb_ld(&bar[XB_TMO])) break; if (sp > XB_SPIN_CAP) { atomicAdd(&bar[XB_TMO], 1u); break; } }
    }
    nloc = mine > 0u ? mine : 1u; nx = cnt > 0u ? cnt : 1u;
}

__device__ __forceinline__ void xcd_barrier(const XcdBarrier& b) {
    asm volatile("s_waitcnt vmcnt(0)" ::: "memory");
    __syncthreads();
    if (threadIdx.x == 0) {
        unsigned* bar = b.bar;
        __builtin_amdgcn_s_waitcnt(0);
        unsigned nloc = b.st[0], nx = b.st[1];
        if (nloc == 0u) { xcd_barrier_complete(bar, b.x, nloc, nx); b.st[0] = nloc; b.st[1] = nx; }
        const unsigned old = xb_add(&bar[XB_XSUB(b.x)], 1u);
        const unsigned gen = old / nloc;
        if (old + 1u == (gen + 1u) * nloc) {
            __builtin_amdgcn_fence(__ATOMIC_RELEASE, "agent");
            asm volatile("s_waitcnt vmcnt(0)" ::: "memory");
            const unsigned og = xb_add(&bar[XB_TOP], 1u);
            const unsigned tg = og / nx;
            if (og + 1u == (tg + 1u) * nx) xb_add(&bar[XB_TOPGEN], 1u);
            else XB_SPIN(xb_ld(&bar[XB_TOPGEN]) == tg, bar);
            __builtin_amdgcn_fence(__ATOMIC_ACQUIRE, "agent");
            xb_add(&bar[XB_XGEN(b.x)], 1u);
            asm volatile("s_waitcnt vmcnt(0)" ::: "memory");
        } else {
            XB_SPIN(xb_ld(&bar[XB_XGEN(b.x)]) == gen, bar);
            __builtin_amdgcn_fence(__ATOMIC_ACQUIRE, "agent");
            asm volatile("s_waitcnt vmcnt(0)" ::: "memory");
        }
    }
    __syncthreads();
}


__global__ void __launch_bounds__(NTHREADS, 2) mk_fwd(Args args) {
    extern __shared__ __attribute__((aligned(16))) unsigned char lds_raw[];
    LAS unsigned char* lds = (LAS unsigned char*)lds_raw;
    const int tid = threadIdx.x, lane = tid & 63, wave = __builtin_amdgcn_readfirstlane(tid >> 6);
    const int G = gridDim.x, bid = blockIdx.x;
    const int gw = bid * NWAVES + wave, NGW = G * NWAVES;
#define DECL_ALL \
    unsigned char* ws = args.ws; \
    const float* x = (const float*)args.in[0]; const float* mem = (const float*)args.in[1]; const int* positions = (const int*)args.in[2]; \
    const float* g_mix = (const float*)args.in[3]; const float* w_in = (const float*)args.in[4]; \
    const float* g_dq = (const float*)args.in[5]; const float* g_dk = (const float*)args.in[6]; \
    const float* lq1 = (const float*)args.in[7]; const float* lk1 = (const float*)args.in[8]; const float* lq2 = (const float*)args.in[9]; const float* lk2 = (const float*)args.in[10]; \
    const float* g_sub = (const float*)args.in[11]; const float* g_sgu = (const float*)args.in[12]; \
    const float* w_sp = (const float*)args.in[13]; const float* b_sp = (const float*)args.in[14]; \
    const float* g_memn = (const float*)args.in[15]; const float* w_kv = (const float*)args.in[16]; \
    const float* g_cq = (const float*)args.in[17]; const float* g_ck = (const float*)args.in[18]; \
    const float* w_out = (const float*)args.in[19]; const float* g_ffn = (const float*)args.in[20]; \
    const float* w_router = (const float*)args.in[21]; const float* b_router = (const float*)args.in[22]; \
    const float* w_mlp1 = (const float*)args.in[23]; const float* b_mlp1 = (const float*)args.in[24]; \
    const float* w_mlp2 = (const float*)args.in[25]; const float* b_mlp2 = (const float*)args.in[26]; \
    float* out = args.out; \
    unsigned* ctl = (unsigned*)(ws + WS_CTL); \
    bf16_t* WIN_T = (bf16_t*)(ws + WS_WIN); bf16_t* WO_T = (bf16_t*)(ws + WS_WO); bf16_t* WKV_T = (bf16_t*)(ws + WS_WKV); \
    float* CS = (float*)(ws + WS_CS); int* LIST = (int*)(ws + WS_LIST); float* GLIST = (float*)(ws + WS_GLIST); float* RS = (float*)(ws + WS_RS); (void)RS; \
    bf16_t* MEMN = (bf16_t*)(ws + WS_MEMN); bf16_t* MEMK = (bf16_t*)(ws + WS_MEMK); bf16_t* MEMV = (bf16_t*)(ws + WS_MEMV); \
    bf16_t* W1T = (bf16_t*)(ws + WS_W1); bf16_t* W2T = (bf16_t*)(ws + WS_W2); bf16_t* H2 = (bf16_t*)(ws + WS_H2); bf16_t* ACT = (bf16_t*)(ws + WS_ACT); \
    bf16_t* XN = (bf16_t*)(ws + WS_XN); bf16_t* QB = (bf16_t*)(ws + WS_QB); bf16_t* KB = (bf16_t*)(ws + WS_KB); bf16_t* VB = (bf16_t*)(ws + WS_VB); \
    bf16_t* UB = (bf16_t*)(ws + WS_UB); bf16_t* VGB = (bf16_t*)(ws + WS_VGB); bf16_t* MQB = (bf16_t*)(ws + WS_MQB); \
    bf16_t* CAT = (bf16_t*)(ws + WS_CAT); bf16_t* X1B = (bf16_t*)(ws + WS_X1B); (void)X1B; bf16_t* YB = (bf16_t*)(ws + WS_YB); bf16_t* OT = (bf16_t*)(ws + WS_OT); (void)OT; \
    float* PROJ = (float*)(ws + WS_PROJ); float* KVT = (float*)(ws + WS_KVT); \
    (void)x; (void)mem; (void)positions; (void)g_mix; (void)w_in; (void)g_dq; (void)g_dk; (void)lq1; (void)lk1; (void)lq2; (void)lk2; (void)g_sub; (void)g_sgu; (void)w_sp; (void)b_sp; \
    (void)g_memn; (void)w_kv; (void)g_cq; (void)g_ck; (void)w_out; (void)g_ffn; (void)w_router; (void)b_router; (void)w_mlp1; (void)b_mlp1; (void)w_mlp2; (void)b_mlp2; (void)out; (void)ctl; \
    (void)WIN_T; (void)WO_T; (void)WKV_T; (void)CS; (void)LIST; (void)GLIST; (void)MEMN; (void)MEMK; (void)MEMV; (void)W1T; (void)W2T; (void)H2; (void)ACT; (void)XN; (void)QB; (void)KB; (void)VB; \
    (void)UB; (void)VGB; (void)MQB; (void)CAT; (void)YB; (void)PROJ; (void)KVT;

    const int lo = args.ph_lo, hi = args.ph_hi;
#ifndef PHMASK
#define PHMASK 0x1ff
#endif
#define IN(k) (((PHMASK >> (k)) & 1) && lo <= (k) && (k) < hi)
#define BOTH(k) (IN(k) && IN((k) + 1))
    volatile LAS unsigned* misc = (volatile LAS unsigned*)(lds + LDS_BYTES - 64);
    if (tid < 2) misc[tid] = 0u;
    __syncthreads();
    XcdBarrier xbar; xbar.bar = (unsigned*)(args.ws + WS_CTL) + CW_BAR; xbar.x = 0; xbar.st = misc;
    if (hi - lo > 1) xbar = xcd_barrier_post((unsigned*)(args.ws + WS_CTL) + CW_BAR, misc);
#define GRID_BAR() xcd_barrier(xbar)
#define PHASE_STAGGER(total_units, unit_us) do { if ((G & 7) == 0) { const int per_ = G >> 3, rounds_ = ((total_units) + G - 1) / G; int nb_ = 0; \
        for (int xx_ = 0; xx_ < 8; ++xx_) nb_ += (((rounds_ - 1) * 8 + xx_) * per_ < (total_units)) ? 1 : 0; \
        const int x_ = bid & 7; if (x_ >= nb_ && rounds_ > 1) { const int idle_ = 8 - nb_, r_ = (x_ - nb_) + idle_ * (bid >> 3) + 1;     \
            const int n_ = (int)((unit_us) * 2.4f * 1000.f / 2048.f) * r_ / (idle_ * per_ + 1); \
            for (int i_ = 0; i_ < n_; ++i_) __builtin_amdgcn_s_sleep(32); } } } while (0)
#ifndef DUP_PHASE
#define DUP_PHASE (-1)
#endif
#ifndef DUP_S3
#define DUP_S3 0
#endif
#ifndef DUP_S0
#define DUP_S0 0
#endif
#ifndef PROBE_AT
#define PROBE_AT 0
#endif
#ifndef PROBE_G1
#define PROBE_G1 0
#endif
#ifndef PROBE_PHASE
#define PROBE_PHASE (-1)
#endif
#define STAMP(k) do { if (PROBE_PHASE >= 0 && bid == 0 && tid == 0) ((unsigned*)(args.ws + WS_CTL))[64 + (k)] = (unsigned)__builtin_amdgcn_s_memrealtime(); } while (0)

    if (IN(0)) {
        DECL_ALL
        STAMP(0);
        for (int rep_ = 0; rep_ < ((DUP_PHASE == 0) ? 2 : 1); ++rep_) { if (rep_) GRID_BAR();
        LAS float* scr = (LAS float*)(lds + wave * 17024);
        constexpr int I_IN = 16 * (NPROJ / 32), I_O = 16 * 32, I_KV = 16 * 16, I_1 = 8 * 64, I_2 = 8 * 32;
        constexpr int NITEMS = I_IN + I_O + I_KV + NE * I_1 + NE * I_2;
        for (int it_ = gw; it_ < NITEMS * (DUP_S0 == 1 ? 2 : 1); it_ += NGW) {
            const int it = it_ >= NITEMS ? it_ - NITEMS : it_; int r = it;
            if (r < I_IN) { transpose_item_p<true>(w_in, DM, NPROJ, WIN_T, scr, r, lane, [](int n) {
                    if (n < 1024 || n >= 2048) { const int w = n & 255, d = w & 63; return (n & ~255) + 128 * ((d >> 3) & 1) + 32 * (w >> 6) + 8 * (d >> 4) + (d & 7); } return n; }, g_mix); continue; } r -= I_IN;
            if (r < I_O) { transpose_item(w_out, DM, DM, WO_T, scr, r, lane); continue; } r -= I_O;
            if (r < I_KV) { transpose_item_p(w_kv, DM, 512, WKV_T, scr, r, lane, [](int n) {
                    if (n < 256) { const int d = n & 63; return 128 * ((d >> 3) & 1) + 32 * (n >> 6) + 8 * (d >> 4) + (d & 7); } return n; }); continue; } r -= I_KV;
            if (r < NE * I_1) { const int e = r / I_1; transpose_item_f8(w_mlp1 + (size_t)e * DM * 2048, DM, 2048, (unsigned char*)W1T + (size_t)e * 2048 * DM, scr, r % I_1, lane,
                                                                   [](int n) { const int half = n >> 10, q = n & 1023; return 256 * (q >> 7) + 128 * half + (q & 127); }); continue; } r -= NE * I_1;
            { const int e = r / I_2; transpose_item_f8(w_mlp2 + (size_t)e * DFF * DM, DFF, DM, (unsigned char*)W2T + (size_t)e * DM * DFF, scr, r % I_2, lane,
                                       [](int n) { const int w = n & 255; return (n & ~255) + 128 * ((w >> 3) & 1) + 32 * (w >> 6) + 8 * ((w >> 4) & 3) + (w & 7); }); }
        }
        for (int m_ = 2 * gw; m_ < M * (DUP_S0 == 2 ? 2 : 1); m_ += 2 * NGW) { const int m = m_ & (M - 1); row2_to_bf16_rs(x + (size_t)m * DM, x + (size_t)(m + 1) * DM, XN + (size_t)m * DM, XN + (size_t)(m + 1) * DM, (float*)(ws + WS_RSX) + m, lane); }
        for (int i = bid * NTHREADS + tid; i < MM; i += G * NTHREADS) ((float*)(ws + WS_RSX))[M + i] = 1.0f;
        for (int m = gw; m < MM; m += NGW) rms_row_to_bf16(mem + (size_t)m * DM, g_memn, MEMN + (size_t)m * DM, lane);
        for (int i = bid * NTHREADS + tid; i < M * 8; i += G * NTHREADS) {
            const int tok = i >> 3, f = i & 7;
            const float inv = exp2f(-(float)f * (0.125f * 18.931568569324174f));
            const float ang = (float)positions[tok] * inv;
            const double a = (double)ang, kk = rint(a * 0.15915494309189535);
            const float r = (float)(a - kk * 6.283185307179586);
            CS[(size_t)tok * 16 + f] = cosf(r); CS[(size_t)tok * 16 + 8 + f] = sinf(r);
        }
        if (bid == 0 && tid < 64) { ctl[tid] = 0u; float* GT = (float*)(ws + WS_CTL + 4096); GT[tid] = g_dq[tid]; GT[64 + tid] = g_dk[tid]; GT[128 + tid] = g_cq[tid]; GT[192 + tid] = g_ck[tid]; }
        }
        if (BOTH(0)) GRID_BAR();
    }

    if (IN(1)) {
        DECL_ALL
        STAMP(1);
        for (int rep_ = 0; rep_ < ((DUP_PHASE == 1) ? 2 : 1); ++rep_) { if (rep_) GRID_BAR();
        PHASE_STAGGER((M / 256) * 9 + (MM / 256) * 2, 30.f);
        pg8::InProjSched S{(const char*)XN, (const char*)MEMN, (const char*)WIN_T, G, bid};
        pg8::EpiInProj E{ws};
        pg8::gemm_phase<pg8::EpiInProj, pg8::InProjSched, false>(lds, S, E, nullptr);
        }
        if (BOTH(1)) GRID_BAR();
    }

    if (IN(2)) {
        DECL_ALL
        STAMP(2);
    }

    if (IN(3)) {
        DECL_ALL
        STAMP(3);
        for (int rep_ = 0; rep_ < ((DUP_PHASE == 3) ? 2 : 1); ++rep_) { if (rep_) GRID_BAR();
        const int vcu = (G % 8 == 0) ? (bid % 8) * (G / 8) + bid / 8 : bid;
        float lam;
        { int ln = lane; asm volatile("" : "+v"(ln));
          const float l0 = __expf(wave_sum(lq1[ln] * lk1[ln])) - __expf(wave_sum(lq2[ln] * lk2[ln])) + 0.2f; lam = __uint_as_float(__builtin_amdgcn_readfirstlane(__float_as_uint(l0))); }
        for (int pair_ = vcu; pair_ < BATCH * 4 * 4 * (DUP_S3 == 1 ? 2 : 1); pair_ += G) {
            const int pair = pair_ & 255; const int bh = pair >> 2, s4 = pair & 3, b = bh >> 2, h = bh & 3; const size_t rb = (size_t)b * SEQ;
            for (int u = 0; u < 2; ++u) {
                const int qb = u ? 7 - s4 : s4;
                attn_body::attn_unit_v128<8, 512, 512, 512, 1024, true, 1>(QB + (rb + qb * 256) * 512 + (h * 2 + 0) * 64, KB + rb * 512 + (h * 2 + 0) * 64, VB + rb * 512 + h * 128,
                                                                           OT, qb, (char*)lds_raw);
                attn_body::attn_unit_v128<8, 512, 512, 512, 1024, true, 2>(QB + (rb + qb * 256) * 512 + (h * 2 + 1) * 64, KB + rb * 512 + (h * 2 + 1) * 64, VB + rb * 512 + h * 128,
                                                                           CAT + (rb + qb * 256) * 1024 + h * 128, qb, (char*)lds_raw, 0, lam, g_sub);
            }
        }
        if (PROBE_AT) {
            for (int pair = vcu; pair < BATCH * 4 * 4; pair += G) {
                const int bh = pair >> 2, s4 = pair & 3, b = bh >> 2, h = bh & 3; const size_t rb = (size_t)b * SEQ;
                for (int u = 0; u < 4; ++u) {
                    const int qb = (u & 2) ? 7 - s4 : s4, c = u & 1;
                    attn_body::attn_unit_v128<8, 512, 512, 512, 1024, false>(QB + (rb + qb * 256) * 512 + (h * 2 + c) * 64, KB + rb * 512 + (h * 2 + c) * 64, VB + rb * 512 + h * 128,
                                                                             ACT + (rb + qb * 256) * 1024 + h * 256 + c * 128, qb, (char*)lds_raw, PROBE_AT & 63, 0.f, nullptr, PROBE_AT >> 6);
                }
            }
        }
        for (int j_ = vcu; j_ < BATCH * 4 * 8 * (DUP_S3 == 2 ? 2 : 1); j_ += G) {
            const int j = j_ & 511; const int bh = j >> 3, qb = j & 7, b = bh >> 2, h = bh & 3; const size_t rb = (size_t)b * SEQ;
            attn_body::attn_unit<8, 256, 256, 256, 1024, false>(MQB + (rb + qb * 256) * 256 + h * 64, MEMK + (size_t)b * MEML * 256 + h * 64, MEMV + (size_t)b * MEML * 256 + h * 64,
                                                                CAT + (rb + qb * 256) * 1024 + 768 + h * 64, MEML / 64, (char*)lds_raw);
        }
        __syncthreads();
        {
        LAS bf16_t* vnT = (LAS bf16_t*)lds;
        int ln = lane; asm volatile("" : "+v"(ln));
        const int fr = ln & 15, fq = ln >> 4, g = wave >> 1, th = wave & 1;
        for (int it_ = bid; it_ < BATCH * 16 * (DUP_S3 == 3 ? 2 : 1); it_ += G) {
            const int it = it_ & 255; const size_t r0 = (size_t)it * 128;
            const f32x4 gg = *(const f32x4*)(g_sgu + 4 * ln);
            for (int r4 = 0; r4 < 16; r4 += 4) {
                u32x2 w[4]; float v[4][4], mean[4], rstd[4];
#pragma unroll
                for (int q = 0; q < 4; ++q) w[q] = *(const u32x2*)(VGB + (r0 + wave + 8 * (r4 + q)) * 256 + 4 * ln);
#pragma unroll
                for (int q = 0; q < 4; ++q) { v[q][0] = bf2f(w[q].x & 0xffffu); v[q][1] = bf2f(w[q].x >> 16); v[q][2] = bf2f(w[q].y & 0xffffu); v[q][3] = bf2f(w[q].y >> 16); mean[q] = (v[q][0] + v[q][1]) + (v[q][2] + v[q][3]); }
#pragma unroll
                for (int o = 1; o < 64; o <<= 1)
#pragma unroll
                    for (int q = 0; q < 4; ++q) mean[q] += __shfl_xor(mean[q], o);
#pragma unroll
                for (int q = 0; q < 4; ++q) { mean[q] *= (1.f / 256);
#pragma unroll
                    for (int i = 0; i < 4; ++i) v[q][i] -= mean[q];
                    rstd[q] = (v[q][0] * v[q][0] + v[q][1] * v[q][1]) + (v[q][2] * v[q][2] + v[q][3] * v[q][3]); }
#pragma unroll
                for (int o = 1; o < 64; o <<= 1)
#pragma unroll
                    for (int q = 0; q < 4; ++q) rstd[q] += __shfl_xor(rstd[q], o);
#pragma unroll
                for (int q = 0; q < 4; ++q) { const float rs = 1.0f / sqrtf(rstd[q] * (1.f / 256) + EPS); const int rr = wave + 8 * (r4 + q);
                    LAS bf16_t* o = vnT + (4 * ln) * 136 + rr;
                    o[0] = (bf16_t)f2bf(v[q][0] * rs * gg.x); o[136] = (bf16_t)f2bf(v[q][1] * rs * gg.y); o[272] = (bf16_t)f2bf(v[q][2] * rs * gg.z); o[408] = (bf16_t)f2bf(v[q][3] * rs * gg.w); }
            }
            __syncthreads();
            f32x4 acc[4][4];
#pragma unroll
            for (int m = 0; m < 4; ++m)
#pragma unroll
                for (int n = 0; n < 4; ++n) acc[m][n] = (f32x4){0.f, 0.f, 0.f, 0.f};
            const int nks = th ? 4 : 2;
            for (int ks = 0; ks < nks; ++ks) {
                bf16x8 af[4], bfr[4];
#pragma unroll
                for (int m = 0; m < 4; ++m) af[m] = *(const LAS bf16x8*)(vnT + (g * 64 + 16 * m + fr) * 136 + 32 * ks + 8 * fq);
#pragma unroll
                for (int n = 0; n < 4; ++n) {
                    const int t = th * 64 + 16 * n + fr, s0 = 32 * ks + 8 * fq;
                    const float* wp = w_sp + ((size_t)g * 128 + t) * 128 + s0;
                    const f32x4 wa = *(const f32x4*)wp, wb = *(const f32x4*)(wp + 4);
                    u32x4 pk; pk.x = pk2(s0 + 0 <= t ? wa[0] : 0.f, s0 + 1 <= t ? wa[1] : 0.f); pk.y = pk2(s0 + 2 <= t ? wa[2] : 0.f, s0 + 3 <= t ? wa[3] : 0.f);
                    pk.z = pk2(s0 + 4 <= t ? wb[0] : 0.f, s0 + 5 <= t ? wb[1] : 0.f); pk.w = pk2(s0 + 6 <= t ? wb[2] : 0.f, s0 + 7 <= t ? wb[3] : 0.f);
                    bfr[n] = __builtin_bit_cast(bf16x8, pk);
                }
#pragma unroll
                for (int m = 0; m < 4; ++m)
#pragma unroll
                    for (int n = 0; n < 4; ++n) acc[m][n] = __builtin_amdgcn_mfma_f32_16x16x32_bf16(af[m], bfr[n], acc[m][n], 0, 0, 0);
            }
#pragma unroll
            for (int n = 0; n < 4; ++n) {
                const int t = th * 64 + 16 * n + fr; const float bt = b_sp[g * 128 + t];
#pragma unroll
                for (int m = 0; m < 4; ++m) {
                    const int ch = g * 64 + 16 * m + 4 * fq;
                    const u32x2 uw = *(const u32x2*)(UB + (r0 + t) * 256 + ch);
                    u32x2 ow; ow.x = pk2(bf2f(uw.x & 0xffffu) * (acc[m][n][0] + bt), bf2f(uw.x >> 16) * (acc[m][n][1] + bt)); ow.y = pk2(bf2f(uw.y & 0xffffu) * (acc[m][n][2] + bt), bf2f(uw.y >> 16) * (acc[m][n][3] + bt));
                    *(u32x2*)(CAT + (r0 + t) * 1024 + 512 + ch) = ow;
                }
            }
            __syncthreads();
        }
        }
        }
        if (BOTH(3)) GRID_BAR();
    }

#define ROUTER_TABLE_FILL() do { LAS unsigned short* th_ = (LAS unsigned short*)lds; LAS unsigned short* tl_ = th_ + 32768; f32x4 wv[16]; float gk[16]; \
        _Pragma("unroll") for (int i = 0; i < 16; ++i) { const int f = tid + NTHREADS * i; wv[i] = *(const f32x4*)(w_router + 4 * f); gk[i] = g_ffn[f >> 3]; } \
        _Pragma("unroll") for (int i = 0; i < 16; ++i) { const int f = tid + NTHREADS * i, k = f >> 3, e0 = 4 * (f & 7); const int o = ((k >> 3) * 32 + e0) * 8 + (k & 7); \
            _Pragma("unroll") for (int q = 0; q < 4; ++q) { const float v = wv[i][q] * gk[i]; const unsigned h = pk2(v, 0.f) & 0xffffu; const float r = v - bf2f(h); \
                th_[o + 8 * q] = (unsigned short)h; tl_[o + 8 * q] = (unsigned short)(pk2(r, 0.f) & 0xffffu); } } } while (0)

    if (IN(4)) {
        DECL_ALL
        STAMP(4);
        for (int rep_ = 0; rep_ < ((DUP_PHASE == 4) ? 2 : 1); ++rep_) { if (rep_) GRID_BAR();
        pg8::DenseSched S{(const char*)CAT, (const char*)WO_T, DM / 256, (M / 256) * (DM / 256), G, bid};
        pg8::EpiResidual E{XN, X1B, (unsigned char*)H2, g_ffn};
        pg8::gemm_phase<pg8::EpiResidual, pg8::DenseSched, false>(lds, S, E, nullptr);
        }
        if (IN(5)) { ROUTER_TABLE_FILL(); }
        if (BOTH(4)) GRID_BAR();
    }

    if (IN(5)) {
        DECL_ALL
        STAMP(5);
        if (!IN(4)) { ROUTER_TABLE_FILL(); }
        LAS unsigned* lcnt = (LAS unsigned*)(lds + 141 * 1024); LAS unsigned* lbase = lcnt + 32;
        const int i16 = lane & 15, kq = lane >> 4;
        const float be0 = b_router[i16], be1 = b_router[16 + i16];
        for (int tile = bid; tile < M / 128; tile += G) {
            if (tid < 32) lcnt[tid] = 0u;
            __syncthreads();
            const int tok0 = tile * 128 + wave * 16;
            const bf16_t* xp = X1B + (size_t)(tok0 + i16) * DM + 8 * kq;
            const LAS unsigned char* wp = (const LAS unsigned char*)lds + (kq * 32 + i16) * 16;
            f32x4 acc0 = (f32x4){0.f, 0.f, 0.f, 0.f}, acc1 = (f32x4){0.f, 0.f, 0.f, 0.f}; float ss = 0.f;
            u32x4 xall[32];
#pragma unroll
            for (int j = 0; j < 32; ++j) xall[j] = *(const u32x4*)(xp + 32 * j);
#pragma unroll
            for (int j = 0; j < 32; ++j) {
                const u32x4 xw = xall[j];
#pragma unroll
                for (int q = 0; q < 4; ++q) { const float lo = bf2f(xw[q] & 0xffffu), hi = __uint_as_float(xw[q] & 0xffff0000u); ss += lo * lo + hi * hi; }
                const bf16x8 xa = __builtin_bit_cast(bf16x8, xw);
                const bf16x8 h0 = *(const LAS bf16x8*)(wp + j * 2048), h1 = *(const LAS bf16x8*)(wp + j * 2048 + 256), l0 = *(const LAS bf16x8*)(wp + 65536 + j * 2048), l1 = *(const LAS bf16x8*)(wp + 65536 + j * 2048 + 256);
                acc0 = __builtin_amdgcn_mfma_f32_16x16x32_bf16(xa, l0, acc0, 0, 0, 0); acc1 = __builtin_amdgcn_mfma_f32_16x16x32_bf16(xa, l1, acc1, 0, 0, 0);
                acc0 = __builtin_amdgcn_mfma_f32_16x16x32_bf16(xa, h0, acc0, 0, 0, 0); acc1 = __builtin_amdgcn_mfma_f32_16x16x32_bf16(xa, h1, acc1, 0, 0, 0);
            }
            ss += __shfl_xor(ss, 16); ss += __shfl_xor(ss, 32);
            const float rstd = 1.0f / sqrtf(ss * (1.f / DM) + EPS);
            unsigned key0[4], key1[4]; float rsr[4];
#pragma unroll
            for (int reg = 0; reg < 4; ++reg) {
                rsr[reg] = __shfl(rstd, 4 * kq + reg);
                const float l0 = acc0[reg] * rsr[reg] + be0, l1 = acc1[reg] * rsr[reg] + be1;
                unsigned u0 = __float_as_uint(l0), u1 = __float_as_uint(l1);
                u0 ^= (u0 >> 31) ? 0xffffffffu : 0x80000000u; u1 ^= (u1 >> 31) ? 0xffffffffu : 0x80000000u;
                key0[reg] = (u0 & ~31u) | (unsigned)(31 - i16); key1[reg] = (u1 & ~31u) | (unsigned)(15 - i16);
            }
            unsigned win[4][4];
#pragma unroll
            for (int k = 0; k < 4; ++k)
#pragma unroll
                for (int reg = 0; reg < 4; ++reg) {
                    unsigned mk = key0[reg] > key1[reg] ? key0[reg] : key1[reg];
#pragma unroll
                    for (int o = 1; o < 16; o <<= 1) { const unsigned ok = (unsigned)__shfl_xor((int)mk, o); mk = ok > mk ? ok : mk; }
                    win[reg][k] = mk;
                    if (key0[reg] == mk) key0[reg] = 0u; if (key1[reg] == mk) key1[reg] = 0u;
                }
            unsigned mym = 0u; float myg = 0.f, myrs = 0.f;
#pragma unroll
            for (int reg = 0; reg < 4; ++reg) {
                float v[4], ex[4], sum = 0.f;
#pragma unroll
                for (int k = 0; k < 4; ++k) { unsigned uu = win[reg][k] & ~31u; uu ^= (uu >> 31) ? 0x80000000u : 0xffffffffu; v[k] = __uint_as_float(uu); }
#pragma unroll
                for (int k = 0; k < 4; ++k) { ex[k] = __expf(v[k] - v[0]); sum += ex[k]; }
                const float rsum = 1.0f / sum;
#pragma unroll
                for (int k = 0; k < 4; ++k) if (i16 == 4 * reg + k) { mym = win[reg][k]; myg = ex[k] * rsum; myrs = rsr[reg]; }
            }
            const int e_sel = 31 - (int)(mym & 31u);
            const unsigned lr = atomicAdd((unsigned*)&lcnt[e_sel], 1u);
            __syncthreads();
            if (tid < 32) { const unsigned c = lcnt[tid]; lbase[tid] = c ? atomicAdd(&ctl[2048 + 32 * tid], c) : 0u; }
            __syncthreads();
            const size_t slot = (size_t)e_sel * M + lbase[e_sel] + lr;
            LIST[slot] = (tok0 + 4 * kq + (i16 >> 2)) * 4 + (i16 & 3); GLIST[(size_t)(tok0 + 4 * kq + (i16 >> 2)) * 4 + (i16 & 3)] = myg; RS[slot] = myrs;
            ((int*)(ws + WS_SLOTS))[(size_t)(tok0 + 4 * kq + (i16 >> 2)) * 4 + (i16 & 3)] = (e_sel << 16) | (int)(lbase[e_sel] + lr);
        }
        if (BOTH(5)) GRID_BAR();
    }

    LAS int* tstart = (LAS int*)(lds + 140 * 1024); LAS int* ecnt = tstart + 40; LAS int* texp = tstart + 80;
    if (IN(6) || IN(7) || IN(8)) {
        DECL_ALL
        __syncthreads();
        if (tid < NE) ecnt[tid] = (int)__hip_atomic_load(&ctl[2048 + 32 * tid], __ATOMIC_RELAXED, __HIP_MEMORY_SCOPE_AGENT);
        __syncthreads();
        if (tid == 0) { int acc = 0; for (int e = 0; e < NE; ++e) { tstart[e] = acc; acc += (ecnt[e] + 255) / 256; } tstart[NE] = acc; }
        __syncthreads();
        for (int t = tid; t < MAXTILES; t += NTHREADS) { int e = 0; for (int q = 1; q < NE; ++q) if (tstart[q] <= t) e = q; texp[t] = e; }
        __syncthreads();
    }
    if (IN(6)) {
        DECL_ALL
        STAMP(6);
        for (int rep_ = 0; rep_ < ((DUP_PHASE == 6) ? 2 : 1); ++rep_) { if (rep_) GRID_BAR();
        const int ntiles = tstart[NE];
        PHASE_STAGGER(ntiles * 8, 15.f);
        pg8::MoeSched S{(const char*)H2, (const char*)W1T, (size_t)2048 * DM, LIST, tstart, ecnt, texp, 8, ntiles * 8, G, bid, false, DM};
        pg8::EpiSwiglu E{(unsigned char*)ACT, b_mlp1, RS, ecnt};
        pg8::gemm_phase<pg8::EpiSwiglu, pg8::MoeSched, true, true>(lds, S, E, (LAS unsigned*)(lds + 131072));
        if (PROBE_G1) {
            GRID_BAR();
            pg8::MoeSched S2 = S; S2.hot = (PROBE_G1 >= 2);
            pg8::EpiSwiglu E2{(unsigned char*)YB, b_mlp1, RS, ecnt};
            if (PROBE_G1 == 3) pg8::gemm_phase<pg8::EpiSwiglu, pg8::MoeSched, true, true, 4>(lds, S2, E2, (LAS unsigned*)(lds + 131072));
            else if (PROBE_G1 == 4) pg8::gemm_phase<pg8::EpiSwiglu, pg8::MoeSched, true, true, 2>(lds, S2, E2, (LAS unsigned*)(lds + 131072));
            else pg8::gemm_phase<pg8::EpiSwiglu, pg8::MoeSched, true, true>(lds, S2, E2, (LAS unsigned*)(lds + 131072));
        }
        }
        if (BOTH(6)) GRID_BAR();
    }
    if (IN(7)) {
        DECL_ALL
        STAMP(7);
        for (int rep_ = 0; rep_ < ((DUP_PHASE == 7) ? 2 : 1); ++rep_) { if (rep_) GRID_BAR();
        const int ntiles = tstart[NE];
        PHASE_STAGGER(ntiles * 4, 16.f);
        pg8::MoeSched S{(const char*)ACT, (const char*)W2T, (size_t)DM * DFF, LIST, tstart, ecnt, texp, 4, ntiles * 4, G, bid, true, DFF};
        pg8::EpiGateScatter E{(unsigned char*)YB, b_mlp2};
        pg8::gemm_phase<pg8::EpiGateScatter, pg8::MoeSched, true, true>(lds, S, E, (LAS unsigned*)(lds + 131072));
        }
        if (BOTH(7)) GRID_BAR();
    }
    if (IN(8)) {
        DECL_ALL
        STAMP(8);
        const size_t i0 = (size_t)bid * NTHREADS + tid, istep = (size_t)G * NTHREADS, iend = (size_t)M * DM / 16;
        u32x4 sl_n = (u32x4){0u, 0u, 0u, 0u}; f32x4 gt_n = (f32x4){0.f, 0.f, 0.f, 0.f};
        if (i0 < iend) { const size_t tok = i0 / (DM / 16); sl_n = *(const u32x4*)((const int*)(ws + WS_SLOTS) + tok * 4); gt_n = *(const f32x4*)(GLIST + tok * 4); }
        for (size_t i = i0; i < iend; i += istep) {
            const size_t tok = i / (DM / 16); const int c = (int)(i % (DM / 16)) * 16;
            f32x4 a[4]; u32x4 y[4]; const f32x4 gt = gt_n; const u32x4 sl = sl_n;
#pragma unroll
            for (int k = 0; k < 4; ++k) { const size_t row = (size_t)tstart[sl[k] >> 16] * 256 + (sl[k] & 0xffffu); y[k] = *(const u32x4*)((const unsigned char*)YB + row * DM + c); }
            u32x4 xw[2];
#pragma unroll
            for (int j = 0; j < 2; ++j) xw[j] = *(const u32x4*)(X1B + tok * DM + c + 8 * j);
            if (i + istep < iend) { const size_t tn = (i + istep) / (DM / 16); sl_n = *(const u32x4*)((const int*)(ws + WS_SLOTS) + tn * 4); gt_n = *(const f32x4*)(GLIST + tn * 4); }
#pragma unroll
            for (int j = 0; j < 2; ++j) {
                a[2 * j] = (f32x4){bf2f(xw[j].x & 0xffffu), __uint_as_float(xw[j].x & 0xffff0000u), bf2f(xw[j].y & 0xffffu), __uint_as_float(xw[j].y & 0xffff0000u)};
                a[2 * j + 1] = (f32x4){bf2f(xw[j].z & 0xffffu), __uint_as_float(xw[j].z & 0xffff0000u), bf2f(xw[j].w & 0xffffu), __uint_as_float(xw[j].w & 0xffff0000u)}; }
#pragma unroll
            for (int k = 0; k < 4; ++k)
#pragma unroll
                for (int j = 0; j < 4; ++j) { const int w = (int)y[k][j]; const float g = gt[k];
                    a[j].x += g * __builtin_amdgcn_cvt_f32_fp8(w, 0); a[j].y += g * __builtin_amdgcn_cvt_f32_fp8(w, 1); a[j].z += g * __builtin_amdgcn_cvt_f32_fp8(w, 2); a[j].w += g * __builtin_amdgcn_cvt_f32_fp8(w, 3); }
#pragma unroll
            for (int j = 0; j < 4; ++j) *(f32x4*)(out + tok * DM + c + 4 * j) = a[j];
        }
    }
#undef IN
#undef BOTH
}

extern "C" void kernel_launch(void* const* d_in, const int* in_sizes, int n_in, void* d_out, int out_size, void* d_ws, size_t ws_size, hipStream_t stream) {
    static int grid = 0;
    if (grid == 0) {
        if (n_in != 27 || out_size != M * DM || ws_size < WS_END) { fprintf(stderr, "kernel_launch: unexpected problem (n_in %d out %d ws %zu)\n", n_in, out_size, ws_size); grid = -1; return; }
        int dev = 0, cus = 0, per_cu = 0;
        hipGetDevice(&dev); hipDeviceGetAttribute(&cus, hipDeviceAttributeMultiprocessorCount, dev);
        if (hipFuncSetAttribute((const void*)mk_fwd, hipFuncAttributeMaxDynamicSharedMemorySize, LDS_BYTES) != hipSuccess) { fprintf(stderr, "kernel_launch: hipFuncSetAttribute failed\n"); grid = -1; return; }
        hipOccupancyMaxActiveBlocksPerMultiprocessor(&per_cu, (const void*)mk_fwd, NTHREADS, LDS_BYTES);
        (void)hipGetLastError();
        if (per_cu < 1) { fprintf(stderr, "kernel_launch: occupancy query says %d blocks per CU\n", per_cu); per_cu = 1; }
        grid = cus;
    }
    if (grid < 0) return;
    if (hipMemsetAsync((char*)d_ws + WS_CTL, 0, CTL_ZERO_BYTES, stream) != hipSuccess) { fprintf(stderr, "kernel_launch: hipMemsetAsync failed\n"); return; }
    Args a{};
    for (int i = 0; i < 27; ++i) a.in[i] = d_in[i];
    a.out = (float*)d_out; a.ws = (unsigned char*)d_ws;
    constexpr int NPH = 9;
    if (MK_N_LAUNCHES == 1) {
        a.ph_lo = 0; a.ph_hi = NPH;
        void* kargs[] = {&a};
        hipError_t e = hipLaunchCooperativeKernel((const void*)mk_fwd, dim3(grid), dim3(NTHREADS), kargs, LDS_BYTES, stream);
        if (e != hipSuccess) fprintf(stderr, "cooperative launch failed: %s (grid %d)\n", hipGetErrorString(e), grid);
    } else {
        for (int p = 0; p < NPH; ++p) { a.ph_lo = p; a.ph_hi = p + 1; hipLaunchKernelGGL(mk_fwd, dim3(grid), dim3(NTHREADS), LDS_BYTES, stream, a); }
    }
}
```
